# Optimizing an MI355X kernel written in HIP

```python
import math
import jax, jax.numpy as jnp
from jax import lax
import numpy as np

D_MODEL = 1024
BATCH = 32
SEQ = 2048
DEPTH = 2

HEAD_DIM = 64
N_HEADS = D_MODEL // HEAD_DIM
N_KV_HEADS = N_HEADS // 4
QKV_WIDTH = (N_HEADS + 2 * N_KV_HEADS) * HEAD_DIM
ATTN_HALF_WINDOW = 128
DILATED_GROUPS = ((128, 1), (512, 4), (2048, 16))
N_DGROUPS = len(DILATED_GROUPS)
N_MIXERS = 2
N_LAYERS_A = (DEPTH + 1) // 2
N_LAYERS_B = DEPTH // 2
D_FF = -(-8 * D_MODEL // (3 * 256)) * 256
ROPE_THETA = 10000.0
RMS_EPS = 1e-6
NEG_INF = -1e30

kernel_name = "hybrid_window_sink_dilated_encoder"


def rmsnorm(x, g):
    x32 = x.astype(jnp.float32)
    y = x32 * lax.rsqrt(jnp.mean(x32 * x32, axis=-1, keepdims=True) + RMS_EPS)
    return (y * g.astype(jnp.float32)).astype(x.dtype)


def rope_tables(seq):
    inv_freq = 1.0 / (ROPE_THETA ** (jnp.arange(0, HEAD_DIM, 2, dtype=jnp.float32) / HEAD_DIM))
    ang = jnp.arange(seq, dtype=jnp.float32)[:, None] * inv_freq[None, :]
    return jnp.cos(ang)[:, None, :], jnp.sin(ang)[:, None, :]


def apply_rope(t, cos, sin):
    t32 = t.astype(jnp.float32)
    t1, t2 = jnp.split(t32, 2, axis=-1)
    out = jnp.concatenate([t1 * cos - t2 * sin, t2 * cos + t1 * sin], axis=-1)
    return out.astype(t.dtype)


def split_qkv(proj, cos, sin):
    b, s, _ = proj.shape
    qw = N_HEADS * HEAD_DIM
    kw = N_KV_HEADS * HEAD_DIM
    q = proj[..., :qw].reshape(b, s, N_HEADS, HEAD_DIM)
    k = proj[..., qw:qw + kw].reshape(b, s, N_KV_HEADS, HEAD_DIM)
    v = proj[..., qw + kw:].reshape(b, s, N_KV_HEADS, HEAD_DIM)
    return apply_rope(q, cos, sin), apply_rope(k, cos, sin), v


def banded_attention(q, k, v, half_window, sink=None):
    n, length, n_q, dh = q.shape
    n_kv = k.shape[2]
    grp = n_q // n_kv
    w = half_window
    nb = -(-length // w)
    lp = nb * w
    qb = jnp.pad(q, ((0, 0), (0, lp - length), (0, 0), (0, 0))).reshape(n, nb, w, n_kv, grp, dh)
    pad_kv = ((0, 0), (w, w + lp - length), (0, 0), (0, 0))
    kp = jnp.pad(k, pad_kv)
    vp = jnp.pad(v, pad_kv)
    scale = 1.0 / math.sqrt(dh)
    offs_q = jnp.arange(w)
    offs_k = jnp.arange(3 * w) - w
    sink_l = None if sink is None else sink.astype(jnp.float32).reshape(n_kv, grp)[None, :, :, None]

    def one_block(i):
        start = i * w
        q_i = lax.dynamic_index_in_dim(qb, i, axis=1, keepdims=False)
        k_i = lax.dynamic_slice_in_dim(kp, start, 3 * w, axis=1)
        v_i = lax.dynamic_slice_in_dim(vp, start, 3 * w, axis=1)
        s = jnp.einsum('nqkgd,nskd->nkgqs', q_i, k_i).astype(jnp.float32) * scale
        qpos = start + offs_q
        kpos = start + offs_k
        valid = ((jnp.abs(qpos[:, None] - kpos[None, :]) <= w)
                 & (kpos[None, :] >= 0) & (kpos[None, :] < length))
        s = jnp.where(valid, s, NEG_INF)
        m = jnp.max(s, axis=-1)
        if sink_l is not None:
            m = jnp.maximum(m, sink_l)
        p = jnp.exp(s - m[..., None])
        denom = jnp.sum(p, axis=-1)
        if sink_l is not None:
            denom = denom + jnp.exp(sink_l - m)
        o = jnp.einsum('nkgqs,nskd->nqkgd', p, v_i.astype(jnp.float32))
        o = o / jnp.transpose(denom, (0, 3, 1, 2))[..., None]
        lse = jnp.transpose(m + jnp.log(denom), (0, 3, 1, 2))
        return o.astype(q.dtype), lse

    o, lse = lax.map(one_block, jnp.arange(nb))
    o = jnp.moveaxis(o, 0, 1).reshape(n, lp, n_q, dh)[:, :length]
    lse = jnp.moveaxis(lse, 0, 1).reshape(n, lp, n_q)[:, :length]
    return o, lse


def dilated_attention(q, k, v, dilation, half_window):
    b, s, n_q, dh = q.shape
    d = dilation

    def to_residue(t):
        return t.reshape(b, s // d, d, t.shape[2], dh).transpose(0, 2, 1, 3, 4).reshape(b * d, s // d, t.shape[2], dh)

    o, lse = banded_attention(to_residue(q), to_residue(k), to_residue(v), half_window // d)
    o = o.reshape(b, d, s // d, n_q, dh).transpose(0, 2, 1, 3, 4).reshape(b, s, n_q, dh)
    lse = lse.reshape(b, d, s // d, n_q).transpose(0, 2, 1, 3).reshape(b, s, n_q)
    return o, lse


def mixer_window_sink(h, w_in, sink, w_out, cos, sin):
    b, s, _ = h.shape
    q, k, v = split_qkv(h @ w_in, cos, sin)
    o, _ = banded_attention(q, k, v, ATTN_HALF_WINDOW, sink)
    return o.reshape(b, s, N_HEADS * HEAD_DIM) @ w_out


def mixer_dilated(h, w_in, w_out, cos, sin):
    b, s, _ = h.shape
    proj = (h @ w_in).reshape(b, s, N_DGROUPS, QKV_WIDTH)
    outs, lses = [], []
    for g, (window, dilation) in enumerate(DILATED_GROUPS):
        q, k, v = split_qkv(proj[:, :, g], cos, sin)
        o, lse = dilated_attention(q, k, v, dilation, window // 2)
        outs.append(o)
        lses.append(lse)
    wts = jax.nn.softmax(jnp.stack(lses, axis=0), axis=0)
    o = (wts[0][..., None] * outs[0].astype(jnp.float32)
         + wts[1][..., None] * outs[1].astype(jnp.float32)
         + wts[2][..., None] * outs[2].astype(jnp.float32))
    return o.astype(h.dtype).reshape(b, s, N_HEADS * HEAD_DIM) @ w_out


def swiglu(h, w_gate, w_up, w_down):
    return (jax.nn.silu(h @ w_gate) * (h @ w_up)) @ w_down


def setup_inputs(seed: int = 0) -> dict:
    key = jax.random.key(seed)
    ks = jax.random.split(key, 14)
    f32 = jnp.float32
    d = D_MODEL
    hd = N_HEADS * HEAD_DIM
    x = jax.random.normal(ks[0], (BATCH, SEQ, d), f32)
    a_w_in = jax.random.normal(ks[1], (N_LAYERS_A, d, QKV_WIDTH), f32) * d ** -0.5
    a_sink = jax.random.normal(ks[2], (N_LAYERS_A, N_HEADS), f32) * 0.5
    a_w_out = jax.random.normal(ks[3], (N_LAYERS_A, hd, d), f32) * hd ** -0.5
    b_w_in = jax.random.normal(ks[4], (N_LAYERS_B, d, N_DGROUPS * QKV_WIDTH), f32) * d ** -0.5
    b_w_out = jax.random.normal(ks[5], (N_LAYERS_B, hd, d), f32) * hd ** -0.5
    norm_mix = 1.0 + 0.02 * jax.random.normal(ks[6], (DEPTH, d), f32)
    norm_ffn = 1.0 + 0.02 * jax.random.normal(ks[7], (DEPTH, d), f32)
    w_gate = jax.random.normal(ks[8], (DEPTH, d, D_FF), f32) * d ** -0.5
    w_up = jax.random.normal(ks[9], (DEPTH, d, D_FF), f32) * d ** -0.5
    w_down = jax.random.normal(ks[10], (DEPTH, D_FF, d), f32) * D_FF ** -0.5
    final_norm = 1.0 + 0.02 * jax.random.normal(ks[11], (d,), f32)
    return {"x": x, "a_w_in": a_w_in, "a_sink": a_sink, "a_w_out": a_w_out,
            "b_w_in": b_w_in, "b_w_out": b_w_out, "norm_mix": norm_mix, "norm_ffn": norm_ffn,
            "w_gate": w_gate, "w_up": w_up, "w_down": w_down, "final_norm": final_norm}


def reference(x, a_w_in, a_sink, a_w_out, b_w_in, b_w_out, norm_mix, norm_ffn,
              w_gate, w_up, w_down, final_norm):
    cos, sin = rope_tables(x.shape[1])
    for i in range(DEPTH):
        h = rmsnorm(x, norm_mix[i])
        j = i // N_MIXERS
        if i % N_MIXERS == 0:
            mix = mixer_window_sink(h, a_w_in[j], a_sink[j], a_w_out[j], cos, sin)
        else:
            mix = mixer_dilated(h, b_w_in[j], b_w_out[j], cos, sin)
        x = x + mix
        h = rmsnorm(x, norm_ffn[i])
        x = x + swiglu(h, w_gate[i], w_up[i], w_down[i])
    return rmsnorm(x, final_norm)
```

```cpp
#include <hip/hip_runtime.h>
#include <hip/hip_cooperative_groups.h>
#include <cstdio>
#include <cstdint>
namespace cg = cooperative_groups;

#ifndef MK_N_LAUNCHES
#define MK_N_LAUNCHES 1
#endif

namespace pg8 {
#define PG8_LAS __attribute__((address_space(3)))
typedef unsigned short bf16_t;
typedef short bf16x8 __attribute__((ext_vector_type(8)));
typedef float f32x4 __attribute__((ext_vector_type(4)));
typedef unsigned u32x4 __attribute__((ext_vector_type(4)));
typedef unsigned u32x2 __attribute__((ext_vector_type(2)));
constexpr int BM = 256, BK = 64, HALF = 128, HTB = HALF * BK * 2, STAGE_BYTES = 8 * HTB, NXCD = 8, WGM = 8;

__host__ __device__ __forceinline__ int lds_byte(int r, int c) { const int st = (r >> 4) * 2 + (c >> 5), rr = r & 15, cc = c & 31, ob = rr * 64 + cc * 2; return st * 1024 + (ob ^ (((ob >> 9) & 1) << 5)); }
__host__ __device__ __forceinline__ void stage_rc(int b, int& R, int& C) { const int st = b / 1024, sb = b % 1024, swz = sb ^ (((sb >> 9) & 1) << 5); R = (st >> 1) * 16 + swz / 64; C = (st & 1) * 32 + (swz % 64) / 2; }
__host__ __device__ __forceinline__ int perm32(int rho) { const int n = rho >> 4, i = rho & 15; return 8 * (i >> 2) + 4 * n + (i & 3); }

struct Unit { int pm, pn; };
struct Gemm { const bf16_t* A; const bf16_t* Bt; int M, N, K; };

struct StaticOrder {
    int nM, nN, nwg, G, c;
    __host__ __device__ void init(int M, int N, int G_, int c_) { nM = M / BM; nN = N / BM; nwg = nM * nN; G = G_; c = c_; }
    __host__ __device__ bool next(int i, Unit& u) const {
        const long L = (long)i * G + c; if (L >= nwg) return false;
        int wgid = (int)L; { const int q = nwg / NXCD, r = nwg % NXCD, xcd = wgid % NXCD, off = wgid / NXCD; wgid = (xcd < r ? xcd * (q + 1) : r * (q + 1) + (xcd - r) * q) + off; }
        const int nig = WGM * nN, gid = wgid / nig, fm = gid * WGM, gsz = (nM - fm) < WGM ? (nM - fm) : WGM;
        u.pm = fm + ((wgid % nig) % gsz); u.pn = (wgid % nig) / gsz; return true;
    }
    __device__ __forceinline__ void a_ready(const Unit&) const {}
    __device__ __forceinline__ void done(const Unit&) const {}
};

__device__ __forceinline__ unsigned cvt_pk_bf16(float lo, float hi) { unsigned r; asm volatile("v_cvt_pk_bf16_f32 %0, %1, %2" : "=v"(r) : "v"(lo), "v"(hi)); return r; }

constexpr float RMS_EPS = 1e-6f;
constexpr float QSCALE = 0.125f * 1.4426950408889634f;


struct EpiQKV {
    static constexpr bool PERM = true, AFTER_DRAIN = false;
    bf16_t* O; int ldc; const float* ssq; const float* cosT; const float* sinT;
    __device__ __forceinline__ void operator()(const f32x4 (&acc)[2][2][4][2], const Unit& u, int wr, int wc, int fr, int fq) const {
        const int row0 = u.pm * BM + wr * 64 + fr; const int t6 = u.pn % 6;
        const int col0 = u.pn * BM + wc * 32 + 8 * fq; const int fi = 16 * (wc & 1) + 4 * fq;
        const float qs = t6 < 4 ? QSCALE : 1.0f; const bool rope = t6 < 5;
#pragma unroll
        for (int ai = 0; ai < 2; ++ai)
#pragma unroll
            for (int m = 0; m < 4; ++m) {
                const int row = row0 + ai * HALF + m * 16; const int t = row & 2047;
                const float rstd = __builtin_amdgcn_rsqf(ssq[row] * (1.0f / 1024.0f) + RMS_EPS);
                f32x4 cs = (f32x4){1.f, 1.f, 1.f, 1.f}, sn = (f32x4){0.f, 0.f, 0.f, 0.f};
                if (rope) { cs = *(const f32x4*)(cosT + t * 32 + fi); sn = *(const f32x4*)(sinT + t * 32 + fi); }
                const float s1 = rstd * qs; cs = cs * s1; sn = sn * s1;
                bf16_t* rowp = O + (size_t)row * ldc + col0;
#pragma unroll
                for (int bj = 0; bj < 2; ++bj) {
                    const f32x4 v0 = acc[ai][bj][m][0], v1 = acc[ai][bj][m][1];
                    const f32x4 o0 = v0 * cs - v1 * sn, o1 = v1 * cs + v0 * sn;
                    u32x4 w; w.x = cvt_pk_bf16(o0[0], o0[1]); w.y = cvt_pk_bf16(o0[2], o0[3]); w.z = cvt_pk_bf16(o1[0], o1[1]); w.w = cvt_pk_bf16(o1[2], o1[3]);
                    *(u32x4*)(rowp + bj * HALF) = w; }
            }
    }
};

struct EpiSwiGLU {
    static constexpr bool PERM = true, AFTER_DRAIN = false;
    bf16_t* O; int ldc; const float* ssq;
    __device__ __forceinline__ void operator()(const f32x4 (&acc)[2][2][4][2], const Unit& u, int wr, int wc, int fr, int fq) const {
        const int row0 = u.pm * BM + wr * 64 + fr; const int col0 = u.pn * HALF + wc * 32 + 8 * fq;
#pragma unroll
        for (int ai = 0; ai < 2; ++ai)
#pragma unroll
            for (int m = 0; m < 4; ++m) {
                const int row = row0 + ai * HALF + m * 16;
                const float rstd = __builtin_amdgcn_rsqf(ssq[row] * (1.0f / 1024.0f) + RMS_EPS);
                float h[8];
#pragma unroll
                for (int n = 0; n < 2; ++n)
#pragma unroll
                    for (int e = 0; e < 4; ++e) { const float g = acc[ai][0][m][n][e] * rstd, up = acc[ai][1][m][n][e] * rstd;
                        h[n * 4 + e] = g * up * __builtin_amdgcn_rcpf(1.0f + __builtin_amdgcn_exp2f(-1.4426950408889634f * g)); }
                u32x4 w; w.x = cvt_pk_bf16(h[0], h[1]); w.y = cvt_pk_bf16(h[2], h[3]); w.z = cvt_pk_bf16(h[4], h[5]); w.w = cvt_pk_bf16(h[6], h[7]);
                *(u32x4*)(O + (size_t)row * ldc + col0) = w;
            }
    }
};

struct EpiRes {
    static constexpr bool PERM = false, AFTER_DRAIN = false;
    const float* xin; float* xout; bf16_t* xb; float* ssq;
    __device__ __forceinline__ void operator()(const f32x4 (&acc)[2][2][4][2], const Unit& u, int wr, int wc, int fr, int fq) const {
        const int row0 = u.pm * BM + wr * 64 + fr; const int col0 = u.pn * BM + wc * 32 + 4 * fq;
#pragma unroll
        for (int ai = 0; ai < 2; ++ai)
#pragma unroll
            for (int m = 0; m < 4; ++m) {
                const int row = row0 + ai * HALF + m * 16; const size_t off = (size_t)row * 1024 + col0; float s = 0.f;
#pragma unroll
                for (int bj = 0; bj < 2; ++bj)
#pragma unroll
                    for (int n = 0; n < 2; ++n) {
                        const f32x4 xv = *(const f32x4*)(xin + off + bj * HALF + n * 16); const f32x4 o = xv + acc[ai][bj][m][n];
                        *(f32x4*)(xout + off + bj * HALF + n * 16) = o; s += (o[0] * o[0] + o[1] * o[1]) + (o[2] * o[2] + o[3] * o[3]);
                        if (xb) { u32x2 w; w.x = cvt_pk_bf16(o[0], o[1]); w.y = cvt_pk_bf16(o[2], o[3]); *(u32x2*)(xb + off + bj * HALF + n * 16) = w; }
                    }
                s += __shfl_xor(s, 16); s += __shfl_xor(s, 32);
                if (fq == 0) atomicAdd(ssq + row, s);
                if (m & 1) asm volatile("" ::: "memory");
            }
    }
};

template <class Epi, class Sched, bool ALIGN_EPI = false, bool SP2 = false>
__device__ __forceinline__ void gemm_phase(PG8_LAS unsigned char* lds, const Gemm g, const Sched& S, const Epi& E) {
    const int tid = threadIdx.x, wid = __builtin_amdgcn_readfirstlane(tid >> 6), lane = tid & 63, wr = wid >> 2, wc = wid & 3, fr = lane & 15, fq = lane >> 4;
    const int K = g.K, nt = K / BK;
    unsigned voffA[2], voffB[2];
#pragma unroll
    for (int i = 0; i < 2; ++i) { int R, C; stage_rc(tid * 16 + i * 8192, R, C); const int Rb = Epi::PERM ? ((R & ~31) + perm32(R & 31)) : R;
        voffA[i] = (unsigned)(R * K + C) * 2u; voffB[i] = (unsigned)(Rb * K + C) * 2u; }
    const size_t kstep = (size_t)(BK * 2);
    const size_t hstep = (size_t)HALF * K * 2;
    const size_t tstep = 2 * hstep;
    const unsigned ldsw = (unsigned)wid * 1024u;
    const int aoff = lds_byte(wr * 64 + fr, fq * 8), boff = lds_byte(wc * 32 + fr, fq * 8);
#define PG8_SA(b, h) (((b) * 2 + (h)) * HTB)
#define PG8_SB(b, h) ((4 + (b) * 2 + (h)) * HTB)
#define PG8_STAGE(bufoff, gbase, voff) do { _Pragma("unroll") for (int _i = 0; _i < 2; ++_i) \
        __builtin_amdgcn_global_load_lds((const unsigned*)((const char*)(gbase) + (voff)[_i]), (PG8_LAS unsigned*)(lds + (bufoff) + ldsw + _i * 8192), 16, 0, 0); } while (0)
#define PG8_LDA(dst, b, h) do { _Pragma("unroll") for (int m = 0; m < 4; ++m) _Pragma("unroll") for (int k = 0; k < 2; ++k) dst[m][k] = *(const PG8_LAS bf16x8*)(lds + PG8_SA(b, h) + aoff + m * 2048 + k * 1024); } while (0)
#define PG8_LDB(dst, b, h) do { _Pragma("unroll") for (int n = 0; n < 2; ++n) _Pragma("unroll") for (int k = 0; k < 2; ++k) dst[n][k] = *(const PG8_LAS bf16x8*)(lds + PG8_SB(b, h) + boff + n * 2048 + k * 1024); } while (0)
#define PG8_MMA(ai, bj, At, Bt) do { __builtin_amdgcn_s_setprio(1); _Pragma("unroll") for (int m = 0; m < 4; ++m) _Pragma("unroll") for (int n = 0; n < 2; ++n) _Pragma("unroll") for (int k = 0; k < 2; ++k) \
        acc[ai][bj][m][n] = __builtin_amdgcn_mfma_f32_16x16x32_bf16(Bt[n][k], At[m][k], acc[ai][bj][m][n], 0, 0, 0); __builtin_amdgcn_s_setprio(0); } while (0)
#define PG8_WAIT_V(n) asm volatile("s_waitcnt vmcnt(" #n ")" ::: "memory")
#define PG8_WAIT_L(n) asm volatile("s_waitcnt lgkmcnt(" #n ")" ::: "memory")
#define PG8_BAR __builtin_amdgcn_s_barrier()
#define PG8_SCHED __builtin_amdgcn_sched_barrier(0)
    Unit cur, nxt; int ui = 0;
    if (!S.next(0, cur)) return;
    f32x4 acc[2][2][4][2];
#pragma unroll
    for (int a = 0; a < 2; ++a)
#pragma unroll
        for (int b = 0; b < 2; ++b)
#pragma unroll
            for (int m = 0; m < 4; ++m)
#pragma unroll
                for (int n = 0; n < 2; ++n) acc[a][b][m][n] = (f32x4){0.f, 0.f, 0.f, 0.f};
    bf16x8 At[4][2], B0[2][2], B1[2][2];
    const char* cA = (const char*)g.A + (size_t)cur.pm * tstep; const char* cB = (const char*)g.Bt + (size_t)cur.pn * tstep;
    S.a_ready(cur);
    if constexpr (SP2) {
        PG8_STAGE(PG8_SB(0, 0), cB, voffB); PG8_STAGE(PG8_SB(0, 1), cB + hstep, voffB); PG8_STAGE(PG8_SA(0, 0), cA, voffA); PG8_STAGE(PG8_SA(0, 1), cA + hstep, voffA);
        if (wr == 1) PG8_BAR;
        PG8_WAIT_V(2); PG8_BAR;
        PG8_STAGE(PG8_SB(1, 0), cB + kstep, voffB); PG8_STAGE(PG8_SA(1, 0), cA + kstep, voffA); PG8_STAGE(PG8_SB(1, 1), cB + hstep + kstep, voffB);
        PG8_WAIT_V(6); PG8_BAR;
    } else {
        PG8_STAGE(PG8_SB(0, 0), cB, voffB); PG8_STAGE(PG8_SA(0, 0), cA, voffA); PG8_STAGE(PG8_SB(0, 1), cB + hstep, voffB); PG8_STAGE(PG8_SA(0, 1), cA + hstep, voffA);
        if (wr == 1) PG8_BAR;
        PG8_WAIT_V(4); PG8_BAR;
        PG8_STAGE(PG8_SB(1, 0), cB + kstep, voffB); PG8_STAGE(PG8_SA(1, 0), cA + kstep, voffA); PG8_STAGE(PG8_SB(1, 1), cB + hstep + kstep, voffB);
        PG8_WAIT_V(6); PG8_BAR;
    }
    for (;;) {
        const bool has_next = S.next(ui + 1, nxt);
        const char* nA = has_next ? (const char*)g.A + (size_t)nxt.pm * tstep : cA; const char* nB = has_next ? (const char*)g.Bt + (size_t)nxt.pn * tstep : cB;
        for (int t = 0; t < nt; t += 2) {
            const bool last = (t == nt - 2);
            const char* a1 = cA + (size_t)(t + 1) * kstep;
            const char* a2 = last ? nA : cA + (size_t)(t + 2) * kstep; const char* b2 = last ? nB : cB + (size_t)(t + 2) * kstep;
            const char* a3 = a2 + kstep; const char* b3 = b2 + kstep;
            if (last && has_next) S.a_ready(nxt);
            if constexpr (SP2) {
            PG8_LDB(B0, 0, 0); PG8_LDB(B1, 0, 1); PG8_SCHED; PG8_LDA(At, 0, 0); PG8_STAGE(PG8_SA(1, 1), a1 + hstep, voffA);
            PG8_WAIT_V(8); PG8_WAIT_L(0); PG8_BAR; PG8_MMA(0, 0, At, B0); PG8_MMA(0, 1, At, B1); PG8_BAR; PG8_SCHED;
            PG8_LDA(At, 0, 1); PG8_STAGE(PG8_SB(0, 0), b2, voffB); PG8_STAGE(PG8_SB(0, 1), b2 + hstep, voffB); PG8_STAGE(PG8_SA(0, 0), a2, voffA);
            PG8_WAIT_V(8); PG8_WAIT_L(0); PG8_BAR; PG8_MMA(1, 0, At, B0); PG8_MMA(1, 1, At, B1); PG8_BAR; PG8_SCHED;
            PG8_LDB(B0, 1, 0); PG8_LDB(B1, 1, 1); PG8_SCHED; PG8_LDA(At, 1, 0); PG8_STAGE(PG8_SA(0, 1), a2 + hstep, voffA);
            PG8_WAIT_V(8); PG8_WAIT_L(0); PG8_BAR; PG8_MMA(0, 0, At, B0); PG8_MMA(0, 1, At, B1); PG8_BAR; PG8_SCHED;
            PG8_LDA(At, 1, 1); PG8_STAGE(PG8_SB(1, 0), b3, voffB); PG8_STAGE(PG8_SB(1, 1), b3 + hstep, voffB); PG8_STAGE(PG8_SA(1, 0), a3, voffA);
            PG8_WAIT_V(8); PG8_WAIT_L(0); PG8_BAR; PG8_MMA(1, 0, At, B0); PG8_MMA(1, 1, At, B1); PG8_BAR; PG8_SCHED;
            } else {
            PG8_LDB(B0, 0, 0); PG8_SCHED; PG8_LDA(At, 0, 0); PG8_STAGE(PG8_SA(1, 1), a1 + hstep, voffA);
            PG8_WAIT_L(8); PG8_BAR; PG8_WAIT_L(0); PG8_MMA(0, 0, At, B0); PG8_BAR; PG8_SCHED;
            PG8_LDB(B1, 0, 1); PG8_STAGE(PG8_SB(0, 0), b2, voffB);
            PG8_BAR; PG8_WAIT_L(0); PG8_MMA(0, 1, At, B1); PG8_BAR;
            PG8_LDA(At, 0, 1); PG8_STAGE(PG8_SA(0, 0), a2, voffA);
            PG8_BAR; PG8_WAIT_L(0); PG8_MMA(1, 0, At, B0); PG8_BAR; PG8_SCHED;
            PG8_STAGE(PG8_SB(0, 1), b2 + hstep, voffB);
            PG8_WAIT_V(6); PG8_BAR; PG8_MMA(1, 1, At, B1); PG8_BAR;
            PG8_LDB(B0, 1, 0); PG8_SCHED; PG8_LDA(At, 1, 0); PG8_STAGE(PG8_SA(0, 1), a2 + hstep, voffA);
            PG8_WAIT_L(8); PG8_BAR; PG8_WAIT_L(0); PG8_MMA(0, 0, At, B0); PG8_BAR; PG8_SCHED;
            PG8_LDB(B1, 1, 1); PG8_STAGE(PG8_SB(1, 0), b3, voffB);
            PG8_BAR; PG8_WAIT_L(0); PG8_MMA(0, 1, At, B1); PG8_BAR;
            PG8_LDA(At, 1, 1); PG8_STAGE(PG8_SA(1, 0), a3, voffA);
            PG8_BAR; PG8_WAIT_L(0); PG8_MMA(1, 0, At, B0); PG8_BAR; PG8_SCHED;
            PG8_STAGE(PG8_SB(1, 1), b3 + hstep, voffB);
            PG8_WAIT_V(6); PG8_BAR; PG8_MMA(1, 1, At, B1); PG8_BAR;
            }
        }
        if constexpr (ALIGN_EPI) { if (wr == 0) PG8_BAR; }
        if constexpr (!Epi::AFTER_DRAIN) { E(acc, cur, wr, wc, fr, fq); S.done(cur); }
        if (!has_next) break;
#pragma unroll
        for (int a = 0; a < 2; ++a)
#pragma unroll
            for (int b = 0; b < 2; ++b)
#pragma unroll
                for (int m = 0; m < 4; ++m)
#pragma unroll
                    for (int n = 0; n < 2; ++n) acc[a][b][m][n] = (f32x4){0.f, 0.f, 0.f, 0.f};
        cur = nxt; cA = nA; cB = nB; ++ui;
        if constexpr (ALIGN_EPI) { if (wr == 1) PG8_BAR; }
    }
    PG8_WAIT_V(0);
    if constexpr (!ALIGN_EPI) { if (wr == 0) PG8_BAR; }
    PG8_BAR;
#undef PG8_SA
#undef PG8_SB
#undef PG8_STAGE
#undef PG8_LDA
#undef PG8_LDB
#undef PG8_MMA
#undef PG8_WAIT_V
#undef PG8_WAIT_L
#undef PG8_BAR
#undef PG8_SCHED
}
}

namespace att {
#define ATT_LAS __attribute__((address_space(3)))
typedef unsigned short bf16_t;
typedef short bf16x8 __attribute__((ext_vector_type(8)));
typedef short s16x4 __attribute__((ext_vector_type(4)));
typedef float f32x16 __attribute__((ext_vector_type(16)));
typedef unsigned u32x4 __attribute__((ext_vector_type(4)));
typedef unsigned u32x2 __attribute__((ext_vector_type(2)));
__device__ __forceinline__ int crow(int r, int hi) { return (r & 3) + 8 * (r >> 2) + 4 * hi; }
__device__ __forceinline__ unsigned swz(int row, int ch) { return (unsigned)(row * 128 + ((ch ^ ((((row >> 1) & 1) << 2) | ((row >> 2) & 3))) << 4)); }
__device__ __forceinline__ float swap32f(float v) { auto rr = __builtin_amdgcn_permlane32_swap(__float_as_uint(v), __float_as_uint(v), false, false); return (threadIdx.x & 32) ? __uint_as_float(rr[0]) : __uint_as_float(rr[1]); }
__device__ __forceinline__ unsigned pk(float lo, float hi) { unsigned r; asm volatile("v_cvt_pk_bf16_f32 %0, %1, %2" : "=v"(r) : "v"(lo), "v"(hi)); return r; }

template <int W, bool SINK, bool LSEOUT>
__device__ __forceinline__ void unit(ATT_LAS unsigned char* lds, const bf16_t* Qb, const bf16_t* Kb, const bf16_t* Vb, bf16_t* Ob,
                                     size_t rstride, size_t ostride, int L, int q0, const float* sink, float* lse, size_t lstride) {
    constexpr int NK = 64 + 2 * W, NCH = NK * 8, PER = NCH / 512, NT = 2 * W / 32 + 1, VOFF = NK * 128;
    static_assert(NCH % 512 == 0, "staging split");
    const int tid = threadIdx.x, lane = tid & 63, r32 = lane & 31, hi = lane >> 5, wid = __builtin_amdgcn_readfirstlane(tid >> 6), h = wid & 3, sb = wid >> 2;
    {
        u32x4 kreg[PER], vreg[PER];
#pragma unroll
        for (int i = 0; i < PER; ++i) { const int cid = tid + 512 * i, row = cid >> 3, ch = cid & 7, kp = q0 - W + row;
            kreg[i] = (u32x4){0u, 0u, 0u, 0u}; vreg[i] = (u32x4){0u, 0u, 0u, 0u};
            if (kp >= 0 && kp < L) { kreg[i] = *(const u32x4*)(Kb + (size_t)kp * rstride + ch * 8); vreg[i] = *(const u32x4*)(Vb + (size_t)kp * rstride + ch * 8); } }
#pragma unroll
        for (int i = 0; i < PER; ++i) { const int cid = tid + 512 * i, row = cid >> 3, ch = cid & 7; const unsigned o = swz(row, ch);
            *(ATT_LAS u32x4*)(lds + o) = kreg[i]; *(ATT_LAS u32x4*)(lds + VOFF + o) = vreg[i]; }
    }
    const int qrow = q0 + 32 * sb + r32;
    const bf16_t* qp = Qb + (size_t)qrow * rstride + h * 64 + 8 * hi;
    bf16x8 qf[4];
#pragma unroll
    for (int d0 = 0; d0 < 4; ++d0) qf[d0] = *(const bf16x8*)(qp + 16 * d0);
    float m = -1e30f, l = 0.f;
    if (SINK) { m = sink[h] * 1.4426950408889634f; l = hi == 0 ? 1.f : 0.f; }
    f32x16 o0 = {}, o1 = {};
    const int qq = (lane & 15) >> 2, p = lane & 3, blk = (lane >> 4) & 1;
    const int fk = (((r32 >> 1) & 1) << 2) | ((r32 >> 2) & 3);
    unsigned kaddr[4];
#pragma unroll
    for (int d0 = 0; d0 < 4; ++d0) kaddr[d0] = (unsigned)(r32 * 128 + (((2 * d0 + hi) ^ fk) << 4));
    unsigned vaddr[2][2];
#pragma unroll
    for (int c = 0; c < 2; ++c)
#pragma unroll
        for (int hf = 0; hf < 2; ++hf) { const int fv = ((qq >> 1) << 2) | ((2 * hf + hi) & 3);
            vaddr[c][hf] = (unsigned)(VOFF + (8 * hf + 4 * hi + qq) * 128 + (((4 * c + 2 * blk + (p >> 1)) ^ fv) << 4) + 8 * (p & 1)); }
    __syncthreads();
    const float NEG = -INFINITY;
    for (int j = 0; j < NT; ++j) {
        const int lo = q0 - W + 32 * sb + 32 * j;
        if (lo < 0 || lo >= L) continue;
        const unsigned rb = (unsigned)((32 * sb + 32 * j) * 128);
        f32x16 S = {};
#pragma unroll
        for (int d0 = 0; d0 < 4; ++d0) { const bf16x8 kf = *(const ATT_LAS bf16x8*)(lds + rb + kaddr[d0]); S = __builtin_amdgcn_mfma_f32_32x32x16_bf16(kf, qf[d0], S, 0, 0, 0); }
        if (j == 0) {
#pragma unroll
            for (int r = 0; r < 16; ++r) if (crow(r, hi) < r32) S[r] = NEG; }
        if (j == NT - 1) {
#pragma unroll
            for (int r = 0; r < 16; ++r) if (crow(r, hi) > r32) S[r] = NEG; }
        float mx = S[0];
#pragma unroll
        for (int r = 1; r < 16; ++r) mx = fmaxf(mx, S[r]);
        mx = fmaxf(mx, swap32f(mx));
        const float mn = fmaxf(m, mx), alpha = __builtin_amdgcn_exp2f(m - mn); m = mn;
        float ls = 0.f;
#pragma unroll
        for (int r = 0; r < 16; ++r) { S[r] = __builtin_amdgcn_exp2f(S[r] - mn); ls += S[r]; }
        l = l * alpha + ls;
#pragma unroll
        for (int r = 0; r < 16; ++r) { o0[r] *= alpha; o1[r] *= alpha; }
        u32x4 pw0, pw1;
        pw0.x = pk(S[0], S[1]); pw0.y = pk(S[2], S[3]); pw0.z = pk(S[4], S[5]); pw0.w = pk(S[6], S[7]);
        pw1.x = pk(S[8], S[9]); pw1.y = pk(S[10], S[11]); pw1.z = pk(S[12], S[13]); pw1.w = pk(S[14], S[15]);
        const bf16x8 pa0 = __builtin_bit_cast(bf16x8, pw0), pa1 = __builtin_bit_cast(bf16x8, pw1);
#pragma unroll
        for (int s = 0; s < 2; ++s) {
            const bf16x8 pa = s ? pa1 : pa0;
#pragma unroll
            for (int c = 0; c < 2; ++c) {
                const s16x4 v0 = __builtin_bit_cast(s16x4, __builtin_amdgcn_ds_read_tr16_b64_v4i16((ATT_LAS s16x4*)(lds + rb + s * 2048 + vaddr[c][0])));
                const s16x4 v1 = __builtin_bit_cast(s16x4, __builtin_amdgcn_ds_read_tr16_b64_v4i16((ATT_LAS s16x4*)(lds + rb + s * 2048 + vaddr[c][1])));
                const bf16x8 vf = (bf16x8){v0[0], v0[1], v0[2], v0[3], v1[0], v1[1], v1[2], v1[3]};
                if (c == 0) o0 = __builtin_amdgcn_mfma_f32_32x32x16_bf16(vf, pa, o0, 0, 0, 0); else o1 = __builtin_amdgcn_mfma_f32_32x32x16_bf16(vf, pa, o1, 0, 0, 0);
            }
        }
    }
    const float lt = l + swap32f(l), inv = 1.0f / lt;
    bf16_t* op = Ob + (size_t)qrow * ostride + h * 64 + 4 * hi;
#pragma unroll
    for (int g = 0; g < 4; ++g) {
        u32x2 w0, w1; w0.x = pk(o0[4 * g] * inv, o0[4 * g + 1] * inv); w0.y = pk(o0[4 * g + 2] * inv, o0[4 * g + 3] * inv);
        w1.x = pk(o1[4 * g] * inv, o1[4 * g + 1] * inv); w1.y = pk(o1[4 * g + 2] * inv, o1[4 * g + 3] * inv);
        *(u32x2*)(op + 8 * g) = w0; *(u32x2*)(op + 32 + 8 * g) = w1; }
    if (LSEOUT) { if (hi == 0) lse[(size_t)qrow * lstride + h] = m + __builtin_amdgcn_logf(lt); }
    __syncthreads();
}
}

#define LAS __attribute__((address_space(3)))
typedef unsigned short bf16;
typedef unsigned v4u __attribute__((ext_vector_type(4)));
typedef float f32x4 __attribute__((ext_vector_type(4)));
constexpr int NWAVES = 8, NTHREADS = 512;
constexpr int BATCH = 32, SEQ = 2048, DM = 1024, T = BATCH * SEQ, DFF = 2816, QKVW = 1536, NH = 16;
constexpr int LDS_BYTES = 135168;
constexpr size_t MiB = 1u << 20;
constexpr size_t WS_WIN0 = 0;
constexpr size_t WS_WOUT0 = WS_WIN0 + (size_t)1536 * 1024 * 2;
constexpr size_t WS_WIN1 = WS_WOUT0 + (size_t)1024 * 1024 * 2;
constexpr size_t WS_WOUT1 = WS_WIN1 + (size_t)4608 * 1024 * 2;
constexpr size_t WS_WGU0 = WS_WOUT1 + (size_t)1024 * 1024 * 2;
constexpr size_t WS_WGU1 = WS_WGU0 + (size_t)5632 * 1024 * 2;
constexpr size_t WS_WD0 = WS_WGU1 + (size_t)5632 * 1024 * 2;
constexpr size_t WS_WD1 = WS_WD0 + (size_t)1024 * 2816 * 2;
constexpr size_t WS_COS = WS_WD1 + (size_t)1024 * 2816 * 2;
constexpr size_t WS_SIN = WS_COS + (size_t)2048 * 32 * 4;
constexpr size_t WS_SSQ = WS_SIN + (size_t)2048 * 32 * 4;
constexpr size_t WS_LSE = WS_SSQ + (size_t)5 * T * 4;
constexpr size_t WS_XB = 64 * MiB;
constexpr size_t WS_O = WS_XB + 128 * MiB;
constexpr size_t WS_BIG = WS_O + 128 * MiB;
constexpr size_t WS_END = WS_BIG + (size_t)T * 4608 * 2;
static_assert(WS_LSE + (size_t)3 * T * 16 * 4 <= WS_XB, "ws map");

__device__ __forceinline__ unsigned f2bf(float f) { unsigned u = __builtin_bit_cast(unsigned, f); return (u + 0x7fffu + ((u >> 16) & 1u)) >> 16; }
__device__ __forceinline__ unsigned pk2(float lo, float hi) { return f2bf(lo) | (f2bf(hi) << 16); }
__device__ __forceinline__ float wave_sum(float v) {
#pragma unroll
    for (int o = 1; o < 64; o <<= 1) v += __shfl_xor(v, o);
    return v;
}
__device__ __forceinline__ void transpose_item(const float* Wa, const float* Wb, int mode, const float* gain, int K, int Nsrc, bf16* WT, int nblk, LAS float* scr, int item, int lane) {
    const int kb = item / nblk, nb = item % nblk, k0 = 64 * kb, n0 = 32 * nb;
    const int np = n0 + (lane & 31); const float* W = Wa; int ncol = np;
    if (mode == 1) { const int grp = np / 1536; int c = np % 1536;
        if (c < 1280) { const int head = c >> 6, pp = c & 63, j = pp >> 3, e = pp & 7; c = head * 64 + (e < 4 ? 4 * j + e : 32 + 4 * j + (e - 4)); }
        ncol = grp * 1536 + c; }
    else if (mode == 2) { const int pn = np >> 8, wi = np & 255; W = (wi >> 7) ? Wb : Wa; ncol = pn * 128 + (wi & 127); }
#pragma unroll 8
    for (int i = 0; i < 32; ++i) { const int kk = 2 * i + (lane >> 5); float v = W[(size_t)(k0 + kk) * Nsrc + ncol]; if (gain) v *= gain[k0 + kk]; scr[kk * 33 + (lane & 31)] = v; }
    asm volatile("s_waitcnt lgkmcnt(0)" ::: "memory");
    const int c = lane & 7;
#pragma unroll
    for (int j = 0; j < 4; ++j) { const int n = (lane >> 3) + 8 * j; const LAS float* s = scr + (8 * c) * 33 + n;
        v4u o; o.x = pk2(s[0 * 33], s[1 * 33]); o.y = pk2(s[2 * 33], s[3 * 33]); o.z = pk2(s[4 * 33], s[5 * 33]); o.w = pk2(s[6 * 33], s[7 * 33]);
        *(v4u*)(WT + (size_t)(n0 + n) * K + k0 + 8 * c) = o; }
    asm volatile("s_waitcnt lgkmcnt(0)" ::: "memory");
}

struct Args {
    const float* x; const float* a_w_in; const float* a_sink; const float* a_w_out; const float* b_w_in; const float* b_w_out;
    const float* norm_mix; const float* norm_ffn; const float* w_gate; const float* w_up; const float* w_down; const float* final_norm;
    float* out; unsigned char* ws; int ph_lo, ph_hi;
};
constexpr int N_PHASES = 13;

__global__ void __launch_bounds__(NTHREADS, 2) mega_fwd(Args a) {
    extern __shared__ __attribute__((aligned(16))) unsigned char lds_raw[];
    LAS unsigned char* lds = (LAS unsigned char*)lds_raw;
    const int tid = threadIdx.x, lane = tid & 63, wave = __builtin_amdgcn_readfirstlane(tid >> 6);
    const int G = gridDim.x, bid = blockIdx.x;
    unsigned char* ws = a.ws;
    bf16* Win0 = (bf16*)(ws + WS_WIN0); bf16* Wout0 = (bf16*)(ws + WS_WOUT0); bf16* Win1 = (bf16*)(ws + WS_WIN1); bf16* Wout1 = (bf16*)(ws + WS_WOUT1);
    bf16* Wgu0 = (bf16*)(ws + WS_WGU0); bf16* Wgu1 = (bf16*)(ws + WS_WGU1); bf16* Wd0 = (bf16*)(ws + WS_WD0); bf16* Wd1 = (bf16*)(ws + WS_WD1);
    float* cosT = (float*)(ws + WS_COS); float* sinT = (float*)(ws + WS_SIN); float* ssq = (float*)(ws + WS_SSQ); float* lse = (float*)(ws + WS_LSE);
    bf16* XB = (bf16*)(ws + WS_XB); bf16* OB = (bf16*)(ws + WS_O); bf16* BIG = (bf16*)(ws + WS_BIG);
    float* X = a.out;
    const int lo = a.ph_lo, hi_ph = a.ph_hi;
#define IN(k) (lo <= (k) && (k) < hi_ph)
#define SEAM(k) do { if (IN(k) && IN((k) + 1)) { cg::this_grid().sync(); } } while (0)

    if (IN(0)) {
        LAS float* scr = (LAS float*)(lds + wave * 16384);
        const int gw = bid * NWAVES + wave, NGW = G * NWAVES;
        constexpr int I_IN0 = 16 * 48, I_OUT = 16 * 32, I_IN1 = 16 * 144, I_GU = 16 * 176, I_D = 44 * 32;
        constexpr int NITEMS = I_IN0 + 2 * I_OUT + I_IN1 + 2 * I_GU + 2 * I_D;
        for (int it = gw; it < NITEMS; it += NGW) {
            int r = it;
            if (r < I_IN0) { transpose_item(a.a_w_in, nullptr, 1, a.norm_mix, 1024, 1536, Win0, 48, scr, r, lane); continue; } r -= I_IN0;
            if (r < I_OUT) { transpose_item(a.a_w_out, nullptr, 0, nullptr, 1024, 1024, Wout0, 32, scr, r, lane); continue; } r -= I_OUT;
            if (r < I_IN1) { transpose_item(a.b_w_in, nullptr, 1, a.norm_mix + 1024, 1024, 4608, Win1, 144, scr, r, lane); continue; } r -= I_IN1;
            if (r < I_OUT) { transpose_item(a.b_w_out, nullptr, 0, nullptr, 1024, 1024, Wout1, 32, scr, r, lane); continue; } r -= I_OUT;
            if (r < I_GU) { transpose_item(a.w_gate, a.w_up, 2, a.norm_ffn, 1024, 2816, Wgu0, 176, scr, r, lane); continue; } r -= I_GU;
            if (r < I_GU) { transpose_item(a.w_gate + (size_t)1024 * 2816, a.w_up + (size_t)1024 * 2816, 2, a.norm_ffn + 1024, 1024, 2816, Wgu1, 176, scr, r, lane); continue; } r -= I_GU;
            if (r < I_D) { transpose_item(a.w_down, nullptr, 0, nullptr, 2816, 1024, Wd0, 32, scr, r, lane); continue; } r -= I_D;
            transpose_item(a.w_down + (size_t)2816 * 1024, nullptr, 0, nullptr, 2816, 1024, Wd1, 32, scr, r, lane);
        }
        const int gt = bid * NTHREADS + tid, NGT = G * NTHREADS;
        for (int i = gt; i < 2048 * 32; i += NGT) {
            const int t = i >> 5, f = i & 31; double inv = 1.0; for (int k = 0; k < f; ++k) inv *= 0.74989420933245583;
            double rev = (double)t * inv * 0.15915494309189535; rev = rev - __builtin_floor(rev); const float fr = (float)rev;
            cosT[i] = __builtin_amdgcn_cosf(fr); sinT[i] = __builtin_amdgcn_sinf(fr);
        }
        for (int i = gt; i < 4 * T; i += NGT) ssq[T + i] = 0.f;
        for (int row = gw; row < T; row += NGW) {
            const f32x4* xr = (const f32x4*)(a.x + (size_t)row * DM) + lane; f32x4 v[4]; float s = 0.f;
#pragma unroll
            for (int j = 0; j < 4; ++j) { v[j] = xr[64 * j]; s += (v[j].x * v[j].x + v[j].y * v[j].y) + (v[j].z * v[j].z + v[j].w * v[j].w); }
            s = wave_sum(s); if (lane == 0) ssq[row] = s;
            unsigned long long* o8 = (unsigned long long*)(XB + (size_t)row * DM) + lane;
#pragma unroll
            for (int j = 0; j < 4; ++j) o8[64 * j] = (unsigned long long)pk2(v[j].x, v[j].y) | ((unsigned long long)pk2(v[j].z, v[j].w) << 32);
        }
        __syncthreads();
    }
    SEAM(0);
    if (IN(1)) {
        pg8::Gemm g{XB, Win0, T, QKVW, DM}; pg8::StaticOrder S; S.init(T, QKVW, G, bid);
        pg8::EpiQKV E{BIG, QKVW, ssq, cosT, sinT};
        pg8::gemm_phase<pg8::EpiQKV, pg8::StaticOrder, true, true>(lds, g, S, E);
    }
    SEAM(1);
    if (IN(2)) {
        constexpr int NU = BATCH * 4 * 32; const int per = (NU + G - 1) / G; const int u1 = min(NU, (bid + 1) * per);
        for (int u = bid * per; u < u1; ++u) {
            const int qb = u & 31, kvh = (u >> 5) & 3, b = u >> 7;
            const bf16* base = BIG + (size_t)b * SEQ * QKVW;
            att::unit<128, true, false>(lds, base + kvh * 256, base + 1024 + kvh * 64, base + 1280 + kvh * 64, OB + (size_t)b * SEQ * DM + kvh * 256,
                                        (size_t)QKVW, (size_t)DM, SEQ, qb * 64, a.a_sink + kvh * 4, nullptr, 0);
        }
    }
    SEAM(2);
    if (IN(3)) {
        pg8::Gemm g{OB, Wout0, T, DM, DM}; pg8::StaticOrder S; S.init(T, DM, G, bid);
        pg8::EpiRes E{a.x, X, XB, ssq + T};
        pg8::gemm_phase<pg8::EpiRes, pg8::StaticOrder, true, true>(lds, g, S, E);
    }
    SEAM(3);
    if (IN(4)) {
        pg8::Gemm g{XB, Wgu0, T, 2 * DFF, DM}; pg8::StaticOrder S; S.init(T, 2 * DFF, G, bid);
        pg8::EpiSwiGLU E{BIG, DFF, ssq + T};
        pg8::gemm_phase<pg8::EpiSwiGLU, pg8::StaticOrder, true, true>(lds, g, S, E);
    }
    SEAM(4);
    if (IN(5)) {
        pg8::Gemm g{BIG, Wd0, T, DM, DFF}; pg8::StaticOrder S; S.init(T, DM, G, bid);
        pg8::EpiRes E{X, X, XB, ssq + 2 * T};
        pg8::gemm_phase<pg8::EpiRes, pg8::StaticOrder, true, true>(lds, g, S, E);
    }
    SEAM(5);
    if (IN(6)) {
        pg8::Gemm g{XB, Win1, T, 3 * QKVW, DM}; pg8::StaticOrder S; S.init(T, 3 * QKVW, G, bid);
        pg8::EpiQKV E{BIG, 3 * QKVW, ssq + 2 * T, cosT, sinT};
        pg8::gemm_phase<pg8::EpiQKV, pg8::StaticOrder, true, true>(lds, g, S, E);
    }
    SEAM(6);
    if (IN(7)) {
        constexpr int NU = 3 * BATCH * 4 * 32; const int per = (NU + G - 1) / G; const int u1 = min(NU, (bid + 1) * per);
        for (int u = bid * per; u < u1; ++u) {
            const int gidx = u >> 12, v = u & 4095, qa = v & 31, kvh = (v >> 5) & 3, b = v >> 7;
            const int dsh = 2 * gidx, dil = 1 << dsh, nbk = 32 >> dsh, r = qa / nbk, qb = qa % nbk;
            bf16* base = BIG + ((size_t)b * SEQ + r) * (3 * QKVW) + gidx * QKVW;
            att::unit<64, false, true>(lds, base + kvh * 256, base + 1024 + kvh * 64, base + 1280 + kvh * 64, base + kvh * 256,
                                       (size_t)dil * 3 * QKVW, (size_t)dil * 3 * QKVW, SEQ >> dsh, qb * 64, nullptr,
                                       lse + ((size_t)gidx * T + (size_t)b * SEQ + r) * NH + kvh * 4, (size_t)dil * NH);
        }
    }
    SEAM(7);
    if (IN(8)) {
        const int gt = bid * NTHREADS + tid, NGT = G * NTHREADS;
        for (int i = gt; i < T * 128; i += NGT) {
            const int tok = i >> 7, ch = i & 127, head = ch >> 3;
            const float l0 = lse[(size_t)tok * NH + head], l1 = lse[((size_t)T + tok) * NH + head], l2 = lse[((size_t)2 * T + tok) * NH + head];
            const float mx = fmaxf(l0, fmaxf(l1, l2)); float w0 = __builtin_amdgcn_exp2f(l0 - mx), w1 = __builtin_amdgcn_exp2f(l1 - mx), w2 = __builtin_amdgcn_exp2f(l2 - mx);
            const float inv = 1.0f / (w0 + w1 + w2); w0 *= inv; w1 *= inv; w2 *= inv;
            const bf16* src = BIG + (size_t)tok * (3 * QKVW) + ch * 8;
            const v4u a0 = *(const v4u*)src, a1 = *(const v4u*)(src + QKVW), a2 = *(const v4u*)(src + 2 * QKVW);
            v4u o;
#pragma unroll
            for (int e = 0; e < 4; ++e) {
                const float x0 = __uint_as_float(a0[e] << 16), y0 = __uint_as_float(a0[e] & 0xffff0000u);
                const float x1 = __uint_as_float(a1[e] << 16), y1 = __uint_as_float(a1[e] & 0xffff0000u);
                const float x2 = __uint_as_float(a2[e] << 16), y2 = __uint_as_float(a2[e] & 0xffff0000u);
                o[e] = pk2(w0 * x0 + w1 * x1 + w2 * x2, w0 * y0 + w1 * y1 + w2 * y2);
            }
            *(v4u*)(OB + (size_t)tok * DM + ch * 8) = o;
        }
    }
    SEAM(8);
    if (IN(9)) {
        pg8::Gemm g{OB, Wout1, T, DM, DM}; pg8::StaticOrder S; S.init(T, DM, G, bid);
        pg8::EpiRes E{X, X, XB, ssq + 3 * T};
        pg8::gemm_phase<pg8::EpiRes, pg8::StaticOrder, true, true>(lds, g, S, E);
    }
    SEAM(9);
    if (IN(10)) {
        pg8::Gemm g{XB, Wgu1, T, 2 * DFF, DM}; pg8::StaticOrder S; S.init(T, 2 * DFF, G, bid);
        pg8::EpiSwiGLU E{BIG, DFF, ssq + 3 * T};
        pg8::gemm_phase<pg8::EpiSwiGLU, pg8::StaticOrder, true, true>(lds, g, S, E);
    }
    SEAM(10);
    if (IN(11)) {
        pg8::Gemm g{BIG, Wd1, T, DM, DFF}; pg8::StaticOrder S; S.init(T, DM, G, bid);
        pg8::EpiRes E{X, X, nullptr, ssq + 4 * T};
        pg8::gemm_phase<pg8::EpiRes, pg8::StaticOrder, true, true>(lds, g, S, E);
    }
    SEAM(11);
    if (IN(12)) {
        const int gw = bid * NWAVES + wave, NGW = G * NWAVES;
        const f32x4* gn = (const f32x4*)a.final_norm + lane; f32x4 gv[4];
#pragma unroll
        for (int j = 0; j < 4; ++j) gv[j] = gn[64 * j];
        for (int row = gw; row < T; row += NGW) {
            const float rstd = __builtin_amdgcn_rsqf(ssq[4 * T + row] * (1.0f / 1024.0f) + pg8::RMS_EPS);
            f32x4* xr = (f32x4*)(X + (size_t)row * DM) + lane;
#pragma unroll
            for (int j = 0; j < 4; ++j) { f32x4 v = xr[64 * j]; v = v * rstd * gv[j]; xr[64 * j] = v; }
        }
    }
#undef IN
#undef SEAM
}

extern "C" void kernel_launch(void* const* d_in, const int* in_sizes, int n_in, void* d_out, int out_size, void* d_ws, size_t ws_size, hipStream_t stream) {
    static int grid = 0;
    if (grid == 0) {
        if (n_in != 12 || in_sizes[0] != T * DM || out_size != T * DM || ws_size < WS_END) {
            fprintf(stderr, "kernel_launch: unexpected shapes (n_in %d, in0 %d, out %d, ws %zu, need %zu)\n", n_in, n_in > 0 ? in_sizes[0] : -1, out_size, ws_size, (size_t)WS_END); grid = -1; return; }
        int dev = 0, cus = 0, per_cu = 0;
        hipGetDevice(&dev); hipDeviceGetAttribute(&cus, hipDeviceAttributeMultiprocessorCount, dev);
        if (hipFuncSetAttribute((const void*)mega_fwd, hipFuncAttributeMaxDynamicSharedMemorySize, LDS_BYTES) != hipSuccess) { fprintf(stderr, "kernel_launch: hipFuncSetAttribute failed\n"); grid = -1; return; }
        if (hipOccupancyMaxActiveBlocksPerMultiprocessor(&per_cu, (const void*)mega_fwd, NTHREADS, LDS_BYTES) != hipSuccess || per_cu < 1) { fprintf(stderr, "kernel_launch: occupancy query gave %d\n", per_cu); per_cu = 1; }
        (void)hipGetLastError();
        grid = cus * per_cu;
    }
    if (grid < 0) return;
    Args a{};
    a.x = (const float*)d_in[0]; a.a_w_in = (const float*)d_in[1]; a.a_sink = (const float*)d_in[2]; a.a_w_out = (const float*)d_in[3];
    a.b_w_in = (const float*)d_in[4]; a.b_w_out = (const float*)d_in[5]; a.norm_mix = (const float*)d_in[6]; a.norm_ffn = (const float*)d_in[7];
    a.w_gate = (const float*)d_in[8]; a.w_up = (const float*)d_in[9]; a.w_down = (const float*)d_in[10]; a.final_norm = (const float*)d_in[11];
    a.out = (float*)d_out; a.ws = (unsigned char*)d_ws;
#if MK_N_LAUNCHES == 1
    a.ph_lo = 0; a.ph_hi = N_PHASES;
    void* args[] = {&a};
    hipError_t e = hipLaunchCooperativeKernel((const void*)mega_fwd, dim3(grid), dim3(NTHREADS), args, LDS_BYTES, stream);
    if (e != hipSuccess) fprintf(stderr, "cooperative launch failed: %s (grid %d)\n", hipGetErrorString(e), grid);
#else
    for (int p = 0; p < N_PHASES; ++p) { a.ph_lo = p; a.ph_hi = p + 1; hipLaunchKernelGGL(mega_fwd, dim3(grid), dim3(NTHREADS), LDS_BYTES, stream, a); }
#endif
}
```

```cpp
#include <hip/hip_runtime.h>
#include <hip/hip_cooperative_groups.h>
#include <cstdio>
#include <cstdint>
namespace cg = cooperative_groups;

#ifndef PROBE_DUP
#define PROBE_DUP -1
#endif
#ifndef MK_N_LAUNCHES
#define MK_N_LAUNCHES 1
#endif

namespace pg8 {
#define PG8_LAS __attribute__((address_space(3)))
typedef unsigned short bf16_t;
typedef short bf16x8 __attribute__((ext_vector_type(8)));
typedef float f32x4 __attribute__((ext_vector_type(4)));
typedef unsigned u32x4 __attribute__((ext_vector_type(4)));
typedef unsigned u32x2 __attribute__((ext_vector_type(2)));
constexpr int BM = 256, BK = 64, HALF = 128, HTB = HALF * BK * 2, STAGE_BYTES = 8 * HTB, NXCD = 8, WGM = 8;

__host__ __device__ __forceinline__ int lds_byte(int r, int c) { const int st = (r >> 4) * 2 + (c >> 5), rr = r & 15, cc = c & 31, ob = rr * 64 + cc * 2; return st * 1024 + (ob ^ (((ob >> 9) & 1) << 5)); }
__host__ __device__ __forceinline__ void stage_rc(int b, int& R, int& C) { const int st = b / 1024, sb = b % 1024, swz = sb ^ (((sb >> 9) & 1) << 5); R = (st >> 1) * 16 + swz / 64; C = (st & 1) * 32 + (swz % 64) / 2; }
__host__ __device__ __forceinline__ int perm32(int rho) { const int n = rho >> 4, i = rho & 15; return 8 * (i >> 2) + 4 * n + (i & 3); }

struct Unit { int pm, pn; };
struct Gemm { const bf16_t* A; const bf16_t* Bt; int M, N, K; };

struct StaticOrder {
    int nM, nN, nwg, G, c;
    __host__ __device__ void init(int M, int N, int G_, int c_) { nM = M / BM; nN = N / BM; nwg = nM * nN; G = G_; c = c_; }
    __host__ __device__ bool next(int i, Unit& u) const {
        const long L = (long)i * G + c; if (L >= nwg) return false;
        int wgid = (int)L; { const int q = nwg / NXCD, r = nwg % NXCD, xcd = wgid % NXCD, off = wgid / NXCD; wgid = (xcd < r ? xcd * (q + 1) : r * (q + 1) + (xcd - r) * q) + off; }
        const int nig = WGM * nN, gid = wgid / nig, fm = gid * WGM, gsz = (nM - fm) < WGM ? (nM - fm) : WGM;
        u.pm = fm + ((wgid % nig) % gsz); u.pn = (wgid % nig) / gsz; return true;
    }
    __device__ __forceinline__ void a_ready(const Unit&) const {}
    __device__ __forceinline__ void done(const Unit&) const {}
};

__device__ __forceinline__ unsigned cvt_pk_bf16(float lo, float hi) { unsigned r; asm volatile("v_cvt_pk_bf16_f32 %0, %1, %2" : "=v"(r) : "v"(lo), "v"(hi)); return r; }

constexpr float RMS_EPS = 1e-6f;
constexpr float QSCALE = 0.125f * 1.4426950408889634f;


struct EpiQKV {
    static constexpr bool PERM = true, AFTER_DRAIN = false;
    bf16_t* O; int ldc; const float* ssq; const float* cosT; const float* sinT;
    __device__ __forceinline__ void operator()(const f32x4 (&acc)[2][2][4][2], const Unit& u, int wr, int wc, int fr, int fq) const {
        const int row0 = u.pm * BM + wr * 64 + fr; const int t6 = u.pn % 6;
        const int col0 = u.pn * BM + wc * 32 + 8 * fq; const int fi = 16 * (wc & 1) + 4 * fq;
        const float qs = t6 < 4 ? QSCALE : 1.0f; const bool rope = t6 < 5;
#pragma unroll
        for (int ai = 0; ai < 2; ++ai)
#pragma unroll
            for (int m = 0; m < 4; ++m) {
                const int row = row0 + ai * HALF + m * 16; const int t = row & 2047;
                const float rstd = __builtin_amdgcn_rsqf(ssq[row] * (1.0f / 1024.0f) + RMS_EPS);
                f32x4 cs = (f32x4){1.f, 1.f, 1.f, 1.f}, sn = (f32x4){0.f, 0.f, 0.f, 0.f};
                if (rope) { cs = *(const f32x4*)(cosT + t * 32 + fi); sn = *(const f32x4*)(sinT + t * 32 + fi); }
                const float s1 = rstd * qs; cs = cs * s1; sn = sn * s1;
                bf16_t* rowp = O + (size_t)row * ldc + col0;
#pragma unroll
                for (int bj = 0; bj < 2; ++bj) {
                    const f32x4 v0 = acc[ai][bj][m][0], v1 = acc[ai][bj][m][1];
                    const f32x4 o0 = v0 * cs - v1 * sn, o1 = v1 * cs + v0 * sn;
                    u32x4 w; w.x = cvt_pk_bf16(o0[0], o0[1]); w.y = cvt_pk_bf16(o0[2], o0[3]); w.z = cvt_pk_bf16(o1[0], o1[1]); w.w = cvt_pk_bf16(o1[2], o1[3]);
                    *(u32x4*)(rowp + bj * HALF) = w; }
            }
    }
};

struct EpiSwiGLU {
    static constexpr bool PERM = true, AFTER_DRAIN = false;
    bf16_t* O; int ldc; const float* ssq;
    __device__ __forceinline__ void operator()(const f32x4 (&acc)[2][2][4][2], const Unit& u, int wr, int wc, int fr, int fq) const {
        const int row0 = u.pm * BM + wr * 64 + fr; const int col0 = u.pn * HALF + wc * 32 + 8 * fq;
#pragma unroll
        for (int ai = 0; ai < 2; ++ai)
#pragma unroll
            for (int m = 0; m < 4; ++m) {
                const int row = row0 + ai * HALF + m * 16;
                const float rstd = __builtin_amdgcn_rsqf(ssq[row] * (1.0f / 1024.0f) + RMS_EPS);
                float h[8];
#pragma unroll
                for (int n = 0; n < 2; ++n)
#pragma unroll
                    for (int e = 0; e < 4; ++e) { const float g = acc[ai][0][m][n][e] * rstd, up = acc[ai][1][m][n][e] * rstd;
                        h[n * 4 + e] = g * up * __builtin_amdgcn_rcpf(1.0f + __builtin_amdgcn_exp2f(-1.4426950408889634f * g)); }
                u32x4 w; w.x = cvt_pk_bf16(h[0], h[1]); w.y = cvt_pk_bf16(h[2], h[3]); w.z = cvt_pk_bf16(h[4], h[5]); w.w = cvt_pk_bf16(h[6], h[7]);
                *(u32x4*)(O + (size_t)row * ldc + col0) = w;
            }
    }
};

struct EpiRes {
    static constexpr bool PERM = true, AFTER_DRAIN = false;
    bf16_t* xb; float* ssq;
    __device__ __forceinline__ void operator()(const f32x4 (&acc)[2][2][4][2], const Unit& u, int wr, int wc, int fr, int fq) const {
        const int row0 = u.pm * BM + wr * 64 + fr; const int col0 = u.pn * BM + wc * 32 + 8 * fq;
#pragma unroll
        for (int ai = 0; ai < 2; ++ai)
#pragma unroll
            for (int m = 0; m < 4; ++m) {
                const int row = row0 + ai * HALF + m * 16; bf16_t* rowp = xb + (size_t)row * 1024 + col0; float s = 0.f;
                u32x4 xv[2];
#pragma unroll
                for (int bj = 0; bj < 2; ++bj) xv[bj] = *(const u32x4*)(rowp + bj * HALF);
#pragma unroll
                for (int bj = 0; bj < 2; ++bj) {
                    float o[8];
#pragma unroll
                    for (int e = 0; e < 4; ++e) { o[2 * e] = __uint_as_float(xv[bj][e] << 16) + acc[ai][bj][m][e >> 1][(2 * e) & 3]; o[2 * e + 1] = __uint_as_float(xv[bj][e] & 0xffff0000u) + acc[ai][bj][m][e >> 1][(2 * e + 1) & 3]; }
#pragma unroll
                    for (int e = 0; e < 8; ++e) s += o[e] * o[e];
                    u32x4 w; w.x = cvt_pk_bf16(o[0], o[1]); w.y = cvt_pk_bf16(o[2], o[3]); w.z = cvt_pk_bf16(o[4], o[5]); w.w = cvt_pk_bf16(o[6], o[7]);
                    *(u32x4*)(rowp + bj * HALF) = w;
                }
                s += __shfl_xor(s, 16); s += __shfl_xor(s, 32);
                if (fq == 0) atomicAdd(ssq + row, s);
                if (m & 1) asm volatile("" ::: "memory");
            }
    }
};

template <class Epi, class Sched, bool ALIGN_EPI = false, bool SP2 = false>
__device__ __forceinline__ void gemm_phase(PG8_LAS unsigned char* lds, const Gemm g, const Sched& S, const Epi& E) {
    const int tid = threadIdx.x, wid = __builtin_amdgcn_readfirstlane(tid >> 6), lane = tid & 63, wr = wid >> 2, wc = wid & 3, fr = lane & 15, fq = lane >> 4;
    const int K = g.K, nt = K / BK;
    unsigned voffA[2], voffB[2];
#pragma unroll
    for (int i = 0; i < 2; ++i) { int R, C; stage_rc(tid * 16 + i * 8192, R, C); const int Rb = Epi::PERM ? ((R & ~31) + perm32(R & 31)) : R;
        voffA[i] = (unsigned)(R * K + C) * 2u; voffB[i] = (unsigned)(Rb * K + C) * 2u; }
    const size_t kstep = (size_t)(BK * 2);
    const size_t hstep = (size_t)HALF * K * 2;
    const size_t tstep = 2 * hstep;
    const unsigned ldsw = (unsigned)wid * 1024u;
    const int aoff = lds_byte(wr * 64 + fr, fq * 8), boff = lds_byte(wc * 32 + fr, fq * 8);
#define PG8_SA(b, h) (((b) * 2 + (h)) * HTB)
#define PG8_SB(b, h) ((4 + (b) * 2 + (h)) * HTB)
#define PG8_STAGE(bufoff, gbase, voff) do { _Pragma("unroll") for (int _i = 0; _i < 2; ++_i) \
        __builtin_amdgcn_global_load_lds((const unsigned*)((const char*)(gbase) + (voff)[_i]), (PG8_LAS unsigned*)(lds + (bufoff) + ldsw + _i * 8192), 16, 0, 0); } while (0)
#define PG8_LDA(dst, b, h) do { _Pragma("unroll") for (int m = 0; m < 4; ++m) _Pragma("unroll") for (int k = 0; k < 2; ++k) dst[m][k] = *(const PG8_LAS bf16x8*)(lds + PG8_SA(b, h) + aoff + m * 2048 + k * 1024); } while (0)
#define PG8_LDB(dst, b, h) do { _Pragma("unroll") for (int n = 0; n < 2; ++n) _Pragma("unroll") for (int k = 0; k < 2; ++k) dst[n][k] = *(const PG8_LAS bf16x8*)(lds + PG8_SB(b, h) + boff + n * 2048 + k * 1024); } while (0)
#define PG8_MMA(ai, bj, At, Bt) do { __builtin_amdgcn_s_setprio(1); _Pragma("unroll") for (int m = 0; m < 4; ++m) _Pragma("unroll") for (int n = 0; n < 2; ++n) _Pragma("unroll") for (int k = 0; k < 2; ++k) \
        acc[ai][bj][m][n] = __builtin_amdgcn_mfma_f32_16x16x32_bf16(Bt[n][k], At[m][k], acc[ai][bj][m][n], 0, 0, 0); __builtin_amdgcn_s_setprio(0); } while (0)
#define PG8_WAIT_V(n) asm volatile("s_waitcnt vmcnt(" #n ")" ::: "memory")
#define PG8_WAIT_L(n) asm volatile("s_waitcnt lgkmcnt(" #n ")" ::: "memory")
#define PG8_BAR __builtin_amdgcn_s_barrier()
#define PG8_SCHED __builtin_amdgcn_sched_barrier(0)
    Unit cur, nxt; int ui = 0;
    if (!S.next(0, cur)) return;
    f32x4 acc[2][2][4][2];
#pragma unroll
    for (int a = 0; a < 2; ++a)
#pragma unroll
        for (int b = 0; b < 2; ++b)
#pragma unroll
            for (int m = 0; m < 4; ++m)
#pragma unroll
                for (int n = 0; n < 2; ++n) acc[a][b][m][n] = (f32x4){0.f, 0.f, 0.f, 0.f};
    bf16x8 At[4][2], B0[2][2], B1[2][2];
    const char* cA = (const char*)g.A + (size_t)cur.pm * tstep; const char* cB = (const char*)g.Bt + (size_t)cur.pn * tstep;
    S.a_ready(cur);
    if constexpr (SP2) {
        PG8_STAGE(PG8_SB(0, 0), cB, voffB); PG8_STAGE(PG8_SB(0, 1), cB + hstep, voffB); PG8_STAGE(PG8_SA(0, 0), cA, voffA); PG8_STAGE(PG8_SA(0, 1), cA + hstep, voffA);
        if (wr == 1) PG8_BAR;
        PG8_WAIT_V(2); PG8_BAR;
        PG8_STAGE(PG8_SB(1, 0), cB + kstep, voffB); PG8_STAGE(PG8_SA(1, 0), cA + kstep, voffA); PG8_STAGE(PG8_SB(1, 1), cB + hstep + kstep, voffB);
        PG8_WAIT_V(6); PG8_BAR;
    } else {
        PG8_STAGE(PG8_SB(0, 0), cB, voffB); PG8_STAGE(PG8_SA(0, 0), cA, voffA); PG8_STAGE(PG8_SB(0, 1), cB + hstep, voffB); PG8_STAGE(PG8_SA(0, 1), cA + hstep, voffA);
        if (wr == 1) PG8_BAR;
        PG8_WAIT_V(4); PG8_BAR;
        PG8_STAGE(PG8_SB(1, 0), cB + kstep, voffB); PG8_STAGE(PG8_SA(1, 0), cA + kstep, voffA); PG8_STAGE(PG8_SB(1, 1), cB + hstep + kstep, voffB);
        PG8_WAIT_V(6); PG8_BAR;
    }
    for (;;) {
        const bool has_next = S.next(ui + 1, nxt);
        const char* nA = has_next ? (const char*)g.A + (size_t)nxt.pm * tstep : cA; const char* nB = has_next ? (const char*)g.Bt + (size_t)nxt.pn * tstep : cB;
        for (int t = 0; t < nt; t += 2) {
            const bool last = (t == nt - 2);
            const char* a1 = cA + (size_t)(t + 1) * kstep;
            const char* a2 = last ? nA : cA + (size_t)(t + 2) * kstep; const char* b2 = last ? nB : cB + (size_t)(t + 2) * kstep;
            const char* a3 = a2 + kstep; const char* b3 = b2 + kstep;
            if (last && has_next) S.a_ready(nxt);
            if constexpr (SP2) {
            PG8_LDB(B0, 0, 0); PG8_LDB(B1, 0, 1); PG8_SCHED; PG8_LDA(At, 0, 0); PG8_STAGE(PG8_SA(1, 1), a1 + hstep, voffA);
            PG8_WAIT_V(8); PG8_WAIT_L(0); PG8_BAR; PG8_MMA(0, 0, At, B0); PG8_MMA(0, 1, At, B1); PG8_BAR; PG8_SCHED;
            PG8_LDA(At, 0, 1); PG8_STAGE(PG8_SB(0, 0), b2, voffB); PG8_STAGE(PG8_SB(0, 1), b2 + hstep, voffB); PG8_STAGE(PG8_SA(0, 0), a2, voffA);
            PG8_WAIT_V(8); PG8_WAIT_L(0); PG8_BAR; PG8_MMA(1, 0, At, B0); PG8_MMA(1, 1, At, B1); PG8_BAR; PG8_SCHED;
            PG8_LDB(B0, 1, 0); PG8_LDB(B1, 1, 1); PG8_SCHED; PG8_LDA(At, 1, 0); PG8_STAGE(PG8_SA(0, 1), a2 + hstep, voffA);
            PG8_WAIT_V(8); PG8_WAIT_L(0); PG8_BAR; PG8_MMA(0, 0, At, B0); PG8_MMA(0, 1, At, B1); PG8_BAR; PG8_SCHED;
            PG8_LDA(At, 1, 1); PG8_STAGE(PG8_SB(1, 0), b3, voffB); PG8_STAGE(PG8_SB(1, 1), b3 + hstep, voffB); PG8_STAGE(PG8_SA(1, 0), a3, voffA);
            PG8_WAIT_V(8); PG8_WAIT_L(0); PG8_BAR; PG8_MMA(1, 0, At, B0); PG8_MMA(1, 1, At, B1); PG8_BAR; PG8_SCHED;
            } else {
            PG8_LDB(B0, 0, 0); PG8_SCHED; PG8_LDA(At, 0, 0); PG8_STAGE(PG8_SA(1, 1), a1 + hstep, voffA);
            PG8_WAIT_L(8); PG8_BAR; PG8_WAIT_L(0); PG8_MMA(0, 0, At, B0); PG8_BAR; PG8_SCHED;
            PG8_LDB(B1, 0, 1); PG8_STAGE(PG8_SB(0, 0), b2, voffB);
            PG8_BAR; PG8_WAIT_L(0); PG8_MMA(0, 1, At, B1); PG8_BAR;
            PG8_LDA(At, 0, 1); PG8_STAGE(PG8_SA(0, 0), a2, voffA);
            PG8_BAR; PG8_WAIT_L(0); PG8_MMA(1, 0, At, B0); PG8_BAR; PG8_SCHED;
            PG8_STAGE(PG8_SB(0, 1), b2 + hstep, voffB);
            PG8_WAIT_V(6); PG8_BAR; PG8_MMA(1, 1, At, B1); PG8_BAR;
            PG8_LDB(B0, 1, 0); PG8_SCHED; PG8_LDA(At, 1, 0); PG8_STAGE(PG8_SA(0, 1), a2 + hstep, voffA);
            PG8_WAIT_L(8); PG8_BAR; PG8_WAIT_L(0); PG8_MMA(0, 0, At, B0); PG8_BAR; PG8_SCHED;
            PG8_LDB(B1, 1, 1); PG8_STAGE(PG8_SB(1, 0), b3, voffB);
            PG8_BAR; PG8_WAIT_L(0); PG8_MMA(0, 1, At, B1); PG8_BAR;
            PG8_LDA(At, 1, 1); PG8_STAGE(PG8_SA(1, 0), a3, voffA);
            PG8_BAR; PG8_WAIT_L(0); PG8_MMA(1, 0, At, B0); PG8_BAR; PG8_SCHED;
            PG8_STAGE(PG8_SB(1, 1), b3 + hstep, voffB);
            PG8_WAIT_V(6); PG8_BAR; PG8_MMA(1, 1, At, B1); PG8_BAR;
            }
        }
        if constexpr (ALIGN_EPI) { if (wr == 0) PG8_BAR; }
        if constexpr (!Epi::AFTER_DRAIN) { E(acc, cur, wr, wc, fr, fq); S.done(cur); }
        if (!has_next) break;
#pragma unroll
        for (int a = 0; a < 2; ++a)
#pragma unroll
            for (int b = 0; b < 2; ++b)
#pragma unroll
                for (int m = 0; m < 4; ++m)
#pragma unroll
                    for (int n = 0; n < 2; ++n) acc[a][b][m][n] = (f32x4){0.f, 0.f, 0.f, 0.f};
        cur = nxt; cA = nA; cB = nB; ++ui;
        if constexpr (ALIGN_EPI) { if (wr == 1) PG8_BAR; }
    }
    PG8_WAIT_V(0);
    if constexpr (!ALIGN_EPI) { if (wr == 0) PG8_BAR; }
    PG8_BAR;
#undef PG8_SA
#undef PG8_SB
#undef PG8_STAGE
#undef PG8_LDA
#undef PG8_LDB
#undef PG8_MMA
#undef PG8_WAIT_V
#undef PG8_WAIT_L
#undef PG8_BAR
#undef PG8_SCHED
}
}

namespace att {
#define ATT_LAS __attribute__((address_space(3)))
typedef unsigned short bf16_t;
typedef short bf16x8 __attribute__((ext_vector_type(8)));
typedef short s16x4 __attribute__((ext_vector_type(4)));
typedef float f32x16 __attribute__((ext_vector_type(16)));
typedef unsigned u32x4 __attribute__((ext_vector_type(4)));
typedef unsigned u32x2 __attribute__((ext_vector_type(2)));
__device__ __forceinline__ int crow(int r, int hi) { return (r & 3) + 8 * (r >> 2) + 4 * hi; }
__device__ __forceinline__ unsigned swz(int row, int ch) { return (unsigned)(row * 128 + ((ch ^ ((((row >> 1) & 1) << 2) | ((row >> 2) & 3))) << 4)); }
__device__ __forceinline__ float swap32f(float v) { auto rr = __builtin_amdgcn_permlane32_swap(__float_as_uint(v), __float_as_uint(v), false, false); return (threadIdx.x & 32) ? __uint_as_float(rr[0]) : __uint_as_float(rr[1]); }
__device__ __forceinline__ unsigned pk(float lo, float hi) { unsigned r; asm volatile("v_cvt_pk_bf16_f32 %0, %1, %2" : "=v"(r) : "v"(lo), "v"(hi)); return r; }

template <int W, bool SINK, bool LSEOUT>
__device__ __forceinline__ void unit(ATT_LAS unsigned char* lds, const bf16_t* Qb, const bf16_t* Kb, const bf16_t* Vb, bf16_t* Ob,
                                     size_t rstride, size_t ostride, int L, int q0, const float* sink, float* lse, size_t lstride) {
    constexpr int NK = 64 + 2 * W, NCH = NK * 8, PER = NCH / 512, NT = 2 * W / 32 + 1, VOFF = NK * 128;
    static_assert(NCH % 512 == 0, "staging split");
    const int tid = threadIdx.x, lane = tid & 63, r32 = lane & 31, hi = lane >> 5, wid = __builtin_amdgcn_readfirstlane(tid >> 6), h = wid & 3, sb = wid >> 2;
    {
        u32x4 kreg[PER], vreg[PER];
#pragma unroll
        for (int i = 0; i < PER; ++i) { const int cid = tid + 512 * i, row = cid >> 3, ch = cid & 7, kp = q0 - W + row;
            kreg[i] = (u32x4){0u, 0u, 0u, 0u}; vreg[i] = (u32x4){0u, 0u, 0u, 0u};
            if (kp >= 0 && kp < L) { kreg[i] = *(const u32x4*)(Kb + (size_t)kp * rstride + ch * 8); vreg[i] = *(const u32x4*)(Vb + (size_t)kp * rstride + ch * 8); } }
#pragma unroll
        for (int i = 0; i < PER; ++i) { const int cid = tid + 512 * i, row = cid >> 3, ch = cid & 7; const unsigned o = swz(row, ch);
            *(ATT_LAS u32x4*)(lds + o) = kreg[i]; *(ATT_LAS u32x4*)(lds + VOFF + o) = vreg[i]; }
    }
    const int qrow = q0 + 32 * sb + r32;
    const bf16_t* qp = Qb + (size_t)qrow * rstride + h * 64 + 8 * hi;
    bf16x8 qf[4];
#pragma unroll
    for (int d0 = 0; d0 < 4; ++d0) qf[d0] = *(const bf16x8*)(qp + 16 * d0);
    float m = -1e30f, l = 0.f;
    if (SINK) { m = sink[h] * 1.4426950408889634f; l = hi == 0 ? 1.f : 0.f; }
    f32x16 o0 = {}, o1 = {};
    const int qq = (lane & 15) >> 2, p = lane & 3, blk = (lane >> 4) & 1;
    const int fk = (((r32 >> 1) & 1) << 2) | ((r32 >> 2) & 3);
    unsigned kaddr[4];
#pragma unroll
    for (int d0 = 0; d0 < 4; ++d0) kaddr[d0] = (unsigned)(r32 * 128 + (((2 * d0 + hi) ^ fk) << 4));
    unsigned vaddr[2][2];
#pragma unroll
    for (int c = 0; c < 2; ++c)
#pragma unroll
        for (int hf = 0; hf < 2; ++hf) { const int fv = ((qq >> 1) << 2) | ((2 * hf + hi) & 3);
            vaddr[c][hf] = (unsigned)(VOFF + (8 * hf + 4 * hi + qq) * 128 + (((4 * c + 2 * blk + (p >> 1)) ^ fv) << 4) + 8 * (p & 1)); }
    __syncthreads();
    const float NEG = -INFINITY;
    for (int j = 0; j < NT; ++j) {
        const int lo = q0 - W + 32 * sb + 32 * j;
        if (lo < 0 || lo >= L) continue;
        const unsigned rb = (unsigned)((32 * sb + 32 * j) * 128);
        f32x16 S = {};
#pragma unroll
        for (int d0 = 0; d0 < 4; ++d0) { const bf16x8 kf = *(const ATT_LAS bf16x8*)(lds + rb + kaddr[d0]); S = __builtin_amdgcn_mfma_f32_32x32x16_bf16(kf, qf[d0], S, 0, 0, 0); }
        if (j == 0) {
#pragma unroll
            for (int r = 0; r < 16; ++r) if (crow(r, hi) < r32) S[r] = NEG; }
        if (j == NT - 1) {
#pragma unroll
            for (int r = 0; r < 16; ++r) if (crow(r, hi) > r32) S[r] = NEG; }
        float mx = S[0];
#pragma unroll
        for (int r = 1; r < 16; ++r) mx = fmaxf(mx, S[r]);
        mx = fmaxf(mx, swap32f(mx));
        const float mn = fmaxf(m, mx), alpha = __builtin_amdgcn_exp2f(m - mn); m = mn;
        float ls = 0.f;
#pragma unroll
        for (int r = 0; r < 16; ++r) { S[r] = __builtin_amdgcn_exp2f(S[r] - mn); ls += S[r]; }
        l = l * alpha + ls;
#pragma unroll
        for (int r = 0; r < 16; ++r) { o0[r] *= alpha; o1[r] *= alpha; }
        u32x4 pw0, pw1;
        pw0.x = pk(S[0], S[1]); pw0.y = pk(S[2], S[3]); pw0.z = pk(S[4], S[5]); pw0.w = pk(S[6], S[7]);
        pw1.x = pk(S[8], S[9]); pw1.y = pk(S[10], S[11]); pw1.z = pk(S[12], S[13]); pw1.w = pk(S[14], S[15]);
        const bf16x8 pa0 = __builtin_bit_cast(bf16x8, pw0), pa1 = __builtin_bit_cast(bf16x8, pw1);
#pragma unroll
        for (int s = 0; s < 2; ++s) {
            const bf16x8 pa = s ? pa1 : pa0;
#pragma unroll
            for (int c = 0; c < 2; ++c) {
                const s16x4 v0 = __builtin_bit_cast(s16x4, __builtin_amdgcn_ds_read_tr16_b64_v4i16((ATT_LAS s16x4*)(lds + rb + s * 2048 + vaddr[c][0])));
                const s16x4 v1 = __builtin_bit_cast(s16x4, __builtin_amdgcn_ds_read_tr16_b64_v4i16((ATT_LAS s16x4*)(lds + rb + s * 2048 + vaddr[c][1])));
                const bf16x8 vf = (bf16x8){v0[0], v0[1], v0[2], v0[3], v1[0], v1[1], v1[2], v1[3]};
                if (c == 0) o0 = __builtin_amdgcn_mfma_f32_32x32x16_bf16(vf, pa, o0, 0, 0, 0); else o1 = __builtin_amdgcn_mfma_f32_32x32x16_bf16(vf, pa, o1, 0, 0, 0);
            }
        }
    }
    const float lt = l + swap32f(l), inv = 1.0f / lt;
    bf16_t* op = Ob + (size_t)qrow * ostride + h * 64 + 4 * hi;
#pragma unroll
    for (int g = 0; g < 4; ++g) {
        u32x2 w0, w1; w0.x = pk(o0[4 * g] * inv, o0[4 * g + 1] * inv); w0.y = pk(o0[4 * g + 2] * inv, o0[4 * g + 3] * inv);
        w1.x = pk(o1[4 * g] * inv, o1[4 * g + 1] * inv); w1.y = pk(o1[4 * g + 2] * inv, o1[4 * g + 3] * inv);
        *(u32x2*)(op + 8 * g) = w0; *(u32x2*)(op + 32 + 8 * g) = w1; }
    if (LSEOUT) { if (hi == 0) lse[(size_t)qrow * lstride + h] = m + __builtin_amdgcn_logf(lt); }
    __syncthreads();
}
}

#define LAS __attribute__((address_space(3)))
typedef unsigned short bf16;
typedef unsigned v4u __attribute__((ext_vector_type(4)));
typedef float f32x4 __attribute__((ext_vector_type(4)));
constexpr int NWAVES = 8, NTHREADS = 512;
constexpr int BATCH = 32, SEQ = 2048, DM = 1024, T = BATCH * SEQ, DFF = 2816, QKVW = 1536, NH = 16;
constexpr int LDS_BYTES = 135168;
constexpr size_t MiB = 1u << 20;
constexpr size_t WS_WIN0 = 0;
constexpr size_t WS_WOUT0 = WS_WIN0 + (size_t)1536 * 1024 * 2;
constexpr size_t WS_WIN1 = WS_WOUT0 + (size_t)1024 * 1024 * 2;
constexpr size_t WS_WOUT1 = WS_WIN1 + (size_t)4608 * 1024 * 2;
constexpr size_t WS_WGU0 = WS_WOUT1 + (size_t)1024 * 1024 * 2;
constexpr size_t WS_WGU1 = WS_WGU0 + (size_t)5632 * 1024 * 2;
constexpr size_t WS_WD0 = WS_WGU1 + (size_t)5632 * 1024 * 2;
constexpr size_t WS_WD1 = WS_WD0 + (size_t)1024 * 2816 * 2;
constexpr size_t WS_COS = WS_WD1 + (size_t)1024 * 2816 * 2;
constexpr size_t WS_SIN = WS_COS + (size_t)2048 * 32 * 4;
constexpr size_t WS_SSQ = WS_SIN + (size_t)2048 * 32 * 4;
constexpr size_t WS_LSE = WS_SSQ + (size_t)5 * T * 4;
constexpr size_t WS_XB = 64 * MiB;
constexpr size_t WS_O = WS_XB + 128 * MiB;
constexpr size_t WS_BIG = WS_O + 128 * MiB;
constexpr size_t WS_END = WS_BIG + (size_t)T * 4608 * 2;
static_assert(WS_LSE + (size_t)3 * T * 16 * 4 <= WS_XB, "ws map");

__device__ __forceinline__ unsigned f2bf(float f) { unsigned u = __builtin_bit_cast(unsigned, f); return (u + 0x7fffu + ((u >> 16) & 1u)) >> 16; }
__device__ __forceinline__ unsigned pk2(float lo, float hi) { return f2bf(lo) | (f2bf(hi) << 16); }
__device__ __forceinline__ float wave_sum(float v) {
#pragma unroll
    for (int o = 1; o < 64; o <<= 1) v += __shfl_xor(v, o);
    return v;
}
__device__ __forceinline__ void transpose_item(const float* Wa, const float* Wb, int mode, const float* gain, int K, int Nsrc, bf16* WT, int nblk, LAS float* scr, int item, int lane) {
    const int kb = item / nblk, nb = item % nblk, k0 = 64 * kb, n0 = 32 * nb;
    const int np = n0 + (lane & 31); const float* W = Wa; int ncol = np;
    if (mode == 1) { const int grp = np / 1536; int c = np % 1536;
        if (c < 1280) { const int head = c >> 6, pp = c & 63, j = pp >> 3, e = pp & 7; c = head * 64 + (e < 4 ? 4 * j + e : 32 + 4 * j + (e - 4)); }
        ncol = grp * 1536 + c; }
    else if (mode == 2) { const int pn = np >> 8, wi = np & 255; W = (wi >> 7) ? Wb : Wa; ncol = pn * 128 + (wi & 127); }
#pragma unroll 8
    for (int i = 0; i < 32; ++i) { const int kk = 2 * i + (lane >> 5); float v = W[(size_t)(k0 + kk) * Nsrc + ncol]; if (gain) v *= gain[k0 + kk]; scr[kk * 33 + (lane & 31)] = v; }
    asm volatile("s_waitcnt lgkmcnt(0)" ::: "memory");
    const int c = lane & 7;
#pragma unroll
    for (int j = 0; j < 4; ++j) { const int n = (lane >> 3) + 8 * j; const LAS float* s = scr + (8 * c) * 33 + n;
        v4u o; o.x = pk2(s[0 * 33], s[1 * 33]); o.y = pk2(s[2 * 33], s[3 * 33]); o.z = pk2(s[4 * 33], s[5 * 33]); o.w = pk2(s[6 * 33], s[7 * 33]);
        *(v4u*)(WT + (size_t)(n0 + n) * K + k0 + 8 * c) = o; }
    asm volatile("s_waitcnt lgkmcnt(0)" ::: "memory");
}

struct Args {
    const float* x; const float* a_w_in; const float* a_sink; const float* a_w_out; const float* b_w_in; const float* b_w_out;
    const float* norm_mix; const float* norm_ffn; const float* w_gate; const float* w_up; const float* w_down; const float* final_norm;
    float* out; unsigned char* ws; int ph_lo, ph_hi;
};
constexpr int N_PHASES = 13;

__global__ void __launch_bounds__(NTHREADS, 2) mega_fwd(Args a) {
    extern __shared__ __attribute__((aligned(16))) unsigned char lds_raw[];
    LAS unsigned char* lds = (LAS unsigned char*)lds_raw;
    const int tid = threadIdx.x, lane = tid & 63, wave = __builtin_amdgcn_readfirstlane(tid >> 6);
    const int G = gridDim.x, bid = blockIdx.x;
    unsigned char* ws = a.ws;
    bf16* Win0 = (bf16*)(ws + WS_WIN0); bf16* Wout0 = (bf16*)(ws + WS_WOUT0); bf16* Win1 = (bf16*)(ws + WS_WIN1); bf16* Wout1 = (bf16*)(ws + WS_WOUT1);
    bf16* Wgu0 = (bf16*)(ws + WS_WGU0); bf16* Wgu1 = (bf16*)(ws + WS_WGU1); bf16* Wd0 = (bf16*)(ws + WS_WD0); bf16* Wd1 = (bf16*)(ws + WS_WD1);
    float* cosT = (float*)(ws + WS_COS); float* sinT = (float*)(ws + WS_SIN); float* ssq = (float*)(ws + WS_SSQ); float* lse = (float*)(ws + WS_LSE);
    bf16* XB = (bf16*)(ws + WS_XB); bf16* OB = (bf16*)(ws + WS_O); bf16* BIG = (bf16*)(ws + WS_BIG);
    float* X = a.out;
    const int lo = a.ph_lo, hi_ph = a.ph_hi;
#define IN(k) (lo <= (k) && (k) < hi_ph)
#define SEAM(k) do { if (IN(k) && IN((k) + 1)) { cg::this_grid().sync(); } } while (0)

    if (IN(0)) {
        LAS float* scr = (LAS float*)(lds + wave * 16384);
        const int gw = bid * NWAVES + wave, NGW = G * NWAVES;
        constexpr int I_IN0 = 16 * 48, I_OUT = 16 * 32, I_IN1 = 16 * 144, I_GU = 16 * 176, I_D = 44 * 32;
        constexpr int NITEMS = I_IN0 + 2 * I_OUT + I_IN1 + 2 * I_GU + 2 * I_D;
        for (int it = gw; it < NITEMS; it += NGW) {
            int r = it;
            if (r < I_IN0) { transpose_item(a.a_w_in, nullptr, 1, a.norm_mix, 1024, 1536, Win0, 48, scr, r, lane); continue; } r -= I_IN0;
            if (r < I_OUT) { transpose_item(a.a_w_out, nullptr, 0, nullptr, 1024, 1024, Wout0, 32, scr, r, lane); continue; } r -= I_OUT;
            if (r < I_IN1) { transpose_item(a.b_w_in, nullptr, 1, a.norm_mix + 1024, 1024, 4608, Win1, 144, scr, r, lane); continue; } r -= I_IN1;
            if (r < I_OUT) { transpose_item(a.b_w_out, nullptr, 0, nullptr, 1024, 1024, Wout1, 32, scr, r, lane); continue; } r -= I_OUT;
            if (r < I_GU) { transpose_item(a.w_gate, a.w_up, 2, a.norm_ffn, 1024, 2816, Wgu0, 176, scr, r, lane); continue; } r -= I_GU;
            if (r < I_GU) { transpose_item(a.w_gate + (size_t)1024 * 2816, a.w_up + (size_t)1024 * 2816, 2, a.norm_ffn + 1024, 1024, 2816, Wgu1, 176, scr, r, lane); continue; } r -= I_GU;
            if (r < I_D) { transpose_item(a.w_down, nullptr, 0, nullptr, 2816, 1024, Wd0, 32, scr, r, lane); continue; } r -= I_D;
            transpose_item(a.w_down + (size_t)2816 * 1024, nullptr, 0, nullptr, 2816, 1024, Wd1, 32, scr, r, lane);
        }
        const int gt = bid * NTHREADS + tid, NGT = G * NTHREADS;
        for (int i = gt; i < 2048 * 32; i += NGT) {
            const int t = i >> 5, f = i & 31; double inv = 1.0; for (int k = 0; k < f; ++k) inv *= 0.74989420933245583;
            double rev = (double)t * inv * 0.15915494309189535; rev = rev - __builtin_floor(rev); const float fr = (float)rev;
            cosT[i] = __builtin_amdgcn_cosf(fr); sinT[i] = __builtin_amdgcn_sinf(fr);
        }
        for (int i = gt; i < 4 * T; i += NGT) ssq[T + i] = 0.f;
        for (int row = gw; row < T; row += NGW) {
            const f32x4* xr = (const f32x4*)(a.x + (size_t)row * DM) + lane; f32x4 v[4]; float s = 0.f;
#pragma unroll
            for (int j = 0; j < 4; ++j) { v[j] = xr[64 * j]; s += (v[j].x * v[j].x + v[j].y * v[j].y) + (v[j].z * v[j].z + v[j].w * v[j].w); }
            s = wave_sum(s); if (lane == 0) ssq[row] = s;
            unsigned long long* o8 = (unsigned long long*)(XB + (size_t)row * DM) + lane;
#pragma unroll
            for (int j = 0; j < 4; ++j) o8[64 * j] = (unsigned long long)pk2(v[j].x, v[j].y) | ((unsigned long long)pk2(v[j].z, v[j].w) << 32);
        }
        __syncthreads();
    }
    SEAM(0);
    if (IN(1)) for (int rep = 0; rep < (PROBE_DUP == 1 ? 2 : 1); ++rep) {
        if (rep) cg::this_grid().sync();
        pg8::Gemm g{XB, Win0, T, QKVW, DM}; pg8::StaticOrder S; S.init(T, QKVW, G, bid);
        pg8::EpiQKV E{BIG, QKVW, ssq, cosT, sinT};
        pg8::gemm_phase<pg8::EpiQKV, pg8::StaticOrder, true, true>(lds, g, S, E);
    }
    SEAM(1);
    if (IN(2)) for (int rep = 0; rep < (PROBE_DUP == 2 ? 2 : 1); ++rep) {
        if (rep) cg::this_grid().sync();
        constexpr int NU = BATCH * 4 * 32; const int per = (NU + G - 1) / G; const int u1 = min(NU, (bid + 1) * per);
        for (int u = bid * per; u < u1; ++u) {
            const int qb = u & 31, kvh = (u >> 5) & 3, b = u >> 7;
            const bf16* base = BIG + (size_t)b * SEQ * QKVW;
            att::unit<128, true, false>(lds, base + kvh * 256, base + 1024 + kvh * 64, base + 1280 + kvh * 64, OB + (size_t)b * SEQ * DM + kvh * 256,
                                        (size_t)QKVW, (size_t)DM, SEQ, qb * 64, a.a_sink + kvh * 4, nullptr, 0);
        }
    }
    SEAM(2);
    if (IN(3)) {
        pg8::Gemm g{OB, Wout0, T, DM, DM}; pg8::StaticOrder S; S.init(T, DM, G, bid);
        pg8::EpiRes E{XB, ssq + T};
        pg8::gemm_phase<pg8::EpiRes, pg8::StaticOrder, true, true>(lds, g, S, E);
    }
    SEAM(3);
    if (IN(4)) for (int rep = 0; rep < (PROBE_DUP == 4 ? 2 : 1); ++rep) {
        if (rep) cg::this_grid().sync();
        pg8::Gemm g{XB, Wgu0, T, 2 * DFF, DM}; pg8::StaticOrder S; S.init(T, 2 * DFF, G, bid);
        pg8::EpiSwiGLU E{BIG, DFF, ssq + T};
        pg8::gemm_phase<pg8::EpiSwiGLU, pg8::StaticOrder, true, true>(lds, g, S, E);
    }
    SEAM(4);
    if (IN(5)) {
        pg8::Gemm g{BIG, Wd0, T, DM, DFF}; pg8::StaticOrder S; S.init(T, DM, G, bid);
        pg8::EpiRes E{XB, ssq + 2 * T};
        pg8::gemm_phase<pg8::EpiRes, pg8::StaticOrder, true, true>(lds, g, S, E);
    }
    SEAM(5);
    if (IN(6)) for (int rep = 0; rep < (PROBE_DUP == 6 ? 2 : 1); ++rep) {
        if (rep) cg::this_grid().sync();
        pg8::Gemm g{XB, Win1, T, 3 * QKVW, DM}; pg8::StaticOrder S; S.init(T, 3 * QKVW, G, bid);
        pg8::EpiQKV E{BIG, 3 * QKVW, ssq + 2 * T, cosT, sinT};
        pg8::gemm_phase<pg8::EpiQKV, pg8::StaticOrder, true, true>(lds, g, S, E);
    }
    SEAM(6);
    if (IN(7)) {
        constexpr int NU = 3 * BATCH * 4 * 32; const int per = (NU + G - 1) / G; const int u1 = min(NU, (bid + 1) * per);
        for (int u = bid * per; u < u1; ++u) {
            const int gidx = u >> 12, v = u & 4095, qa = v & 31, kvh = (v >> 5) & 3, b = v >> 7;
            const int dsh = 2 * gidx, dil = 1 << dsh, nbk = 32 >> dsh, r = qa / nbk, qb = qa % nbk;
            bf16* base = BIG + ((size_t)b * SEQ + r) * (3 * QKVW) + gidx * QKVW;
            att::unit<64, false, true>(lds, base + kvh * 256, base + 1024 + kvh * 64, base + 1280 + kvh * 64, base + kvh * 256,
                                       (size_t)dil * 3 * QKVW, (size_t)dil * 3 * QKVW, SEQ >> dsh, qb * 64, nullptr,
                                       lse + ((size_t)gidx * T + (size_t)b * SEQ + r) * NH + kvh * 4, (size_t)dil * NH);
        }
    }
    SEAM(7);
    if (IN(8)) {
        const int gt = bid * NTHREADS + tid, NGT = G * NTHREADS;
        for (int i = gt; i < T * 128; i += NGT) {
            const int tok = i >> 7, ch = i & 127, head = ch >> 3;
            const float l0 = lse[(size_t)tok * NH + head], l1 = lse[((size_t)T + tok) * NH + head], l2 = lse[((size_t)2 * T + tok) * NH + head];
            const float mx = fmaxf(l0, fmaxf(l1, l2)); float w0 = __builtin_amdgcn_exp2f(l0 - mx), w1 = __builtin_amdgcn_exp2f(l1 - mx), w2 = __builtin_amdgcn_exp2f(l2 - mx);
            const float inv = 1.0f / (w0 + w1 + w2); w0 *= inv; w1 *= inv; w2 *= inv;
            const bf16* src = BIG + (size_t)tok * (3 * QKVW) + ch * 8;
            const v4u a0 = *(const v4u*)src, a1 = *(const v4u*)(src + QKVW), a2 = *(const v4u*)(src + 2 * QKVW);
            v4u o;
#pragma unroll
            for (int e = 0; e < 4; ++e) {
                const float x0 = __uint_as_float(a0[e] << 16), y0 = __uint_as_float(a0[e] & 0xffff0000u);
                const float x1 = __uint_as_float(a1[e] << 16), y1 = __uint_as_float(a1[e] & 0xffff0000u);
                const float x2 = __uint_as_float(a2[e] << 16), y2 = __uint_as_float(a2[e] & 0xffff0000u);
                o[e] = pk2(w0 * x0 + w1 * x1 + w2 * x2, w0 * y0 + w1 * y1 + w2 * y2);
            }
            *(v4u*)(OB + (size_t)tok * DM + ch * 8) = o;
        }
    }
    SEAM(8);
    if (IN(9)) {
        pg8::Gemm g{OB, Wout1, T, DM, DM}; pg8::StaticOrder S; S.init(T, DM, G, bid);
        pg8::EpiRes E{XB, ssq + 3 * T};
        pg8::gemm_phase<pg8::EpiRes, pg8::StaticOrder, true, true>(lds, g, S, E);
    }
    SEAM(9);
    if (IN(10)) for (int rep = 0; rep < (PROBE_DUP == 10 ? 2 : 1); ++rep) {
        if (rep) cg::this_grid().sync();
        pg8::Gemm g{XB, Wgu1, T, 2 * DFF, DM}; pg8::StaticOrder S; S.init(T, 2 * DFF, G, bid);
        pg8::EpiSwiGLU E{BIG, DFF, ssq + 3 * T};
        pg8::gemm_phase<pg8::EpiSwiGLU, pg8::StaticOrder, true, true>(lds, g, S, E);
    }
    SEAM(10);
    if (IN(11)) {
        pg8::Gemm g{BIG, Wd1, T, DM, DFF}; pg8::StaticOrder S; S.init(T, DM, G, bid);
        pg8::EpiRes E{XB, ssq + 4 * T};
        pg8::gemm_phase<pg8::EpiRes, pg8::StaticOrder, true, true>(lds, g, S, E);
    }
    SEAM(11);
    if (IN(12)) {
        const int gw = bid * NWAVES + wave, NGW = G * NWAVES;
        f32x4 gv[2][2];
#pragma unroll
        for (int j = 0; j < 2; ++j) { gv[j][0] = *(const f32x4*)(a.final_norm + 512 * j + 8 * lane); gv[j][1] = *(const f32x4*)(a.final_norm + 512 * j + 8 * lane + 4); }
        for (int row = gw; row < T; row += NGW) {
            const float rstd = __builtin_amdgcn_rsqf(ssq[4 * T + row] * (1.0f / 1024.0f) + pg8::RMS_EPS);
            const bf16* xr = XB + (size_t)row * DM + 8 * lane; float* orow = X + (size_t)row * DM + 8 * lane;
#pragma unroll
            for (int j = 0; j < 2; ++j) { const v4u v = *(const v4u*)(xr + 512 * j);
                f32x4 o0 = (f32x4){__uint_as_float(v.x << 16), __uint_as_float(v.x & 0xffff0000u), __uint_as_float(v.y << 16), __uint_as_float(v.y & 0xffff0000u)};
                f32x4 o1 = (f32x4){__uint_as_float(v.z << 16), __uint_as_float(v.z & 0xffff0000u), __uint_as_float(v.w << 16), __uint_as_float(v.w & 0xffff0000u)};
                *(f32x4*)(orow + 512 * j) = o0 * rstd * gv[j][0]; *(f32x4*)(orow + 512 * j + 4) = o1 * rstd * gv[j][1]; }
        }
    }
#undef IN
#undef SEAM
}

extern "C" void kernel_launch(void* const* d_in, const int* in_sizes, int n_in, void* d_out, int out_size, void* d_ws, size_t ws_size, hipStream_t stream) {
    static int grid = 0;
    if (grid == 0) {
        if (n_in != 12 || in_sizes[0] != T * DM || out_size != T * DM || ws_size < WS_END) {
            fprintf(stderr, "kernel_launch: unexpected shapes (n_in %d, in0 %d, out %d, ws %zu, need %zu)\n", n_in, n_in > 0 ? in_sizes[0] : -1, out_size, ws_size, (size_t)WS_END); grid = -1; return; }
        int dev = 0, cus = 0, per_cu = 0;
        hipGetDevice(&dev); hipDeviceGetAttribute(&cus, hipDeviceAttributeMultiprocessorCount, dev);
        if (hipFuncSetAttribute((const void*)mega_fwd, hipFuncAttributeMaxDynamicSharedMemorySize, LDS_BYTES) != hipSuccess) { fprintf(stderr, "kernel_launch: hipFuncSetAttribute failed\n"); grid = -1; return; }
        if (hipOccupancyMaxActiveBlocksPerMultiprocessor(&per_cu, (const void*)mega_fwd, NTHREADS, LDS_BYTES) != hipSuccess || per_cu < 1) { fprintf(stderr, "kernel_launch: occupancy query gave %d\n", per_cu); per_cu = 1; }
        (void)hipGetLastError();
        grid = cus * per_cu;
    }
    if (grid < 0) return;
    Args a{};
    a.x = (const float*)d_in[0]; a.a_w_in = (const float*)d_in[1]; a.a_sink = (const float*)d_in[2]; a.a_w_out = (const float*)d_in[3];
    a.b_w_in = (const float*)d_in[4]; a.b_w_out = (const float*)d_in[5]; a.norm_mix = (const float*)d_in[6]; a.norm_ffn = (const float*)d_in[7];
    a.w_gate = (const float*)d_in[8]; a.w_up = (const float*)d_in[9]; a.w_down = (const float*)d_in[10]; a.final_norm = (const float*)d_in[11];
    a.out = (float*)d_out; a.ws = (unsigned char*)d_ws;
#if MK_N_LAUNCHES == 1
    a.ph_lo = 0; a.ph_hi = N_PHASES;
    void* args[] = {&a};
    hipError_t e = hipLaunchCooperativeKernel((const void*)mega_fwd, dim3(grid), dim3(NTHREADS), args, LDS_BYTES, stream);
    if (e != hipSuccess) fprintf(stderr, "cooperative launch failed: %s (grid %d)\n", hipGetErrorString(e), grid);
#else
    for (int p = 0; p < N_PHASES; ++p) { a.ph_lo = p; a.ph_hi = p + 1; hipLaunchKernelGGL(mega_fwd, dim3(grid), dim3(NTHREADS), LDS_BYTES, stream, a); }
#endif
}
```

```cpp
#include <hip/hip_runtime.h>
#include <hip/hip_cooperative_groups.h>
#include <cstdio>
#include <cstdint>
namespace cg = cooperative_groups;

#ifndef PROBE_DUP
#define PROBE_DUP -1
#endif
#ifndef STAGGER_US
#define STAGGER_US 0
#endif
#ifndef XCD_LOCAL
#define XCD_LOCAL 1
#endif
#ifndef MK_N_LAUNCHES
#define MK_N_LAUNCHES 1
#endif

namespace pg8 {
#define PG8_LAS __attribute__((address_space(3)))
typedef unsigned short bf16_t;
typedef short bf16x8 __attribute__((ext_vector_type(8)));
typedef float f32x4 __attribute__((ext_vector_type(4)));
typedef unsigned u32x4 __attribute__((ext_vector_type(4)));
typedef unsigned u32x2 __attribute__((ext_vector_type(2)));
constexpr int BM = 256, BK = 64, HALF = 128, HTB = HALF * BK * 2, STAGE_BYTES = 8 * HTB, NXCD = 8, WGM = 8;

__host__ __device__ __forceinline__ int lds_byte(int r, int c) { const int st = (r >> 4) * 2 + (c >> 5), rr = r & 15, cc = c & 31, ob = rr * 64 + cc * 2; return st * 1024 + (ob ^ (((ob >> 9) & 1) << 5)); }
__host__ __device__ __forceinline__ void stage_rc(int b, int& R, int& C) { const int st = b / 1024, sb = b % 1024, swz = sb ^ (((sb >> 9) & 1) << 5); R = (st >> 1) * 16 + swz / 64; C = (st & 1) * 32 + (swz % 64) / 2; }
__host__ __device__ __forceinline__ int perm32(int rho) { const int n = rho >> 4, i = rho & 15; return 8 * (i >> 2) + 4 * n + (i & 3); }

struct Unit { int pm, pn; };
struct Gemm { const bf16_t* A; const bf16_t* Bt; int M, N, K; };

struct StaticOrder {
    int nM, nN, nwg, G, c;
    __host__ __device__ void init(int M, int N, int G_, int c_) { nM = M / BM; nN = N / BM; nwg = nM * nN; G = G_; c = c_; }
    __host__ __device__ bool next(int i, Unit& u) const {
        const long L = (long)i * G + c; if (L >= nwg) return false;
        int wgid = (int)L; { const int q = nwg / NXCD, r = nwg % NXCD, xcd = wgid % NXCD, off = wgid / NXCD; wgid = (xcd < r ? xcd * (q + 1) : r * (q + 1) + (xcd - r) * q) + off; }
        const int nig = WGM * nN, gid = wgid / nig, fm = gid * WGM, gsz = (nM - fm) < WGM ? (nM - fm) : WGM;
        u.pm = fm + ((wgid % nig) % gsz); u.pn = (wgid % nig) / gsz; return true;
    }
    __device__ __forceinline__ void a_ready(const Unit&) const {}
    __device__ __forceinline__ void done(const Unit&) const {}
};

__device__ __forceinline__ unsigned cvt_pk_bf16(float lo, float hi) { unsigned r; asm volatile("v_cvt_pk_bf16_f32 %0, %1, %2" : "=v"(r) : "v"(lo), "v"(hi)); return r; }

constexpr float RMS_EPS = 1e-6f;
constexpr float SSQ_SCALE = 2048.0f, SSQ_INV = 1.0f / (2048.0f * 1024.0f);
constexpr float QSCALE = 0.125f * 1.4426950408889634f;


struct EpiQKV {
    static constexpr bool PERM = true, AFTER_DRAIN = false;
    bf16_t* O; int ldc; const unsigned* ssq; const float* cosT; const float* sinT; const float* rot;
    __device__ __forceinline__ void operator()(const f32x4 (&acc)[2][2][4][2], const Unit& u, int wr, int wc, int fr, int fq) const {
        const int row0 = u.pm * BM + wr * 64 + fr; const int t6 = u.pn % 6;
        const int col0 = u.pn * BM + wc * 32 + 8 * fq; const int fi = 16 * (wc & 1) + 4 * fq;
        const float qs = t6 < 4 ? QSCALE : 1.0f; const bool rope = t6 < 5;
        unsigned sq[8];
#pragma unroll
        for (int i = 0; i < 8; ++i) { const int row = row0 + (i >> 2) * HALF + (i & 3) * 16; sq[i] = ssq[row]; }
        f32x4 c0 = (f32x4){1.f, 1.f, 1.f, 1.f}, s0 = (f32x4){0.f, 0.f, 0.f, 0.f}, c16 = c0, s16 = s0, c128 = c0, s128 = s0;
        if (rope) { const int t0 = row0 & 2047;
            c0 = *(const f32x4*)(cosT + t0 * 32 + fi); s0 = *(const f32x4*)(sinT + t0 * 32 + fi);
            c16 = *(const f32x4*)(rot + fi); s16 = *(const f32x4*)(rot + 32 + fi); c128 = *(const f32x4*)(rot + 64 + fi); s128 = *(const f32x4*)(rot + 96 + fi); }
        asm volatile("" ::: "memory");
#pragma unroll
        for (int ai = 0; ai < 2; ++ai) {
            f32x4 c = c0, sn = s0;
            if (ai == 1) { c = c0 * c128 - s0 * s128; sn = s0 * c128 + c0 * s128; }
#pragma unroll
            for (int m = 0; m < 4; ++m) {
                const int row = row0 + ai * HALF + m * 16;
                const float s1 = __builtin_amdgcn_rsqf((float)sq[ai * 4 + m] * SSQ_INV + RMS_EPS) * qs; const f32x4 c1 = c * s1, n1 = sn * s1;
                bf16_t* rowp = O + (size_t)row * ldc + col0;
#pragma unroll
                for (int bj = 0; bj < 2; ++bj) {
                    const f32x4 v0 = acc[ai][bj][m][0], v1 = acc[ai][bj][m][1];
                    const f32x4 o0 = v0 * c1 - v1 * n1, o1 = v1 * c1 + v0 * n1;
                    u32x4 w; w.x = cvt_pk_bf16(o0[0], o0[1]); w.y = cvt_pk_bf16(o0[2], o0[3]); w.z = cvt_pk_bf16(o1[0], o1[1]); w.w = cvt_pk_bf16(o1[2], o1[3]);
                    *(u32x4*)(rowp + bj * HALF) = w; }
                if (m < 3) { const f32x4 cn = c * c16 - sn * s16; sn = sn * c16 + c * s16; c = cn; }
            }
        }
    }
};

struct EpiSwiGLU {
    static constexpr bool PERM = true, AFTER_DRAIN = false;
    bf16_t* O; int ldc; const unsigned* ssq;
    __device__ __forceinline__ void operator()(const f32x4 (&acc)[2][2][4][2], const Unit& u, int wr, int wc, int fr, int fq) const {
        const int row0 = u.pm * BM + wr * 64 + fr; const int col0 = u.pn * HALF + wc * 32 + 8 * fq;
        unsigned sq[8];
#pragma unroll
        for (int i = 0; i < 8; ++i) sq[i] = ssq[row0 + (i >> 2) * HALF + (i & 3) * 16];
        asm volatile("" ::: "memory");
#pragma unroll
        for (int i = 0; i < 8; ++i) {
            const int ai = i >> 2, m = i & 3; const int row = row0 + ai * HALF + m * 16;
            const float rstd = __builtin_amdgcn_rsqf((float)sq[i] * SSQ_INV + RMS_EPS), nr = -1.4426950408889634f * rstd, r2 = rstd * rstd;
            float h[8];
#pragma unroll
            for (int n = 0; n < 2; ++n)
#pragma unroll
                for (int e = 0; e < 4; ++e) { const float ag = acc[ai][0][m][n][e], au = acc[ai][1][m][n][e];
                    h[n * 4 + e] = (ag * au) * (r2 * __builtin_amdgcn_rcpf(1.0f + __builtin_amdgcn_exp2f(ag * nr))); }
            u32x4 w; w.x = cvt_pk_bf16(h[0], h[1]); w.y = cvt_pk_bf16(h[2], h[3]); w.z = cvt_pk_bf16(h[4], h[5]); w.w = cvt_pk_bf16(h[6], h[7]);
            *(u32x4*)(O + (size_t)row * ldc + col0) = w;
        }
    }
};

struct EpiRes {
    static constexpr bool PERM = true, AFTER_DRAIN = false;
    bf16_t* xb; unsigned* ssq;
    __device__ __forceinline__ void operator()(const f32x4 (&acc)[2][2][4][2], const Unit& u, int wr, int wc, int fr, int fq) const {
        const int row0 = u.pm * BM + wr * 64 + fr; const int col0 = u.pn * BM + wc * 32 + 8 * fq;
#pragma unroll
        for (int i = 0; i < 8; ++i) {
            const int ai = i >> 2, m = i & 3; const int row = row0 + ai * HALF + m * 16; bf16_t* rowp = xb + (size_t)row * 1024 + col0; float s = 0.f;
            u32x4 xv[2];
#pragma unroll
            for (int bj = 0; bj < 2; ++bj) xv[bj] = *(const u32x4*)(rowp + bj * HALF);
#pragma unroll
            for (int bj = 0; bj < 2; ++bj) {
                float o[8];
#pragma unroll
                for (int e = 0; e < 4; ++e) { o[2 * e] = __uint_as_float(xv[bj][e] << 16) + acc[ai][bj][m][e >> 1][(2 * e) & 3]; o[2 * e + 1] = __uint_as_float(xv[bj][e] & 0xffff0000u) + acc[ai][bj][m][e >> 1][(2 * e + 1) & 3]; }
#pragma unroll
                for (int e = 0; e < 8; ++e) s += o[e] * o[e];
                u32x4 w; w.x = cvt_pk_bf16(o[0], o[1]); w.y = cvt_pk_bf16(o[2], o[3]); w.z = cvt_pk_bf16(o[4], o[5]); w.w = cvt_pk_bf16(o[6], o[7]);
                *(u32x4*)(rowp + bj * HALF) = w;
            }
            s += __shfl_xor(s, 16); s += __shfl_xor(s, 32);
            if (fq == 0) atomicAdd(ssq + row, (unsigned)(s * SSQ_SCALE + 0.5f));
        }
    }
};

template <class Epi, class Sched, bool ALIGN_EPI = false, bool SP2 = false>
__device__ __forceinline__ void gemm_phase(PG8_LAS unsigned char* lds, const Gemm g, const Sched& S, const Epi& E) {
    const int tid = threadIdx.x, wid = __builtin_amdgcn_readfirstlane(tid >> 6), lane = tid & 63, wr = wid >> 2, wc = wid & 3, fr = lane & 15, fq = lane >> 4;
    const int K = g.K, nt = K / BK;
    unsigned voffA[2], voffB[2];
#pragma unroll
    for (int i = 0; i < 2; ++i) { int R, C; stage_rc(tid * 16 + i * 8192, R, C); const int Rb = Epi::PERM ? ((R & ~31) + perm32(R & 31)) : R;
        voffA[i] = (unsigned)(R * K + C) * 2u; voffB[i] = (unsigned)(Rb * K + C) * 2u; }
    const size_t kstep = (size_t)(BK * 2);
    const size_t hstep = (size_t)HALF * K * 2;
    const size_t tstep = 2 * hstep;
    const unsigned ldsw = (unsigned)wid * 1024u;
    const int aoff = lds_byte(wr * 64 + fr, fq * 8), boff = lds_byte(wc * 32 + fr, fq * 8);
#define PG8_SA(b, h) (((b) * 2 + (h)) * HTB)
#define PG8_SB(b, h) ((4 + (b) * 2 + (h)) * HTB)
#define PG8_STAGE(bufoff, gbase, voff) do { _Pragma("unroll") for (int _i = 0; _i < 2; ++_i) \
        __builtin_amdgcn_global_load_lds((const unsigned*)((const char*)(gbase) + (voff)[_i]), (PG8_LAS unsigned*)(lds + (bufoff) + ldsw + _i * 8192), 16, 0, 0); } while (0)
#define PG8_LDA(dst, b, h) do { _Pragma("unroll") for (int m = 0; m < 4; ++m) _Pragma("unroll") for (int k = 0; k < 2; ++k) dst[m][k] = *(const PG8_LAS bf16x8*)(lds + PG8_SA(b, h) + aoff + m * 2048 + k * 1024); } while (0)
#define PG8_LDB(dst, b, h) do { _Pragma("unroll") for (int n = 0; n < 2; ++n) _Pragma("unroll") for (int k = 0; k < 2; ++k) dst[n][k] = *(const PG8_LAS bf16x8*)(lds + PG8_SB(b, h) + boff + n * 2048 + k * 1024); } while (0)
#define PG8_MMA(ai, bj, At, Bt) do { __builtin_amdgcn_s_setprio(1); _Pragma("unroll") for (int m = 0; m < 4; ++m) _Pragma("unroll") for (int n = 0; n < 2; ++n) _Pragma("unroll") for (int k = 0; k < 2; ++k) \
        acc[ai][bj][m][n] = __builtin_amdgcn_mfma_f32_16x16x32_bf16(Bt[n][k], At[m][k], acc[ai][bj][m][n], 0, 0, 0); __builtin_amdgcn_s_setprio(0); } while (0)
#define PG8_WAIT_V(n) asm volatile("s_waitcnt vmcnt(" #n ")" ::: "memory")
#define PG8_WAIT_L(n) asm volatile("s_waitcnt lgkmcnt(" #n ")" ::: "memory")
#define PG8_BAR __builtin_amdgcn_s_barrier()
#define PG8_SCHED __builtin_amdgcn_sched_barrier(0)
    Unit cur, nxt; int ui = 0;
    if (!S.next(0, cur)) return;
    f32x4 acc[2][2][4][2];
#pragma unroll
    for (int a = 0; a < 2; ++a)
#pragma unroll
        for (int b = 0; b < 2; ++b)
#pragma unroll
            for (int m = 0; m < 4; ++m)
#pragma unroll
                for (int n = 0; n < 2; ++n) acc[a][b][m][n] = (f32x4){0.f, 0.f, 0.f, 0.f};
    bf16x8 At[4][2], B0[2][2], B1[2][2];
    const char* cA = (const char*)g.A + (size_t)cur.pm * tstep; const char* cB = (const char*)g.Bt + (size_t)cur.pn * tstep;
    S.a_ready(cur);
    if constexpr (SP2) {
        PG8_STAGE(PG8_SB(0, 0), cB, voffB); PG8_STAGE(PG8_SB(0, 1), cB + hstep, voffB); PG8_STAGE(PG8_SA(0, 0), cA, voffA); PG8_STAGE(PG8_SA(0, 1), cA + hstep, voffA);
        if (wr == 1) PG8_BAR;
        PG8_WAIT_V(2); PG8_BAR;
        PG8_STAGE(PG8_SB(1, 0), cB + kstep, voffB); PG8_STAGE(PG8_SA(1, 0), cA + kstep, voffA); PG8_STAGE(PG8_SB(1, 1), cB + hstep + kstep, voffB);
        PG8_WAIT_V(6); PG8_BAR;
    } else {
        PG8_STAGE(PG8_SB(0, 0), cB, voffB); PG8_STAGE(PG8_SA(0, 0), cA, voffA); PG8_STAGE(PG8_SB(0, 1), cB + hstep, voffB); PG8_STAGE(PG8_SA(0, 1), cA + hstep, voffA);
        if (wr == 1) PG8_BAR;
        PG8_WAIT_V(4); PG8_BAR;
        PG8_STAGE(PG8_SB(1, 0), cB + kstep, voffB); PG8_STAGE(PG8_SA(1, 0), cA + kstep, voffA); PG8_STAGE(PG8_SB(1, 1), cB + hstep + kstep, voffB);
        PG8_WAIT_V(6); PG8_BAR;
    }
    for (;;) {
        const bool has_next = S.next(ui + 1, nxt);
        const char* nA = has_next ? (const char*)g.A + (size_t)nxt.pm * tstep : cA; const char* nB = has_next ? (const char*)g.Bt + (size_t)nxt.pn * tstep : cB;
        for (int t = 0; t < nt; t += 2) {
            const bool last = (t == nt - 2);
            const char* a1 = cA + (size_t)(t + 1) * kstep;
            const char* a2 = last ? nA : cA + (size_t)(t + 2) * kstep; const char* b2 = last ? nB : cB + (size_t)(t + 2) * kstep;
            const char* a3 = a2 + kstep; const char* b3 = b2 + kstep;
            if (last && has_next) S.a_ready(nxt);
            if constexpr (SP2) {
            PG8_LDB(B0, 0, 0); PG8_LDB(B1, 0, 1); PG8_SCHED; PG8_LDA(At, 0, 0); PG8_STAGE(PG8_SA(1, 1), a1 + hstep, voffA);
            PG8_WAIT_V(8); PG8_WAIT_L(0); PG8_BAR; PG8_MMA(0, 0, At, B0); PG8_MMA(0, 1, At, B1); PG8_BAR; PG8_SCHED;
            PG8_LDA(At, 0, 1); PG8_STAGE(PG8_SB(0, 0), b2, voffB); PG8_STAGE(PG8_SB(0, 1), b2 + hstep, voffB); PG8_STAGE(PG8_SA(0, 0), a2, voffA);
            PG8_WAIT_V(8); PG8_WAIT_L(0); PG8_BAR; PG8_MMA(1, 0, At, B0); PG8_MMA(1, 1, At, B1); PG8_BAR; PG8_SCHED;
            PG8_LDB(B0, 1, 0); PG8_LDB(B1, 1, 1); PG8_SCHED; PG8_LDA(At, 1, 0); PG8_STAGE(PG8_SA(0, 1), a2 + hstep, voffA);
            PG8_WAIT_V(8); PG8_WAIT_L(0); PG8_BAR; PG8_MMA(0, 0, At, B0); PG8_MMA(0, 1, At, B1); PG8_BAR; PG8_SCHED;
            PG8_LDA(At, 1, 1); PG8_STAGE(PG8_SB(1, 0), b3, voffB); PG8_STAGE(PG8_SB(1, 1), b3 + hstep, voffB); PG8_STAGE(PG8_SA(1, 0), a3, voffA);
            PG8_WAIT_V(8); PG8_WAIT_L(0); PG8_BAR; PG8_MMA(1, 0, At, B0); PG8_MMA(1, 1, At, B1); PG8_BAR; PG8_SCHED;
            } else {
            PG8_LDB(B0, 0, 0); PG8_SCHED; PG8_LDA(At, 0, 0); PG8_STAGE(PG8_SA(1, 1), a1 + hstep, voffA);
            PG8_WAIT_L(8); PG8_BAR; PG8_WAIT_L(0); PG8_MMA(0, 0, At, B0); PG8_BAR; PG8_SCHED;
            PG8_LDB(B1, 0, 1); PG8_STAGE(PG8_SB(0, 0), b2, voffB);
            PG8_BAR; PG8_WAIT_L(0); PG8_MMA(0, 1, At, B1); PG8_BAR;
            PG8_LDA(At, 0, 1); PG8_STAGE(PG8_SA(0, 0), a2, voffA);
            PG8_BAR; PG8_WAIT_L(0); PG8_MMA(1, 0, At, B0); PG8_BAR; PG8_SCHED;
            PG8_STAGE(PG8_SB(0, 1), b2 + hstep, voffB);
            PG8_WAIT_V(6); PG8_BAR; PG8_MMA(1, 1, At, B1); PG8_BAR;
            PG8_LDB(B0, 1, 0); PG8_SCHED; PG8_LDA(At, 1, 0); PG8_STAGE(PG8_SA(0, 1), a2 + hstep, voffA);
            PG8_WAIT_L(8); PG8_BAR; PG8_WAIT_L(0); PG8_MMA(0, 0, At, B0); PG8_BAR; PG8_SCHED;
            PG8_LDB(B1, 1, 1); PG8_STAGE(PG8_SB(1, 0), b3, voffB);
            PG8_BAR; PG8_WAIT_L(0); PG8_MMA(0, 1, At, B1); PG8_BAR;
            PG8_LDA(At, 1, 1); PG8_STAGE(PG8_SA(1, 0), a3, voffA);
            PG8_BAR; PG8_WAIT_L(0); PG8_MMA(1, 0, At, B0); PG8_BAR; PG8_SCHED;
            PG8_STAGE(PG8_SB(1, 1), b3 + hstep, voffB);
            PG8_WAIT_V(6); PG8_BAR; PG8_MMA(1, 1, At, B1); PG8_BAR;
            }
        }
        if constexpr (ALIGN_EPI) { if (wr == 0) PG8_BAR; }
        if constexpr (!Epi::AFTER_DRAIN) { E(acc, cur, wr, wc, fr, fq); S.done(cur); }
        if (!has_next) break;
#pragma unroll
        for (int a = 0; a < 2; ++a)
#pragma unroll
            for (int b = 0; b < 2; ++b)
#pragma unroll
                for (int m = 0; m < 4; ++m)
#pragma unroll
                    for (int n = 0; n < 2; ++n) acc[a][b][m][n] = (f32x4){0.f, 0.f, 0.f, 0.f};
        cur = nxt; cA = nA; cB = nB; ++ui;
        if constexpr (ALIGN_EPI) { if (wr == 1) PG8_BAR; }
    }
    PG8_WAIT_V(0);
    if constexpr (!ALIGN_EPI) { if (wr == 0) PG8_BAR; }
    PG8_BAR;
#undef PG8_SA
#undef PG8_SB
#undef PG8_STAGE
#undef PG8_LDA
#undef PG8_LDB
#undef PG8_MMA
#undef PG8_WAIT_V
#undef PG8_WAIT_L
#undef PG8_BAR
#undef PG8_SCHED
}
}

namespace att {
#define ATT_LAS __attribute__((address_space(3)))
typedef unsigned short bf16_t;
typedef short bf16x8 __attribute__((ext_vector_type(8)));
typedef short s16x4 __attribute__((ext_vector_type(4)));
typedef float f32x16 __attribute__((ext_vector_type(16)));
typedef unsigned u32x4 __attribute__((ext_vector_type(4)));
typedef unsigned u32x2 __attribute__((ext_vector_type(2)));
__device__ __forceinline__ int crow(int r, int hi) { return (r & 3) + 8 * (r >> 2) + 4 * hi; }
__device__ __forceinline__ unsigned swz(int row, int ch) { return (unsigned)(row * 128 + ((ch ^ ((((row >> 1) & 1) << 2) | ((row >> 2) & 3))) << 4)); }
__device__ __forceinline__ float swap32f(float v) { auto rr = __builtin_amdgcn_permlane32_swap(__float_as_uint(v), __float_as_uint(v), false, false); return (threadIdx.x & 32) ? __uint_as_float(rr[0]) : __uint_as_float(rr[1]); }
__device__ __forceinline__ unsigned pk(float lo, float hi) { unsigned r; asm volatile("v_cvt_pk_bf16_f32 %0, %1, %2" : "=v"(r) : "v"(lo), "v"(hi)); return r; }

struct AU { const bf16_t* Q; const bf16_t* K; const bf16_t* V; bf16_t* O; size_t rstride, ostride; int L, q0; const float* sink; float* lse; size_t lstride; };

template <int W, bool SINK, bool LSEOUT, class Dec, bool SKIPT = false>
__device__ __forceinline__ void phase(ATT_LAS unsigned char* lds, int ub, int ue, const Dec& dec) {
    constexpr int NK = 64 + 2 * W, NCH = NK * 8, PER = NCH / 512, NT = 2 * W / 32 + 1, VOFF = NK * 128;
    static_assert(NCH % 512 == 0, "staging split");
    if (ub >= ue) return;
    const int tid = threadIdx.x, lane = tid & 63, r32 = lane & 31, hi = lane >> 5, wid = __builtin_amdgcn_readfirstlane(tid >> 6), h = wid & 3, sb = wid >> 2;
    const int qq = (lane & 15) >> 2, p = lane & 3, blk = (lane >> 4) & 1;
    const int fk = (((r32 >> 1) & 1) << 2) | ((r32 >> 2) & 3);
    unsigned kaddr[4];
#pragma unroll
    for (int d0 = 0; d0 < 4; ++d0) kaddr[d0] = (unsigned)(r32 * 128 + (((2 * d0 + hi) ^ fk) << 4));
    unsigned vaddr[2][2];
#pragma unroll
    for (int c = 0; c < 2; ++c)
#pragma unroll
        for (int hf = 0; hf < 2; ++hf) { const int fv = ((qq >> 1) << 2) | ((2 * hf + hi) & 3);
            vaddr[c][hf] = (unsigned)(VOFF + (8 * hf + 4 * hi + qq) * 128 + (((4 * c + 2 * blk + (p >> 1)) ^ fv) << 4) + 8 * (p & 1)); }
    u32x4 kreg[PER], vreg[PER]; unsigned kmask[PER]; bf16x8 qn[4]; float sinkn = 0.f;
#define ATT_LOAD(U) do { \
        _Pragma("unroll") for (int i_ = 0; i_ < PER; ++i_) { const int cid_ = tid + 512 * i_, row_ = cid_ >> 3, ch_ = cid_ & 7, kp_ = (U).q0 - W + row_; \
            const int kc_ = min(max(kp_, 0), (U).L - 1); const unsigned ok_ = (kp_ == kc_) ? 0xffffffffu : 0u;     \
            kreg[i_] = *(const u32x4*)((U).K + (size_t)kc_ * (U).rstride + ch_ * 8); vreg[i_] = *(const u32x4*)((U).V + (size_t)kc_ * (U).rstride + ch_ * 8); kmask[i_] = ok_; } \
        { const bf16_t* qp_ = (U).Q + (size_t)((U).q0 + 32 * sb + r32) * (U).rstride + h * 64 + 8 * hi; \
          if (SINK) sinkn = (U).sink[h]; \
          _Pragma("unroll") for (int d0_ = 0; d0_ < 4; ++d0_) qn[d0_] = *(const bf16x8*)(qp_ + 16 * d0_); } } while (0)
#define ATT_PIN() asm volatile("" : "+v"(qn[3]))
    AU cur = dec(ub);
    ATT_LOAD(cur); ATT_PIN();
    for (int u = ub; u < ue; ++u) {
        const float sink2 = sinkn * 1.4426950408889634f;
#pragma unroll
        for (int i = 0; i < PER; ++i) { const int cid = tid + 512 * i, row = cid >> 3, ch = cid & 7; const unsigned o = swz(row, ch);
            *(ATT_LAS u32x4*)(lds + o) = kreg[i] & kmask[i]; *(ATT_LAS u32x4*)(lds + VOFF + o) = vreg[i] & kmask[i]; }
        bf16x8 qf[4];
#pragma unroll
        for (int d0 = 0; d0 < 4; ++d0) qf[d0] = qn[d0];
        asm volatile("s_waitcnt lgkmcnt(0)" ::: "memory"); __builtin_amdgcn_s_barrier(); asm volatile("" ::: "memory");
        const AU nxt = dec(min(u + 1, ue - 1));
        ATT_LOAD(nxt);
        const int q0 = cur.q0, L = cur.L; const int qrow = q0 + 32 * sb + r32;
        float m = 0.f, l = 0.f; f32x16 o0 = {}, o1 = {}, negm = {};
        const float NEG = -INFINITY;
        const int tb = q0 - W + 32 * sb;
        const int j0 = tb < 0 ? (-tb) >> 5 : 0; const int j1 = SKIPT ? j0 - 1 : min(NT - 1, (L - 32 - tb) >> 5);
        bf16x8 kf[4];
        { const unsigned rb0 = (unsigned)((32 * sb + 32 * j0) * 128);
#pragma unroll
          for (int d0 = 0; d0 < 4; ++d0) kf[d0] = *(const ATT_LAS bf16x8*)(lds + rb0 + kaddr[d0]); }
        for (int j = j0; j <= j1; ++j) {
            const unsigned rb = (unsigned)((32 * sb + 32 * j) * 128);
            f32x16 S = negm;
#pragma unroll
            for (int d0 = 0; d0 < 4; ++d0) S = __builtin_amdgcn_mfma_f32_32x32x16_bf16(kf[d0], qf[d0], S, 0, 0, 0);
            s16x4 vv[2][2][2];
#pragma unroll
            for (int s2 = 0; s2 < 2; ++s2)
#pragma unroll
                for (int c = 0; c < 2; ++c)
#pragma unroll
                    for (int hf = 0; hf < 2; ++hf) vv[s2][c][hf] = __builtin_bit_cast(s16x4, __builtin_amdgcn_ds_read_tr16_b64_v4i16((ATT_LAS s16x4*)(lds + rb + s2 * 2048 + vaddr[c][hf])));
            { const unsigned rbn = j < j1 ? rb + 4096u : rb;
#pragma unroll
              for (int d0 = 0; d0 < 4; ++d0) kf[d0] = *(const ATT_LAS bf16x8*)(lds + rbn + kaddr[d0]); }
            __builtin_amdgcn_sched_barrier(0);
            if (j == 0) {
#pragma unroll
                for (int r = 0; r < 16; ++r) if (crow(r, hi) < r32) S[r] = NEG; }
            if (j == NT - 1) {
#pragma unroll
                for (int r = 0; r < 16; ++r) if (crow(r, hi) > r32) S[r] = NEG; }
            float mx = fmaxf(fmaxf(S[0], S[1]), S[2]);
#pragma unroll
            for (int r = 3; r < 15; r += 2) mx = fmaxf(fmaxf(mx, S[r]), S[r + 1]);
            mx = fmaxf(mx, S[15]);
            { auto rr = __builtin_amdgcn_permlane32_swap(__float_as_uint(mx), __float_as_uint(mx), false, false); mx = fmaxf(__uint_as_float(rr[0]), __uint_as_float(rr[1])); }
            if (j == j0) {
                float mr = mx; if (SINK) mr = fmaxf(mr, sink2);
                m = mr; l = 0.f; if (SINK) l = hi == 0 ? __builtin_amdgcn_exp2f(sink2 - mr) : 0.f;
#pragma unroll
                for (int r = 0; r < 16; ++r) { S[r] -= mr; negm[r] = -mr; }
            } else if (__builtin_amdgcn_ballot_w64(mx > 8.0f) != 0ull) {
                const float d = fmaxf(mx, 0.f), alpha = __builtin_amdgcn_exp2f(-d); m += d; l *= alpha;
#pragma unroll
                for (int r = 0; r < 16; ++r) { S[r] -= d; negm[r] = -m; o0[r] *= alpha; o1[r] *= alpha; }
            }
            float ls0 = 0.f, ls1 = 0.f;
#pragma unroll
            for (int r = 0; r < 16; r += 2) { S[r] = __builtin_amdgcn_exp2f(S[r]); S[r + 1] = __builtin_amdgcn_exp2f(S[r + 1]); ls0 += S[r]; ls1 += S[r + 1]; }
            l += ls0 + ls1;
            u32x4 pw0, pw1;
            pw0.x = pk(S[0], S[1]); pw0.y = pk(S[2], S[3]); pw0.z = pk(S[4], S[5]); pw0.w = pk(S[6], S[7]);
            pw1.x = pk(S[8], S[9]); pw1.y = pk(S[10], S[11]); pw1.z = pk(S[12], S[13]); pw1.w = pk(S[14], S[15]);
            const bf16x8 pa0 = __builtin_bit_cast(bf16x8, pw0), pa1 = __builtin_bit_cast(bf16x8, pw1);
#pragma unroll
            for (int s2 = 0; s2 < 2; ++s2) {
                const bf16x8 pa = s2 ? pa1 : pa0;
#pragma unroll
                for (int c = 0; c < 2; ++c) {
                    const s16x4 v0 = vv[s2][c][0], v1 = vv[s2][c][1];
                    const bf16x8 vf = (bf16x8){v0[0], v0[1], v0[2], v0[3], v1[0], v1[1], v1[2], v1[3]};
                    if (c == 0) o0 = __builtin_amdgcn_mfma_f32_32x32x16_bf16(vf, pa, o0, 0, 0, 0); else o1 = __builtin_amdgcn_mfma_f32_32x32x16_bf16(vf, pa, o1, 0, 0, 0);
                }
            }
        }
        float lt; { auto rr = __builtin_amdgcn_permlane32_swap(__float_as_uint(l), __float_as_uint(l), false, false); lt = __uint_as_float(rr[0]) + __uint_as_float(rr[1]); }
        const float inv = 1.0f / lt;
        bf16_t* op = cur.O + (size_t)qrow * cur.ostride + h * 64 + 4 * hi;
#pragma unroll
        for (int g = 0; g < 4; ++g) {
            u32x2 w0, w1; w0.x = pk(o0[4 * g] * inv, o0[4 * g + 1] * inv); w0.y = pk(o0[4 * g + 2] * inv, o0[4 * g + 3] * inv);
            w1.x = pk(o1[4 * g] * inv, o1[4 * g + 1] * inv); w1.y = pk(o1[4 * g + 2] * inv, o1[4 * g + 3] * inv);
            *(u32x2*)(op + 8 * g) = w0; *(u32x2*)(op + 32 + 8 * g) = w1; }
        if (LSEOUT) { if (hi == 0) cur.lse[(size_t)qrow * cur.lstride + h] = m + __builtin_amdgcn_logf(lt); }
        asm volatile("s_waitcnt lgkmcnt(0)" ::: "memory"); __builtin_amdgcn_s_barrier(); asm volatile("" ::: "memory");
        ATT_PIN();
        cur = nxt;
    }
#undef ATT_LOAD
#undef ATT_PIN
}
}

#define LAS __attribute__((address_space(3)))
typedef unsigned short bf16;
typedef unsigned v4u __attribute__((ext_vector_type(4)));
typedef float f32x4 __attribute__((ext_vector_type(4)));
constexpr int NWAVES = 8, NTHREADS = 512;
constexpr int BATCH = 32, SEQ = 2048, DM = 1024, T = BATCH * SEQ, DFF = 2816, QKVW = 1536, NH = 16;
constexpr int LDS_BYTES = 135168;
constexpr size_t MiB = 1u << 20;
constexpr size_t WS_WIN0 = 0;
constexpr size_t WS_WOUT0 = WS_WIN0 + (size_t)1536 * 1024 * 2;
constexpr size_t WS_WIN1 = WS_WOUT0 + (size_t)1024 * 1024 * 2;
constexpr size_t WS_WOUT1 = WS_WIN1 + (size_t)4608 * 1024 * 2;
constexpr size_t WS_WGU0 = WS_WOUT1 + (size_t)1024 * 1024 * 2;
constexpr size_t WS_WGU1 = WS_WGU0 + (size_t)5632 * 1024 * 2;
constexpr size_t WS_WD0 = WS_WGU1 + (size_t)5632 * 1024 * 2;
constexpr size_t WS_WD1 = WS_WD0 + (size_t)1024 * 2816 * 2;
constexpr size_t WS_COS = WS_WD1 + (size_t)1024 * 2816 * 2;
constexpr size_t WS_SIN = WS_COS + (size_t)2048 * 32 * 4;
constexpr size_t WS_SSQ = WS_SIN + (size_t)2048 * 32 * 4;
constexpr size_t WS_LSE = WS_SSQ + (size_t)5 * T * 4;
constexpr size_t WS_CTL = 71 * MiB;
constexpr size_t WS_ROT = 71 * MiB + 65536;
constexpr size_t WS_XB = 72 * MiB;
constexpr size_t WS_O = WS_XB + 128 * MiB;
constexpr size_t WS_BIG = WS_O + 128 * MiB;
constexpr size_t WS_END = WS_BIG + (size_t)T * 4608 * 2;
static_assert(WS_LSE + (size_t)3 * T * 16 * 4 <= WS_XB, "ws map");

__device__ __forceinline__ unsigned f2bf(float f) { unsigned u = __builtin_bit_cast(unsigned, f); return (u + 0x7fffu + ((u >> 16) & 1u)) >> 16; }
__device__ __forceinline__ unsigned pk2(float lo, float hi) { return f2bf(lo) | (f2bf(hi) << 16); }
__device__ __forceinline__ float wave_sum(float v) {
#pragma unroll
    for (int o = 1; o < 64; o <<= 1) v += __shfl_xor(v, o);
    return v;
}
__device__ __forceinline__ void transpose_item(const float* Wa, const float* Wb, int mode, const float* gain, int K, int Nsrc, bf16* WT, int nblk, LAS float* scr, int item, int lane) {
    const int kb = item / nblk, nb = item % nblk, k0 = 64 * kb, n0 = 32 * nb;
    const int np = n0 + (lane & 31); const float* W = Wa; int ncol = np;
    if (mode == 1) { const int grp = np / 1536; int c = np % 1536;
        if (c < 1280) { const int head = c >> 6, pp = c & 63, j = pp >> 3, e = pp & 7; c = head * 64 + (e < 4 ? 4 * j + e : 32 + 4 * j + (e - 4)); }
        ncol = grp * 1536 + c; }
    else if (mode == 2) { const int pn = np >> 8, wi = np & 255; W = (wi >> 7) ? Wb : Wa; ncol = pn * 128 + (wi & 127); }
    float wv[32], gv[32];
#pragma unroll
    for (int i = 0; i < 32; ++i) { const int kk = 2 * i + (lane >> 5); wv[i] = W[(size_t)(k0 + kk) * Nsrc + ncol]; gv[i] = gain ? gain[k0 + kk] : 1.0f; }
#pragma unroll
    for (int i = 0; i < 32; ++i) { const int kk = 2 * i + (lane >> 5); scr[kk * 33 + (lane & 31)] = wv[i] * gv[i]; }
    asm volatile("s_waitcnt lgkmcnt(0)" ::: "memory");
    const int c = lane & 7;
#pragma unroll
    for (int j = 0; j < 4; ++j) { const int n = (lane >> 3) + 8 * j; const LAS float* s = scr + (8 * c) * 33 + n;
        v4u o; o.x = pk2(s[0 * 33], s[1 * 33]); o.y = pk2(s[2 * 33], s[3 * 33]); o.z = pk2(s[4 * 33], s[5 * 33]); o.w = pk2(s[6 * 33], s[7 * 33]);
        *(v4u*)(WT + (size_t)(n0 + n) * K + k0 + 8 * c) = o; }
    asm volatile("s_waitcnt lgkmcnt(0)" ::: "memory");
}

#define XB_TMO      128
#define XB_XCNT(j)  (256  + 64 * (j))
#define XB_XSUB(j)  (1280 + 64 * (j))
#define XB_XGEN(j)  (2304 + 64 * (j))
#define XB_TOP      3328
#define XB_TOPGEN   3392
#define XCD_BAR_WORDS 3456
#define XB_SPIN_CAP (1u << 18)
__device__ __forceinline__ unsigned xb_ld(unsigned* p)              { return __hip_atomic_load(p, __ATOMIC_RELAXED, __HIP_MEMORY_SCOPE_AGENT); }
__device__ __forceinline__ unsigned xb_add(unsigned* p, unsigned v) { return __hip_atomic_fetch_add(p, v, __ATOMIC_RELAXED, __HIP_MEMORY_SCOPE_AGENT); }
__device__ __forceinline__ unsigned xb_xcc_id() { return (unsigned)__builtin_amdgcn_s_getreg((3 << 11) | 20) & 0xFu; }
#define XB_SPIN(cond, bar) do { unsigned _sp = 0; while (cond) { __builtin_amdgcn_s_sleep(1); \
    if ((++_sp & 255u) == 0u) { if (xb_ld(&(bar)[XB_TMO])) break; if (_sp > XB_SPIN_CAP) { atomicAdd(&(bar)[XB_TMO], 1u); break; } } } } while (0)
struct XcdBarrier { unsigned* bar; unsigned x; volatile LAS unsigned* st; };
__device__ __forceinline__ XcdBarrier xcd_barrier_post(unsigned* bar, volatile LAS unsigned* st) {
    XcdBarrier b; b.bar = bar; b.x = xb_xcc_id(); b.st = st;
    if (threadIdx.x == 0) (void)xb_add(&bar[XB_XCNT(b.x)], 1u);
    return b;
}
__device__ __forceinline__ void xcd_barrier_complete(unsigned* bar, unsigned x, unsigned& nloc, unsigned& nx) {
    const unsigned G = gridDim.x * gridDim.y * gridDim.z;
    unsigned sum, cnt, mine, sp = 0u;
    for (;;) {
        sum = 0u; cnt = 0u; mine = 0u;
#pragma unroll
        for (unsigned j = 0; j < 16; ++j) { const unsigned c = xb_ld(&bar[XB_XCNT(j)]); sum += c; cnt += (c > 0u) ? 1u : 0u; mine = (j == x) ? c : mine; }
        if (sum == G) break;
        __builtin_amdgcn_s_sleep(1);
        if ((++sp & 255u) == 0u) { if (xb_ld(&bar[XB_TMO])) break; if (sp > XB_SPIN_CAP) { atomicAdd(&bar[XB_TMO], 1u); break; } }
    }
    nloc = mine > 0u ? mine : 1u; nx = cnt > 0u ? cnt : 1u;
}
__device__ __forceinline__ void xcd_barrier(const XcdBarrier& b) {
    asm volatile("s_waitcnt vmcnt(0)" ::: "memory");
    __syncthreads();
    if (threadIdx.x == 0) {
        unsigned* bar = b.bar;
        __builtin_amdgcn_s_waitcnt(0);
        unsigned nloc = b.st[0], nx = b.st[1];
        if (nloc == 0u) { xcd_barrier_complete(bar, b.x, nloc, nx); b.st[0] = nloc; b.st[1] = nx; }
        const unsigned old = xb_add(&bar[XB_XSUB(b.x)], 1u);
        const unsigned gen = old / nloc;
        if (old + 1u == (gen + 1u) * nloc) {
            __builtin_amdgcn_fence(__ATOMIC_RELEASE, "agent");
            asm volatile("s_waitcnt vmcnt(0)" ::: "memory");
            const unsigned og = xb_add(&bar[XB_TOP], 1u);
            const unsigned tg = og / nx;
            if (og + 1u == (tg + 1u) * nx) xb_add(&bar[XB_TOPGEN], 1u);
            else XB_SPIN(xb_ld(&bar[XB_TOPGEN]) == tg, bar);
            __builtin_amdgcn_fence(__ATOMIC_ACQUIRE, "agent");
            xb_add(&bar[XB_XGEN(b.x)], 1u);
            asm volatile("s_waitcnt vmcnt(0)" ::: "memory");
        } else {
            XB_SPIN(xb_ld(&bar[XB_XGEN(b.x)]) == gen, bar);
            __builtin_amdgcn_fence(__ATOMIC_ACQUIRE, "agent");
            asm volatile("s_waitcnt vmcnt(0)" ::: "memory");
        }
    }
    __syncthreads();
}

#define XB_LOC(j) (3456 + 64 * (j))
__device__ __forceinline__ void xcd_local_barrier(unsigned* bar, unsigned x, unsigned nloc, unsigned epoch) {
    asm volatile("s_waitcnt vmcnt(0)" ::: "memory");
    __syncthreads();
    if (threadIdx.x == 0) {
        __builtin_amdgcn_s_waitcnt(0);
        (void)xb_add(&bar[XB_LOC(x)], 1u);
        const unsigned target = epoch * nloc;
        XB_SPIN(xb_ld(&bar[XB_LOC(x)]) < target, bar);
        __builtin_amdgcn_fence(__ATOMIC_ACQUIRE, "agent");
        asm volatile("s_waitcnt vmcnt(0)" ::: "memory");
    }
    __syncthreads();
}

struct Args {
    const float* x; const float* a_w_in; const float* a_sink; const float* a_w_out; const float* b_w_in; const float* b_w_out;
    const float* norm_mix; const float* norm_ffn; const float* w_gate; const float* w_up; const float* w_down; const float* final_norm;
    float* out; unsigned char* ws; int ph_lo, ph_hi;
};
constexpr int N_PHASES = 13;

__global__ void __launch_bounds__(NTHREADS, 2) mega_fwd(Args a) {
    extern __shared__ __attribute__((aligned(16))) unsigned char lds_raw[];
    LAS unsigned char* lds = (LAS unsigned char*)lds_raw;
    const int tid = threadIdx.x, lane = tid & 63, wave = __builtin_amdgcn_readfirstlane(tid >> 6);
    const int G = gridDim.x, bid = blockIdx.x;
    unsigned char* ws = a.ws;
    bf16* Win0 = (bf16*)(ws + WS_WIN0); bf16* Wout0 = (bf16*)(ws + WS_WOUT0); bf16* Win1 = (bf16*)(ws + WS_WIN1); bf16* Wout1 = (bf16*)(ws + WS_WOUT1);
    bf16* Wgu0 = (bf16*)(ws + WS_WGU0); bf16* Wgu1 = (bf16*)(ws + WS_WGU1); bf16* Wd0 = (bf16*)(ws + WS_WD0); bf16* Wd1 = (bf16*)(ws + WS_WD1);
    float* cosT = (float*)(ws + WS_COS); float* sinT = (float*)(ws + WS_SIN); float* rotT = (float*)(ws + WS_ROT); unsigned* ssq = (unsigned*)(ws + WS_SSQ); float* lse = (float*)(ws + WS_LSE);
    bf16* XB = (bf16*)(ws + WS_XB); bf16* OB = (bf16*)(ws + WS_O); bf16* BIG = (bf16*)(ws + WS_BIG);
    float* X = a.out;
    const int lo = a.ph_lo, hi_ph = a.ph_hi;
    unsigned* ctl = (unsigned*)(ws + WS_CTL);
    LAS unsigned* ldsctl = (LAS unsigned*)(lds + 133120);
    if (tid < 8) ldsctl[tid] = 0u;
    __syncthreads();
    XcdBarrier xbar; xbar.bar = ctl; xbar.x = 0; xbar.st = nullptr;
    if (MK_N_LAUNCHES == 1) { xbar.bar = ctl; xbar.x = xb_xcc_id(); xbar.st = (volatile LAS unsigned*)(ldsctl + 2);
        if (tid == 0) ldsctl[4] = xb_add(&ctl[XB_XCNT(xbar.x)], 1u); }
    int vid = bid, bidA = bid; bool local_mode = false; unsigned lepoch = 0u;
    if (a.ph_lo < 0) cg::this_grid().sync();
#define IN(k) (lo <= (k) && (k) < hi_ph)
#define GSYNC() do { asm volatile("s_waitcnt vmcnt(0) lgkmcnt(0)" ::: "memory"); cg::this_grid().sync(); } while (0)
#define SEAM(k) do { if (IN(k) && IN((k) + 1)) { if (local_mode) { ++lepoch; xcd_local_barrier(ctl, xbar.x, (unsigned)(G / 8), lepoch); } else { xcd_barrier(xbar); } } } while (0)
#define STAGGER() do { if (STAGGER_US > 0) { const unsigned long long t0_ = __builtin_amdgcn_s_memrealtime(); const unsigned long long d_ = (unsigned long long)((bid >> 3) & 7) * (unsigned long long)(STAGGER_US * 100 / 8); \
        while (__builtin_amdgcn_s_memrealtime() - t0_ < d_) __builtin_amdgcn_s_sleep(8); } } while (0)

    if (IN(0)) {
        LAS float* scr = (LAS float*)(lds + wave * 16384);
        const int gw = bid * NWAVES + wave, NGW = G * NWAVES;
        constexpr int I_IN0 = 16 * 48, I_OUT = 16 * 32, I_IN1 = 16 * 144, I_GU = 16 * 176, I_D = 44 * 32;
        constexpr int NITEMS = I_IN0 + 2 * I_OUT + I_IN1 + 2 * I_GU + 2 * I_D;
        for (int it = gw; it < NITEMS; it += NGW) {
            int r = it;
            if (r < I_IN0) { transpose_item(a.a_w_in, nullptr, 1, a.norm_mix, 1024, 1536, Win0, 48, scr, r, lane); continue; } r -= I_IN0;
            if (r < I_OUT) { transpose_item(a.a_w_out, nullptr, 0, nullptr, 1024, 1024, Wout0, 32, scr, r, lane); continue; } r -= I_OUT;
            if (r < I_IN1) { transpose_item(a.b_w_in, nullptr, 1, a.norm_mix + 1024, 1024, 4608, Win1, 144, scr, r, lane); continue; } r -= I_IN1;
            if (r < I_OUT) { transpose_item(a.b_w_out, nullptr, 0, nullptr, 1024, 1024, Wout1, 32, scr, r, lane); continue; } r -= I_OUT;
            if (r < I_GU) { transpose_item(a.w_gate, a.w_up, 2, a.norm_ffn, 1024, 2816, Wgu0, 176, scr, r, lane); continue; } r -= I_GU;
            if (r < I_GU) { transpose_item(a.w_gate + (size_t)1024 * 2816, a.w_up + (size_t)1024 * 2816, 2, a.norm_ffn + 1024, 1024, 2816, Wgu1, 176, scr, r, lane); continue; } r -= I_GU;
            if (r < I_D) { transpose_item(a.w_down, nullptr, 0, nullptr, 2816, 1024, Wd0, 32, scr, r, lane); continue; } r -= I_D;
            transpose_item(a.w_down + (size_t)2816 * 1024, nullptr, 0, nullptr, 2816, 1024, Wd1, 32, scr, r, lane);
        }
        const int gt = bid * NTHREADS + tid, NGT = G * NTHREADS;
        for (int i = gt; i < 2048 * 32; i += NGT) {
            const int t = i >> 5, f = i & 31; double inv = 1.0; for (int k = 0; k < f; ++k) inv *= 0.74989420933245583;
            double rev = (double)t * inv * 0.15915494309189535; rev = rev - __builtin_floor(rev); const float fr = (float)rev;
            cosT[i] = __builtin_amdgcn_cosf(fr); sinT[i] = __builtin_amdgcn_sinf(fr);
        }
        if (gt < 32) { double inv = 1.0; for (int k = 0; k < gt; ++k) inv *= 0.74989420933245583;
            double r16 = 16.0 * inv * 0.15915494309189535; r16 -= __builtin_floor(r16); double r128 = 128.0 * inv * 0.15915494309189535; r128 -= __builtin_floor(r128);
            rotT[gt] = __builtin_amdgcn_cosf((float)r16); rotT[32 + gt] = __builtin_amdgcn_sinf((float)r16); rotT[64 + gt] = __builtin_amdgcn_cosf((float)r128); rotT[96 + gt] = __builtin_amdgcn_sinf((float)r128); }
        for (int i = gt; i < 4 * T; i += NGT) ssq[T + i] = 0u;
        for (int row = gw; row < T; row += 4 * NGW) {
            f32x4 v[4][4];
#pragma unroll
            for (int q = 0; q < 4; ++q) { const int rq = min(row + q * NGW, T - 1); const f32x4* xr = (const f32x4*)(a.x + (size_t)rq * DM) + lane;
#pragma unroll
                for (int j = 0; j < 4; ++j) v[q][j] = xr[64 * j]; }
#pragma unroll
            for (int q = 0; q < 4; ++q) { const int rq = row + q * NGW; if (rq < T) { float s = 0.f;
#pragma unroll
                for (int j = 0; j < 4; ++j) s += (v[q][j].x * v[q][j].x + v[q][j].y * v[q][j].y) + (v[q][j].z * v[q][j].z + v[q][j].w * v[q][j].w);
                s = wave_sum(s); if (lane == 0) ssq[rq] = (unsigned)(s * pg8::SSQ_SCALE + 0.5f);
                unsigned long long* o8 = (unsigned long long*)(XB + (size_t)rq * DM) + lane;
#pragma unroll
                for (int j = 0; j < 4; ++j) o8[64 * j] = (unsigned long long)pk2(v[q][j].x, v[q][j].y) | ((unsigned long long)pk2(v[q][j].z, v[q][j].w) << 32); } }
        }
        __syncthreads();
    }
    SEAM(0);
    if (MK_N_LAUNCHES == 1 && XCD_LOCAL && IN(0) && IN(1)) {
        bool okc = (G % 8) == 0 && (G / 8) == 32;
        for (int j = 0; j < 16; ++j) { const unsigned c = xb_ld(&ctl[XB_XCNT(j)]); okc = okc && (j < 8 ? c == (unsigned)(G / 8) : c == 0u); }
        okc = okc && xbar.x < 8u;
        if (okc) { const int xl = (int)ldsctl[4]; local_mode = true; vid = xl * 8 + (int)xbar.x; bidA = (int)xbar.x * 32 + xl; }
    }
    const size_t SLICE = (size_t)8192 * 4608;
    const size_t xsel = local_mode ? (size_t)xbar.x : 0;
    bf16* BIGQ = BIG + xsel * (SLICE - (size_t)8192 * QKVW);
    bf16* BIGH = BIG + xsel * (SLICE - (size_t)8192 * DFF);
    bf16* BIGP = BIG;
    if (IN(1)) _Pragma("unroll") for (int rep = 0; rep < (PROBE_DUP == 1 ? 2 : 1); ++rep) {
        if (rep) GSYNC();
        pg8::Gemm g{XB, Win0, T, QKVW, DM}; pg8::StaticOrder S; S.init(T, QKVW, G, vid);
        pg8::EpiQKV E{BIGQ, QKVW, ssq, cosT, sinT, rotT};
        STAGGER();
        pg8::gemm_phase<pg8::EpiQKV, pg8::StaticOrder, true, true>(lds, g, S, E);
    }
    SEAM(1);
    if (IN(2)) _Pragma("unroll") for (int rep = 0; rep < (PROBE_DUP == 2 ? 2 : 1); ++rep) {
        if (rep) GSYNC();
        constexpr int NU = BATCH * 4 * 32; const int per = (NU + G - 1) / G;
        const bf16* BIGc = BIGQ; bf16* OBc = OB; const float* sinkp = a.a_sink;
        auto dec = [=](int u) { const int qb = u & 31, kvh = (u >> 5) & 3, b = u >> 7; const bf16* base = BIGc + (size_t)b * SEQ * QKVW;
            return att::AU{base + kvh * 256, base + 1024 + kvh * 64, base + 1280 + kvh * 64, OBc + (size_t)b * SEQ * DM + kvh * 256, (size_t)QKVW, (size_t)DM, SEQ, qb * 64, sinkp + kvh * 4, nullptr, 0}; };
        att::phase<128, true, false>(lds, min(NU, bidA * per), min(NU, (bidA + 1) * per), dec);
    }
    SEAM(2);
    if (IN(3)) {
        pg8::Gemm g{OB, Wout0, T, DM, DM}; pg8::StaticOrder S; S.init(T, DM, G, vid);
        pg8::EpiRes E{XB, ssq + T};
        STAGGER();
        pg8::gemm_phase<pg8::EpiRes, pg8::StaticOrder, true, true>(lds, g, S, E);
    }
    SEAM(3);
    if (IN(4)) _Pragma("unroll") for (int rep = 0; rep < (PROBE_DUP == 4 ? 2 : 1); ++rep) {
        if (rep) GSYNC();
        pg8::Gemm g{XB, Wgu0, T, 2 * DFF, DM}; pg8::StaticOrder S; S.init(T, 2 * DFF, G, vid);
        pg8::EpiSwiGLU E{BIGH, DFF, ssq + T};
        STAGGER();
        pg8::gemm_phase<pg8::EpiSwiGLU, pg8::StaticOrder, true, true>(lds, g, S, E);
    }
    SEAM(4);
    if (IN(5)) {
        pg8::Gemm g{BIGH, Wd0, T, DM, DFF}; pg8::StaticOrder S; S.init(T, DM, G, vid);
        pg8::EpiRes E{XB, ssq + 2 * T};
        STAGGER();
        pg8::gemm_phase<pg8::EpiRes, pg8::StaticOrder, true, true>(lds, g, S, E);
    }
    SEAM(5);
    if (IN(6)) _Pragma("unroll") for (int rep = 0; rep < (PROBE_DUP == 6 ? 2 : 1); ++rep) {
        if (rep) GSYNC();
        pg8::Gemm g{XB, Win1, T, 3 * QKVW, DM}; pg8::StaticOrder S; S.init(T, 3 * QKVW, G, vid);
        pg8::EpiQKV E{BIGP, 3 * QKVW, ssq + 2 * T, cosT, sinT, rotT};
        STAGGER();
        pg8::gemm_phase<pg8::EpiQKV, pg8::StaticOrder, true, true>(lds, g, S, E);
    }
    SEAM(6);
    if (IN(7)) {
        constexpr int NU = 3 * BATCH * 4 * 32; const int per = (NU + G - 1) / G;
        bf16* BIGc = BIGP; float* lsep = lse;
        auto dec = [=](int u) { const int xblk = u / 1536, rem = u % 1536, gidx = rem >> 9, v = rem & 511, b = 4 * xblk + (v >> 7), kvh = (v >> 5) & 3, qa = v & 31;
            const int dsh = 2 * gidx, dil = 1 << dsh, nbk = 32 >> dsh, r = qa / nbk, qb = qa % nbk;
            bf16* base = BIGc + ((size_t)b * SEQ + r) * (3 * QKVW) + gidx * QKVW;
            return att::AU{base + kvh * 256, base + 1024 + kvh * 64, base + 1280 + kvh * 64, base + kvh * 256, (size_t)dil * 3 * QKVW, (size_t)dil * 3 * QKVW, SEQ >> dsh, qb * 64, nullptr,
                           lsep + ((size_t)gidx * T + (size_t)b * SEQ + r) * NH + kvh * 4, (size_t)dil * NH}; };
        att::phase<64, false, true>(lds, min(NU, bidA * per), min(NU, (bidA + 1) * per), dec);
    }
    SEAM(7);
    if (IN(8)) {
        const int gt = bid * NTHREADS + tid, NGT = G * NTHREADS;
        const int tpw = T / G;
#pragma unroll 4
        for (int il = tid; il < tpw * 128; il += NTHREADS) {
            const int i = bidA * tpw * 128 + il;
            const int tok = i >> 7, ch = i & 127, head = ch >> 3;
            const float l0 = lse[(size_t)tok * NH + head], l1 = lse[((size_t)T + tok) * NH + head], l2 = lse[((size_t)2 * T + tok) * NH + head];
            const float mx = fmaxf(l0, fmaxf(l1, l2)); float w0 = __builtin_amdgcn_exp2f(l0 - mx), w1 = __builtin_amdgcn_exp2f(l1 - mx), w2 = __builtin_amdgcn_exp2f(l2 - mx);
            const float inv = 1.0f / (w0 + w1 + w2); w0 *= inv; w1 *= inv; w2 *= inv;
            const bf16* src = BIGP + (size_t)tok * (3 * QKVW) + ch * 8;
            const v4u a0 = *(const v4u*)src, a1 = *(const v4u*)(src + QKVW), a2 = *(const v4u*)(src + 2 * QKVW);
            v4u o;
#pragma unroll
            for (int e = 0; e < 4; ++e) {
                const float x0 = __uint_as_float(a0[e] << 16), y0 = __uint_as_float(a0[e] & 0xffff0000u);
                const float x1 = __uint_as_float(a1[e] << 16), y1 = __uint_as_float(a1[e] & 0xffff0000u);
                const float x2 = __uint_as_float(a2[e] << 16), y2 = __uint_as_float(a2[e] & 0xffff0000u);
                o[e] = pk2(w0 * x0 + w1 * x1 + w2 * x2, w0 * y0 + w1 * y1 + w2 * y2);
            }
            *(v4u*)(OB + (size_t)tok * DM + ch * 8) = o;
        }
    }
    SEAM(8);
    if (IN(9)) {
        pg8::Gemm g{OB, Wout1, T, DM, DM}; pg8::StaticOrder S; S.init(T, DM, G, vid);
        pg8::EpiRes E{XB, ssq + 3 * T};
        STAGGER();
        pg8::gemm_phase<pg8::EpiRes, pg8::StaticOrder, true, true>(lds, g, S, E);
    }
    SEAM(9);
    if (IN(10)) _Pragma("unroll") for (int rep = 0; rep < (PROBE_DUP == 10 ? 2 : 1); ++rep) {
        if (rep) GSYNC();
        pg8::Gemm g{XB, Wgu1, T, 2 * DFF, DM}; pg8::StaticOrder S; S.init(T, 2 * DFF, G, vid);
        pg8::EpiSwiGLU E{BIGH, DFF, ssq + 3 * T};
        STAGGER();
        pg8::gemm_phase<pg8::EpiSwiGLU, pg8::StaticOrder, true, true>(lds, g, S, E);
    }
    SEAM(10);
    if (IN(11)) {
        pg8::Gemm g{BIGH, Wd1, T, DM, DFF}; pg8::StaticOrder S; S.init(T, DM, G, vid);
        pg8::EpiRes E{XB, ssq + 4 * T};
        STAGGER();
        pg8::gemm_phase<pg8::EpiRes, pg8::StaticOrder, true, true>(lds, g, S, E);
    }
    SEAM(11);
    if (IN(12)) {
        const int gt = bid * NTHREADS + tid, NGT = G * NTHREADS;
        const int tpw = T / G;
#pragma unroll 4
        for (int il = tid; il < tpw * 128; il += NTHREADS) {
            const int i = bidA * tpw * 128 + il;
            const int row = i >> 7, ch = i & 127;
            const float rstd = __builtin_amdgcn_rsqf((float)ssq[4 * T + row] * pg8::SSQ_INV + pg8::RMS_EPS);
            const v4u v = *(const v4u*)(XB + (size_t)row * DM + ch * 8);
            const f32x4 g0 = *(const f32x4*)(a.final_norm + ch * 8), g1 = *(const f32x4*)(a.final_norm + ch * 8 + 4);
            const f32x4 o0 = (f32x4){__uint_as_float(v.x << 16), __uint_as_float(v.x & 0xffff0000u), __uint_as_float(v.y << 16), __uint_as_float(v.y & 0xffff0000u)};
            const f32x4 o1 = (f32x4){__uint_as_float(v.z << 16), __uint_as_float(v.z & 0xffff0000u), __uint_as_float(v.w << 16), __uint_as_float(v.w & 0xffff0000u)};
            float* orow = X + (size_t)row * DM + ch * 8;
            *(f32x4*)orow = o0 * rstd * g0; *(f32x4*)(orow + 4) = o1 * rstd * g1;
        }
    }
#undef IN
#undef SEAM
}

extern "C" void kernel_launch(void* const* d_in, const int* in_sizes, int n_in, void* d_out, int out_size, void* d_ws, size_t ws_size, hipStream_t stream) {
    static int grid = 0;
    if (grid == 0) {
        if (n_in != 12 || in_sizes[0] != T * DM || out_size != T * DM || ws_size < WS_END) {
            fprintf(stderr, "kernel_launch: unexpected shapes (n_in %d, in0 %d, out %d, ws %zu, need %zu)\n", n_in, n_in > 0 ? in_sizes[0] : -1, out_size, ws_size, (size_t)WS_END); grid = -1; return; }
        int dev = 0, cus = 0, per_cu = 0;
        hipGetDevice(&dev); hipDeviceGetAttribute(&cus, hipDeviceAttributeMultiprocessorCount, dev);
        if (hipFuncSetAttribute((const void*)mega_fwd, hipFuncAttributeMaxDynamicSharedMemorySize, LDS_BYTES) != hipSuccess) { fprintf(stderr, "kernel_launch: hipFuncSetAttribute failed\n"); grid = -1; return; }
        if (hipOccupancyMaxActiveBlocksPerMultiprocessor(&per_cu, (const void*)mega_fwd, NTHREADS, LDS_BYTES) != hipSuccess || per_cu < 1) { fprintf(stderr, "kernel_launch: occupancy query gave %d\n", per_cu); per_cu = 1; }
        (void)hipGetLastError();
        grid = cus * per_cu;
        if (T % grid != 0) { fprintf(stderr, "kernel_launch: grid %d does not divide the %d tokens\n", grid, T); grid = -1; return; }
    }
    if (grid < 0) return;
    Args a{};
    a.x = (const float*)d_in[0]; a.a_w_in = (const float*)d_in[1]; a.a_sink = (const float*)d_in[2]; a.a_w_out = (const float*)d_in[3];
    a.b_w_in = (const float*)d_in[4]; a.b_w_out = (const float*)d_in[5]; a.norm_mix = (const float*)d_in[6]; a.norm_ffn = (const float*)d_in[7];
    a.w_gate = (const float*)d_in[8]; a.w_up = (const float*)d_in[9]; a.w_down = (const float*)d_in[10]; a.final_norm = (const float*)d_in[11];
    a.out = (float*)d_out; a.ws = (unsigned char*)d_ws;
#if MK_N_LAUNCHES == 1
    (void)hipMemsetAsync((char*)d_ws + WS_CTL, 0, 16384, stream);
    a.ph_lo = 0; a.ph_hi = N_PHASES;
    void* args[] = {&a};
    hipError_t e = hipLaunchCooperativeKernel((const void*)mega_fwd, dim3(grid), dim3(NTHREADS), args, LDS_BYTES, stream);
    if (e != hipSuccess) fprintf(stderr, "cooperative launch failed: %s (grid %d)\n", hipGetErrorString(e), grid);
#else
    for (int p = 0; p < N_PHASES; ++p) { a.ph_lo = p; a.ph_hi = p + 1; hipLaunchKernelGGL(mega_fwd, dim3(grid), dim3(NTHREADS), LDS_BYTES, stream, a); }
#endif
}
```

```cpp
#include <hip/hip_runtime.h>
#include <hip/hip_cooperative_groups.h>
#include <cstdio>
#include <cstdint>
namespace cg = cooperative_groups;

#ifndef PROBE_DUP
#define PROBE_DUP -1
#endif
#ifndef STAGGER_US
#define STAGGER_US 0
#endif
#ifndef XCD_LOCAL
#define XCD_LOCAL 1
#endif
#ifndef MK_N_LAUNCHES
#define MK_N_LAUNCHES 1
#endif

namespace pg8 {
#define PG8_LAS __attribute__((address_space(3)))
typedef unsigned short bf16_t;
typedef short bf16x8 __attribute__((ext_vector_type(8)));
typedef float f32x4 __attribute__((ext_vector_type(4)));
typedef unsigned u32x4 __attribute__((ext_vector_type(4)));
typedef unsigned u32x2 __attribute__((ext_vector_type(2)));
constexpr int BM = 256, BK = 64, HALF = 128, HTB = HALF * BK * 2, STAGE_BYTES = 8 * HTB, NXCD = 8, WGM = 8;

__host__ __device__ __forceinline__ int lds_byte(int r, int c) { const int st = (r >> 4) * 2 + (c >> 5), rr = r & 15, cc = c & 31, ob = rr * 64 + cc * 2; return st * 1024 + (ob ^ (((ob >> 9) & 1) << 5)); }
__host__ __device__ __forceinline__ void stage_rc(int b, int& R, int& C) { const int st = b / 1024, sb = b % 1024, swz = sb ^ (((sb >> 9) & 1) << 5); R = (st >> 1) * 16 + swz / 64; C = (st & 1) * 32 + (swz % 64) / 2; }
__host__ __device__ __forceinline__ int perm32(int rho) { const int n = rho >> 4, i = rho & 15; return 8 * (i >> 2) + 4 * n + (i & 3); }

struct Unit { int pm, pn; };
struct Gemm { const bf16_t* A; const bf16_t* Bt; int M, N, K; };

struct StaticOrder {
    int nM, nN, nwg, G, c;
    __host__ __device__ void init(int M, int N, int G_, int c_) { nM = M / BM; nN = N / BM; nwg = nM * nN; G = G_; c = c_; }
    __host__ __device__ bool next(int i, Unit& u) const {
        const long L = (long)i * G + c; if (L >= nwg) return false;
        int wgid = (int)L; { const int q = nwg / NXCD, r = nwg % NXCD, xcd = wgid % NXCD, off = wgid / NXCD; wgid = (xcd < r ? xcd * (q + 1) : r * (q + 1) + (xcd - r) * q) + off; }
        const int nig = WGM * nN, gid = wgid / nig, fm = gid * WGM, gsz = (nM - fm) < WGM ? (nM - fm) : WGM;
        u.pm = fm + ((wgid % nig) % gsz); u.pn = (wgid % nig) / gsz; return true;
    }
    __device__ __forceinline__ void a_ready(const Unit&) const {}
    __device__ __forceinline__ void done(const Unit&) const {}
};

__device__ __forceinline__ unsigned cvt_pk_bf16(float lo, float hi) { unsigned r; asm volatile("v_cvt_pk_bf16_f32 %0, %1, %2" : "=v"(r) : "v"(lo), "v"(hi)); return r; }

constexpr float RMS_EPS = 1e-6f;
constexpr float SSQ_SCALE = 2048.0f, SSQ_INV = 1.0f / (2048.0f * 1024.0f);
constexpr float QSCALE = 0.125f * 1.4426950408889634f;


struct EpiQKV {
    static constexpr bool PERM = true, AFTER_DRAIN = false;
    bf16_t* O; int ldc; const unsigned* ssq; const float* cosT; const float* sinT; const float* rot;
    __device__ __forceinline__ void operator()(const f32x4 (&acc)[2][2][4][2], const Unit& u, int wr, int wc, int fr, int fq) const {
        const int row0 = u.pm * BM + wr * 64 + fr; const int t6 = u.pn % 6;
        const int col0 = u.pn * BM + wc * 32 + 8 * fq; const int fi = 16 * (wc & 1) + 4 * fq;
        const float qs = t6 < 4 ? QSCALE : 1.0f; const bool rope = t6 < 5;
        unsigned sq[8];
#pragma unroll
        for (int i = 0; i < 8; ++i) { const int row = row0 + (i >> 2) * HALF + (i & 3) * 16; sq[i] = ssq[row]; }
        f32x4 c0 = (f32x4){1.f, 1.f, 1.f, 1.f}, s0 = (f32x4){0.f, 0.f, 0.f, 0.f}, c16 = c0, s16 = s0, c128 = c0, s128 = s0;
        if (rope) { const int t0 = row0 & 2047;
            c0 = *(const f32x4*)(cosT + t0 * 32 + fi); s0 = *(const f32x4*)(sinT + t0 * 32 + fi);
            c16 = *(const f32x4*)(rot + fi); s16 = *(const f32x4*)(rot + 32 + fi); c128 = *(const f32x4*)(rot + 64 + fi); s128 = *(const f32x4*)(rot + 96 + fi); }
        asm volatile("" ::: "memory");
#pragma unroll
        for (int ai = 0; ai < 2; ++ai) {
            f32x4 c = c0, sn = s0;
            if (ai == 1) { c = c0 * c128 - s0 * s128; sn = s0 * c128 + c0 * s128; }
#pragma unroll
            for (int m = 0; m < 4; ++m) {
                const int row = row0 + ai * HALF + m * 16;
                const float s1 = __builtin_amdgcn_rsqf((float)sq[ai * 4 + m] * SSQ_INV + RMS_EPS) * qs; const f32x4 c1 = c * s1, n1 = sn * s1;
                bf16_t* rowp = O + (size_t)row * ldc + col0;
#pragma unroll
                for (int bj = 0; bj < 2; ++bj) {
                    const f32x4 v0 = acc[ai][bj][m][0], v1 = acc[ai][bj][m][1];
                    const f32x4 o0 = v0 * c1 - v1 * n1, o1 = v1 * c1 + v0 * n1;
                    u32x4 w; w.x = cvt_pk_bf16(o0[0], o0[1]); w.y = cvt_pk_bf16(o0[2], o0[3]); w.z = cvt_pk_bf16(o1[0], o1[1]); w.w = cvt_pk_bf16(o1[2], o1[3]);
                    *(u32x4*)(rowp + bj * HALF) = w; }
                if (m < 3) { const f32x4 cn = c * c16 - sn * s16; sn = sn * c16 + c * s16; c = cn; }
            }
        }
    }
};

struct EpiSwiGLU {
    static constexpr bool PERM = true, AFTER_DRAIN = false;
    bf16_t* O; int ldc; const unsigned* ssq;
    __device__ __forceinline__ void operator()(const f32x4 (&acc)[2][2][4][2], const Unit& u, int wr, int wc, int fr, int fq) const {
        const int row0 = u.pm * BM + wr * 64 + fr; const int col0 = u.pn * HALF + wc * 32 + 8 * fq;
        unsigned sq[8];
#pragma unroll
        for (int i = 0; i < 8; ++i) sq[i] = ssq[row0 + (i >> 2) * HALF + (i & 3) * 16];
        asm volatile("" ::: "memory");
#pragma unroll
        for (int i = 0; i < 8; ++i) {
            const int ai = i >> 2, m = i & 3; const int row = row0 + ai * HALF + m * 16;
            const float rstd = __builtin_amdgcn_rsqf((float)sq[i] * SSQ_INV + RMS_EPS), nr = -1.4426950408889634f * rstd, r2 = rstd * rstd;
            float h[8];
#pragma unroll
            for (int n = 0; n < 2; ++n)
#pragma unroll
                for (int e = 0; e < 4; ++e) { const float ag = acc[ai][0][m][n][e], au = acc[ai][1][m][n][e];
                    h[n * 4 + e] = (ag * au) * (r2 * __builtin_amdgcn_rcpf(1.0f + __builtin_amdgcn_exp2f(ag * nr))); }
            u32x4 w; w.x = cvt_pk_bf16(h[0], h[1]); w.y = cvt_pk_bf16(h[2], h[3]); w.z = cvt_pk_bf16(h[4], h[5]); w.w = cvt_pk_bf16(h[6], h[7]);
            *(u32x4*)(O + (size_t)row * ldc + col0) = w;
        }
    }
};

struct EpiRes {
    static constexpr bool PERM = true, AFTER_DRAIN = false;
    bf16_t* xb; unsigned* ssq;
    __device__ __forceinline__ void operator()(const f32x4 (&acc)[2][2][4][2], const Unit& u, int wr, int wc, int fr, int fq) const {
        const int row0 = u.pm * BM + wr * 64 + fr; const int col0 = u.pn * BM + wc * 32 + 8 * fq;
#pragma unroll
        for (int i = 0; i < 8; ++i) {
            const int ai = i >> 2, m = i & 3; const int row = row0 + ai * HALF + m * 16; bf16_t* rowp = xb + (size_t)row * 1024 + col0; float s = 0.f;
            u32x4 xv[2];
#pragma unroll
            for (int bj = 0; bj < 2; ++bj) xv[bj] = *(const u32x4*)(rowp + bj * HALF);
#pragma unroll
            for (int bj = 0; bj < 2; ++bj) {
                float o[8];
#pragma unroll
                for (int e = 0; e < 4; ++e) { o[2 * e] = __uint_as_float(xv[bj][e] << 16) + acc[ai][bj][m][e >> 1][(2 * e) & 3]; o[2 * e + 1] = __uint_as_float(xv[bj][e] & 0xffff0000u) + acc[ai][bj][m][e >> 1][(2 * e + 1) & 3]; }
#pragma unroll
                for (int e = 0; e < 8; ++e) s += o[e] * o[e];
                u32x4 w; w.x = cvt_pk_bf16(o[0], o[1]); w.y = cvt_pk_bf16(o[2], o[3]); w.z = cvt_pk_bf16(o[4], o[5]); w.w = cvt_pk_bf16(o[6], o[7]);
                *(u32x4*)(rowp + bj * HALF) = w;
            }
            s += __shfl_xor(s, 16); s += __shfl_xor(s, 32);
            if (fq == 0) atomicAdd(ssq + row, (unsigned)(s * SSQ_SCALE + 0.5f));
        }
    }
};

template <class Epi, class Sched, bool ALIGN_EPI = false, bool SP2 = false>
__device__ __forceinline__ void gemm_phase(PG8_LAS unsigned char* lds, const Gemm g, const Sched& S, const Epi& E) {
    const int tid = threadIdx.x, wid = __builtin_amdgcn_readfirstlane(tid >> 6), lane = tid & 63, wr = wid >> 2, wc = wid & 3, fr = lane & 15, fq = lane >> 4;
    const int K = g.K, nt = K / BK;
    unsigned voffA[2], voffB[2];
#pragma unroll
    for (int i = 0; i < 2; ++i) { int R, C; stage_rc(tid * 16 + i * 8192, R, C); const int Rb = Epi::PERM ? ((R & ~31) + perm32(R & 31)) : R;
        voffA[i] = (unsigned)(R * K + C) * 2u; voffB[i] = (unsigned)(Rb * K + C) * 2u; }
    const size_t kstep = (size_t)(BK * 2);
    const size_t hstep = (size_t)HALF * K * 2;
    const size_t tstep = 2 * hstep;
    const unsigned ldsw = (unsigned)wid * 1024u;
    const int aoff = lds_byte(wr * 64 + fr, fq * 8), boff = lds_byte(wc * 32 + fr, fq * 8);
#define PG8_SA(b, h) (((b) * 2 + (h)) * HTB)
#define PG8_SB(b, h) ((4 + (b) * 2 + (h)) * HTB)
#define PG8_STAGE(bufoff, gbase, voff) do { _Pragma("unroll") for (int _i = 0; _i < 2; ++_i) \
        __builtin_amdgcn_global_load_lds((const unsigned*)((const char*)(gbase) + (voff)[_i]), (PG8_LAS unsigned*)(lds + (bufoff) + ldsw + _i * 8192), 16, 0, 0); } while (0)
#define PG8_LDA(dst, b, h) do { _Pragma("unroll") for (int m = 0; m < 4; ++m) _Pragma("unroll") for (int k = 0; k < 2; ++k) dst[m][k] = *(const PG8_LAS bf16x8*)(lds + PG8_SA(b, h) + aoff + m * 2048 + k * 1024); } while (0)
#define PG8_LDB(dst, b, h) do { _Pragma("unroll") for (int n = 0; n < 2; ++n) _Pragma("unroll") for (int k = 0; k < 2; ++k) dst[n][k] = *(const PG8_LAS bf16x8*)(lds + PG8_SB(b, h) + boff + n * 2048 + k * 1024); } while (0)
#define PG8_MMA(ai, bj, At, Bt) do { __builtin_amdgcn_s_setprio(1); _Pragma("unroll") for (int m = 0; m < 4; ++m) _Pragma("unroll") for (int n = 0; n < 2; ++n) _Pragma("unroll") for (int k = 0; k < 2; ++k) \
        acc[ai][bj][m][n] = __builtin_amdgcn_mfma_f32_16x16x32_bf16(Bt[n][k], At[m][k], acc[ai][bj][m][n], 0, 0, 0); __builtin_amdgcn_s_setprio(0); } while (0)
#define PG8_WAIT_V(n) asm volatile("s_waitcnt vmcnt(" #n ")" ::: "memory")
#define PG8_WAIT_L(n) asm volatile("s_waitcnt lgkmcnt(" #n ")" ::: "memory")
#define PG8_BAR __builtin_amdgcn_s_barrier()
#define PG8_SCHED __builtin_amdgcn_sched_barrier(0)
    Unit cur, nxt; int ui = 0;
    if (!S.next(0, cur)) return;
    f32x4 acc[2][2][4][2];
#pragma unroll
    for (int a = 0; a < 2; ++a)
#pragma unroll
        for (int b = 0; b < 2; ++b)
#pragma unroll
            for (int m = 0; m < 4; ++m)
#pragma unroll
                for (int n = 0; n < 2; ++n) acc[a][b][m][n] = (f32x4){0.f, 0.f, 0.f, 0.f};
    bf16x8 At[4][2], B0[2][2], B1[2][2];
    const char* cA = (const char*)g.A + (size_t)cur.pm * tstep; const char* cB = (const char*)g.Bt + (size_t)cur.pn * tstep;
    S.a_ready(cur);
    if constexpr (SP2) {
        PG8_STAGE(PG8_SB(0, 0), cB, voffB); PG8_STAGE(PG8_SB(0, 1), cB + hstep, voffB); PG8_STAGE(PG8_SA(0, 0), cA, voffA); PG8_STAGE(PG8_SA(0, 1), cA + hstep, voffA);
        if (wr == 1) PG8_BAR;
        PG8_WAIT_V(2); PG8_BAR;
        PG8_STAGE(PG8_SB(1, 0), cB + kstep, voffB); PG8_STAGE(PG8_SA(1, 0), cA + kstep, voffA); PG8_STAGE(PG8_SB(1, 1), cB + hstep + kstep, voffB);
        PG8_WAIT_V(6); PG8_BAR;
    } else {
        PG8_STAGE(PG8_SB(0, 0), cB, voffB); PG8_STAGE(PG8_SA(0, 0), cA, voffA); PG8_STAGE(PG8_SB(0, 1), cB + hstep, voffB); PG8_STAGE(PG8_SA(0, 1), cA + hstep, voffA);
        if (wr == 1) PG8_BAR;
        PG8_WAIT_V(4); PG8_BAR;
        PG8_STAGE(PG8_SB(1, 0), cB + kstep, voffB); PG8_STAGE(PG8_SA(1, 0), cA + kstep, voffA); PG8_STAGE(PG8_SB(1, 1), cB + hstep + kstep, voffB);
        PG8_WAIT_V(6); PG8_BAR;
    }
    for (;;) {
        const bool has_next = S.next(ui + 1, nxt);
        const char* nA = has_next ? (const char*)g.A + (size_t)nxt.pm * tstep : cA; const char* nB = has_next ? (const char*)g.Bt + (size_t)nxt.pn * tstep : cB;
        for (int t = 0; t < nt; t += 2) {
            const bool last = (t == nt - 2);
            const char* a1 = cA + (size_t)(t + 1) * kstep;
            const char* a2 = last ? nA : cA + (size_t)(t + 2) * kstep; const char* b2 = last ? nB : cB + (size_t)(t + 2) * kstep;
            const char* a3 = a2 + kstep; const char* b3 = b2 + kstep;
            if (last && has_next) S.a_ready(nxt);
            if constexpr (SP2) {
            PG8_LDB(B0, 0, 0); PG8_LDB(B1, 0, 1); PG8_SCHED; PG8_LDA(At, 0, 0); PG8_STAGE(PG8_SA(1, 1), a1 + hstep, voffA);
            PG8_WAIT_V(8); PG8_WAIT_L(0); PG8_BAR; PG8_MMA(0, 0, At, B0); PG8_MMA(0, 1, At, B1); PG8_BAR; PG8_SCHED;
            PG8_LDA(At, 0, 1); PG8_STAGE(PG8_SB(0, 0), b2, voffB); PG8_STAGE(PG8_SB(0, 1), b2 + hstep, voffB); PG8_STAGE(PG8_SA(0, 0), a2, voffA);
            PG8_WAIT_V(8); PG8_WAIT_L(0); PG8_BAR; PG8_MMA(1, 0, At, B0); PG8_MMA(1, 1, At, B1); PG8_BAR; PG8_SCHED;
            PG8_LDB(B0, 1, 0); PG8_LDB(B1, 1, 1); PG8_SCHED; PG8_LDA(At, 1, 0); PG8_STAGE(PG8_SA(0, 1), a2 + hstep, voffA);
            PG8_WAIT_V(8); PG8_WAIT_L(0); PG8_BAR; PG8_MMA(0, 0, At, B0); PG8_MMA(0, 1, At, B1); PG8_BAR; PG8_SCHED;
            PG8_LDA(At, 1, 1); PG8_STAGE(PG8_SB(1, 0), b3, voffB); PG8_STAGE(PG8_SB(1, 1), b3 + hstep, voffB); PG8_STAGE(PG8_SA(1, 0), a3, voffA);
            PG8_WAIT_V(8); PG8_WAIT_L(0); PG8_BAR; PG8_MMA(1, 0, At, B0); PG8_MMA(1, 1, At, B1); PG8_BAR; PG8_SCHED;
            } else {
            PG8_LDB(B0, 0, 0); PG8_SCHED; PG8_LDA(At, 0, 0); PG8_STAGE(PG8_SA(1, 1), a1 + hstep, voffA);
            PG8_WAIT_L(8); PG8_BAR; PG8_WAIT_L(0); PG8_MMA(0, 0, At, B0); PG8_BAR; PG8_SCHED;
            PG8_LDB(B1, 0, 1); PG8_STAGE(PG8_SB(0, 0), b2, voffB);
            PG8_BAR; PG8_WAIT_L(0); PG8_MMA(0, 1, At, B1); PG8_BAR;
            PG8_LDA(At, 0, 1); PG8_STAGE(PG8_SA(0, 0), a2, voffA);
            PG8_BAR; PG8_WAIT_L(0); PG8_MMA(1, 0, At, B0); PG8_BAR; PG8_SCHED;
            PG8_STAGE(PG8_SB(0, 1), b2 + hstep, voffB);
            PG8_WAIT_V(6); PG8_BAR; PG8_MMA(1, 1, At, B1); PG8_BAR;
            PG8_LDB(B0, 1, 0); PG8_SCHED; PG8_LDA(At, 1, 0); PG8_STAGE(PG8_SA(0, 1), a2 + hstep, voffA);
            PG8_WAIT_L(8); PG8_BAR; PG8_WAIT_L(0); PG8_MMA(0, 0, At, B0); PG8_BAR; PG8_SCHED;
            PG8_LDB(B1, 1, 1); PG8_STAGE(PG8_SB(1, 0), b3, voffB);
            PG8_BAR; PG8_WAIT_L(0); PG8_MMA(0, 1, At, B1); PG8_BAR;
            PG8_LDA(At, 1, 1); PG8_STAGE(PG8_SA(1, 0), a3, voffA);
            PG8_BAR; PG8_WAIT_L(0); PG8_MMA(1, 0, At, B0); PG8_BAR; PG8_SCHED;
            PG8_STAGE(PG8_SB(1, 1), b3 + hstep, voffB);
            PG8_WAIT_V(6); PG8_BAR; PG8_MMA(1, 1, At, B1); PG8_BAR;
            }
        }
        if constexpr (ALIGN_EPI) { if (wr == 0) PG8_BAR; }
        if constexpr (!Epi::AFTER_DRAIN) { E(acc, cur, wr, wc, fr, fq); S.done(cur); }
        if (!has_next) break;
#pragma unroll
        for (int a = 0; a < 2; ++a)
#pragma unroll
            for (int b = 0; b < 2; ++b)
#pragma unroll
                for (int m = 0; m < 4; ++m)
#pragma unroll
                    for (int n = 0; n < 2; ++n) acc[a][b][m][n] = (f32x4){0.f, 0.f, 0.f, 0.f};
        cur = nxt; cA = nA; cB = nB; ++ui;
        if constexpr (ALIGN_EPI) { if (wr == 1) PG8_BAR; }
    }
    PG8_WAIT_V(0);
    if constexpr (!ALIGN_EPI) { if (wr == 0) PG8_BAR; }
    PG8_BAR;
#undef PG8_SA
#undef PG8_SB
#undef PG8_STAGE
#undef PG8_LDA
#undef PG8_LDB
#undef PG8_MMA
#undef PG8_WAIT_V
#undef PG8_WAIT_L
#undef PG8_BAR
#undef PG8_SCHED
}
}

namespace att {
#define ATT_LAS __attribute__((address_space(3)))
typedef unsigned short bf16_t;
typedef short bf16x8 __attribute__((ext_vector_type(8)));
typedef short s16x4 __attribute__((ext_vector_type(4)));
typedef float f32x16 __attribute__((ext_vector_type(16)));
typedef unsigned u32x4 __attribute__((ext_vector_type(4)));
typedef unsigned u32x2 __attribute__((ext_vector_type(2)));
__device__ __forceinline__ int crow(int r, int hi) { return (r & 3) + 8 * (r >> 2) + 4 * hi; }
__device__ __forceinline__ unsigned swz(int row, int ch) { return (unsigned)(row * 128 + ((ch ^ ((((row >> 1) & 1) << 2) | ((row >> 2) & 3))) << 4)); }
__device__ __forceinline__ float swap32f(float v) { auto rr = __builtin_amdgcn_permlane32_swap(__float_as_uint(v), __float_as_uint(v), false, false); return (threadIdx.x & 32) ? __uint_as_float(rr[0]) : __uint_as_float(rr[1]); }
__device__ __forceinline__ unsigned pk(float lo, float hi) { unsigned r; asm volatile("v_cvt_pk_bf16_f32 %0, %1, %2" : "=v"(r) : "v"(lo), "v"(hi)); return r; }

struct AU { const bf16_t* Q; const bf16_t* K; const bf16_t* V; bf16_t* O; size_t rstride, ostride; int L, q0; const float* sink; float* lse; size_t lstride; };

template <int W, bool SINK, bool LSEOUT, class Dec, bool SKIPT = false>
__device__ __forceinline__ void phase(ATT_LAS unsigned char* lds, int ub, int ue, const Dec& dec) {
    constexpr int NK = 64 + 2 * W, NCH = NK * 8, PER = NCH / 512, NT = 2 * W / 32 + 1, VOFF = NK * 128;
    static_assert(NCH % 512 == 0, "staging split");
    if (ub >= ue) return;
    const int tid = threadIdx.x, lane = tid & 63, r32 = lane & 31, hi = lane >> 5, wid = __builtin_amdgcn_readfirstlane(tid >> 6), h = wid & 3, sb = wid >> 2;
    const int qq = (lane & 15) >> 2, p = lane & 3, blk = (lane >> 4) & 1;
    const int fk = (((r32 >> 1) & 1) << 2) | ((r32 >> 2) & 3);
    unsigned kaddr[4];
#pragma unroll
    for (int d0 = 0; d0 < 4; ++d0) kaddr[d0] = (unsigned)(r32 * 128 + (((2 * d0 + hi) ^ fk) << 4));
    unsigned vaddr[2][2];
#pragma unroll
    for (int c = 0; c < 2; ++c)
#pragma unroll
        for (int hf = 0; hf < 2; ++hf) { const int fv = ((qq >> 1) << 2) | ((2 * hf + hi) & 3);
            vaddr[c][hf] = (unsigned)(VOFF + (8 * hf + 4 * hi + qq) * 128 + (((4 * c + 2 * blk + (p >> 1)) ^ fv) << 4) + 8 * (p & 1)); }
    u32x4 kreg[PER], vreg[PER]; unsigned kmask[PER]; bf16x8 qn[4]; float sinkn = 0.f;
#define ATT_LOAD(U) do { \
        _Pragma("unroll") for (int i_ = 0; i_ < PER; ++i_) { const int cid_ = tid + 512 * i_, row_ = cid_ >> 3, ch_ = cid_ & 7, kp_ = (U).q0 - W + row_; \
            const int kc_ = min(max(kp_, 0), (U).L - 1); const unsigned ok_ = (kp_ == kc_) ? 0xffffffffu : 0u;     \
            kreg[i_] = *(const u32x4*)((U).K + (size_t)kc_ * (U).rstride + ch_ * 8); vreg[i_] = *(const u32x4*)((U).V + (size_t)kc_ * (U).rstride + ch_ * 8); kmask[i_] = ok_; } \
        { const bf16_t* qp_ = (U).Q + (size_t)((U).q0 + 32 * sb + r32) * (U).rstride + h * 64 + 8 * hi; \
          if (SINK) sinkn = (U).sink[h]; \
          _Pragma("unroll") for (int d0_ = 0; d0_ < 4; ++d0_) qn[d0_] = *(const bf16x8*)(qp_ + 16 * d0_); } } while (0)
#define ATT_PIN() asm volatile("" : "+v"(qn[3]))
    AU cur = dec(ub);
    ATT_LOAD(cur); ATT_PIN();
    for (int u = ub; u < ue; ++u) {
        const float sink2 = sinkn * 1.4426950408889634f;
#pragma unroll
        for (int i = 0; i < PER; ++i) { const int cid = tid + 512 * i, row = cid >> 3, ch = cid & 7; const unsigned o = swz(row, ch);
            *(ATT_LAS u32x4*)(lds + o) = kreg[i] & kmask[i]; *(ATT_LAS u32x4*)(lds + VOFF + o) = vreg[i] & kmask[i]; }
        bf16x8 qf[4];
#pragma unroll
        for (int d0 = 0; d0 < 4; ++d0) qf[d0] = qn[d0];
        asm volatile("s_waitcnt lgkmcnt(0)" ::: "memory"); __builtin_amdgcn_s_barrier(); asm volatile("" ::: "memory");
        const AU nxt = dec(min(u + 1, ue - 1));
        ATT_LOAD(nxt);
        const int q0 = cur.q0, L = cur.L; const int qrow = q0 + 32 * sb + r32;
        float m = 0.f, l = 0.f; f32x16 o0 = {}, o1 = {}, negm = {};
        const float NEG = -INFINITY;
        const int tb = q0 - W + 32 * sb;
        const int j0 = tb < 0 ? (-tb) >> 5 : 0; const int j1 = SKIPT ? j0 - 1 : min(NT - 1, (L - 32 - tb) >> 5);
        bf16x8 kf[4];
        { const unsigned rb0 = (unsigned)((32 * sb + 32 * j0) * 128);
#pragma unroll
          for (int d0 = 0; d0 < 4; ++d0) kf[d0] = *(const ATT_LAS bf16x8*)(lds + rb0 + kaddr[d0]); }
        for (int j = j0; j <= j1; ++j) {
            const unsigned rb = (unsigned)((32 * sb + 32 * j) * 128);
            f32x16 S = negm;
#pragma unroll
            for (int d0 = 0; d0 < 4; ++d0) S = __builtin_amdgcn_mfma_f32_32x32x16_bf16(kf[d0], qf[d0], S, 0, 0, 0);
            s16x4 vv[2][2][2];
#pragma unroll
            for (int s2 = 0; s2 < 2; ++s2)
#pragma unroll
                for (int c = 0; c < 2; ++c)
#pragma unroll
                    for (int hf = 0; hf < 2; ++hf) vv[s2][c][hf] = __builtin_bit_cast(s16x4, __builtin_amdgcn_ds_read_tr16_b64_v4i16((ATT_LAS s16x4*)(lds + rb + s2 * 2048 + vaddr[c][hf])));
            { const unsigned rbn = j < j1 ? rb + 4096u : rb;
#pragma unroll
              for (int d0 = 0; d0 < 4; ++d0) kf[d0] = *(const ATT_LAS bf16x8*)(lds + rbn + kaddr[d0]); }
            __builtin_amdgcn_sched_barrier(0);
            if (j == 0) {
#pragma unroll
                for (int r = 0; r < 16; ++r) if (crow(r, hi) < r32) S[r] = NEG; }
            if (j == NT - 1) {
#pragma unroll
                for (int r = 0; r < 16; ++r) if (crow(r, hi) > r32) S[r] = NEG; }
            float mx = fmaxf(fmaxf(S[0], S[1]), S[2]);
#pragma unroll
            for (int r = 3; r < 15; r += 2) mx = fmaxf(fmaxf(mx, S[r]), S[r + 1]);
            mx = fmaxf(mx, S[15]);
            { auto rr = __builtin_amdgcn_permlane32_swap(__float_as_uint(mx), __float_as_uint(mx), false, false); mx = fmaxf(__uint_as_float(rr[0]), __uint_as_float(rr[1])); }
            if (j == j0) {
                float mr = mx; if (SINK) mr = fmaxf(mr, sink2);
                m = mr; l = 0.f; if (SINK) l = hi == 0 ? __builtin_amdgcn_exp2f(sink2 - mr) : 0.f;
#pragma unroll
                for (int r = 0; r < 16; ++r) { S[r] -= mr; negm[r] = -mr; }
            } else if (__builtin_amdgcn_ballot_w64(mx > 8.0f) != 0ull) {
                const float d = fmaxf(mx, 0.f), alpha = __builtin_amdgcn_exp2f(-d); m += d; l *= alpha;
#pragma unroll
                for (int r = 0; r < 16; ++r) { S[r] -= d; negm[r] = -m; o0[r] *= alpha; o1[r] *= alpha; }
            }
            float ls0 = 0.f, ls1 = 0.f;
#pragma unroll
            for (int r = 0; r < 16; r += 2) { S[r] = __builtin_amdgcn_exp2f(S[r]); S[r + 1] = __builtin_amdgcn_exp2f(S[r + 1]); ls0 += S[r]; ls1 += S[r + 1]; }
            l += ls0 + ls1;
            u32x4 pw0, pw1;
            pw0.x = pk(S[0], S[1]); pw0.y = pk(S[2], S[3]); pw0.z = pk(S[4], S[5]); pw0.w = pk(S[6], S[7]);
            pw1.x = pk(S[8], S[9]); pw1.y = pk(S[10], S[11]); pw1.z = pk(S[12], S[13]); pw1.w = pk(S[14], S[15]);
            const bf16x8 pa0 = __builtin_bit_cast(bf16x8, pw0), pa1 = __builtin_bit_cast(bf16x8, pw1);
#pragma unroll
            for (int s2 = 0; s2 < 2; ++s2) {
                const bf16x8 pa = s2 ? pa1 : pa0;
#pragma unroll
                for (int c = 0; c < 2; ++c) {
                    const s16x4 v0 = vv[s2][c][0], v1 = vv[s2][c][1];
                    const bf16x8 vf = (bf16x8){v0[0], v0[1], v0[2], v0[3], v1[0], v1[1], v1[2], v1[3]};
                    if (c == 0) o0 = __builtin_amdgcn_mfma_f32_32x32x16_bf16(vf, pa, o0, 0, 0, 0); else o1 = __builtin_amdgcn_mfma_f32_32x32x16_bf16(vf, pa, o1, 0, 0, 0);
                }
            }
        }
        float lt; { auto rr = __builtin_amdgcn_permlane32_swap(__float_as_uint(l), __float_as_uint(l), false, false); lt = __uint_as_float(rr[0]) + __uint_as_float(rr[1]); }
        const float inv = 1.0f / lt;
        unsigned char* rbp = (unsigned char*)(cur.O + (size_t)qrow * cur.ostride + h * 64) + (hi ? 16 : 0);
#pragma unroll
        for (int kp = 0; kp < 4; ++kp) {
            const int c = kp >> 1, g0 = 2 * (kp & 1);
            unsigned ax, ay, bx, by;
            if (c == 0) { ax = pk(o0[4 * g0] * inv, o0[4 * g0 + 1] * inv); ay = pk(o0[4 * g0 + 2] * inv, o0[4 * g0 + 3] * inv); bx = pk(o0[4 * g0 + 4] * inv, o0[4 * g0 + 5] * inv); by = pk(o0[4 * g0 + 6] * inv, o0[4 * g0 + 7] * inv); }
            else        { ax = pk(o1[4 * g0] * inv, o1[4 * g0 + 1] * inv); ay = pk(o1[4 * g0 + 2] * inv, o1[4 * g0 + 3] * inv); bx = pk(o1[4 * g0 + 4] * inv, o1[4 * g0 + 5] * inv); by = pk(o1[4 * g0 + 6] * inv, o1[4 * g0 + 7] * inv); }
            { auto r = __builtin_amdgcn_permlane32_swap(ax, bx, false, false); ax = r[0]; bx = r[1]; }
            { auto r = __builtin_amdgcn_permlane32_swap(ay, by, false, false); ay = r[0]; by = r[1]; }
            *(u32x4*)(rbp + 32 * kp) = (u32x4){ax, ay, bx, by};
        }
        if (LSEOUT) { if (hi == 0) cur.lse[(size_t)qrow * cur.lstride + h] = m + __builtin_amdgcn_logf(lt); }
        asm volatile("s_waitcnt lgkmcnt(0)" ::: "memory"); __builtin_amdgcn_s_barrier(); asm volatile("" ::: "memory");
        ATT_PIN();
        cur = nxt;
    }
#undef ATT_LOAD
#undef ATT_PIN
}
}

#define LAS __attribute__((address_space(3)))
typedef unsigned short bf16;
typedef unsigned v4u __attribute__((ext_vector_type(4)));
typedef float f32x4 __attribute__((ext_vector_type(4)));
constexpr int NWAVES = 8, NTHREADS = 512;
constexpr int BATCH = 32, SEQ = 2048, DM = 1024, T = BATCH * SEQ, DFF = 2816, QKVW = 1536, NH = 16;
constexpr int LDS_BYTES = 135168;
constexpr size_t MiB = 1u << 20;
constexpr size_t WS_WIN0 = 0;
constexpr size_t WS_WOUT0 = WS_WIN0 + (size_t)1536 * 1024 * 2;
constexpr size_t WS_WIN1 = WS_WOUT0 + (size_t)1024 * 1024 * 2;
constexpr size_t WS_WOUT1 = WS_WIN1 + (size_t)4608 * 1024 * 2;
constexpr size_t WS_WGU0 = WS_WOUT1 + (size_t)1024 * 1024 * 2;
constexpr size_t WS_WGU1 = WS_WGU0 + (size_t)5632 * 1024 * 2;
constexpr size_t WS_WD0 = WS_WGU1 + (size_t)5632 * 1024 * 2;
constexpr size_t WS_WD1 = WS_WD0 + (size_t)1024 * 2816 * 2;
constexpr size_t WS_COS = WS_WD1 + (size_t)1024 * 2816 * 2;
constexpr size_t WS_SIN = WS_COS + (size_t)2048 * 32 * 4;
constexpr size_t WS_SSQ = WS_SIN + (size_t)2048 * 32 * 4;
constexpr size_t WS_LSE = WS_SSQ + (size_t)5 * T * 4;
constexpr size_t WS_CTL = 71 * MiB;
constexpr size_t WS_ROT = 71 * MiB + 65536;
constexpr size_t WS_XB = 72 * MiB;
constexpr size_t WS_O = WS_XB + 128 * MiB;
constexpr size_t WS_BIG = WS_O + 128 * MiB;
constexpr size_t WS_END = WS_BIG + (size_t)T * 4608 * 2;
static_assert(WS_LSE + (size_t)3 * T * 16 * 4 <= WS_XB, "ws map");

__device__ __forceinline__ unsigned f2bf(float f) { unsigned u = __builtin_bit_cast(unsigned, f); return (u + 0x7fffu + ((u >> 16) & 1u)) >> 16; }
__device__ __forceinline__ unsigned pk2(float lo, float hi) { return f2bf(lo) | (f2bf(hi) << 16); }
__device__ __forceinline__ float wave_sum(float v) {
#pragma unroll
    for (int o = 1; o < 64; o <<= 1) v += __shfl_xor(v, o);
    return v;
}
__device__ __forceinline__ void transpose_item(const float* Wa, const float* Wb, int mode, const float* gain, int K, int Nsrc, bf16* WT, int nblk, LAS float* scr, int item, int lane) {
    const int kb = item / nblk, nb = item % nblk, k0 = 64 * kb, n0 = 32 * nb;
    const int np = n0 + (lane & 31); const float* W = Wa; int ncol = np;
    if (mode == 1) { const int grp = np / 1536; int c = np % 1536;
        if (c < 1280) { const int head = c >> 6, pp = c & 63, j = pp >> 3, e = pp & 7; c = head * 64 + (e < 4 ? 4 * j + e : 32 + 4 * j + (e - 4)); }
        ncol = grp * 1536 + c; }
    else if (mode == 2) { const int pn = np >> 8, wi = np & 255; W = (wi >> 7) ? Wb : Wa; ncol = pn * 128 + (wi & 127); }
    float wv[32], gv[32];
#pragma unroll
    for (int i = 0; i < 32; ++i) { const int kk = 2 * i + (lane >> 5); wv[i] = W[(size_t)(k0 + kk) * Nsrc + ncol]; gv[i] = gain ? gain[k0 + kk] : 1.0f; }
#pragma unroll
    for (int i = 0; i < 32; ++i) { const int kk = 2 * i + (lane >> 5); scr[kk * 33 + (lane & 31)] = wv[i] * gv[i]; }
    asm volatile("s_waitcnt lgkmcnt(0)" ::: "memory");
    const int c = lane & 7;
#pragma unroll
    for (int j = 0; j < 4; ++j) { const int n = (lane >> 3) + 8 * j; const LAS float* s = scr + (8 * c) * 33 + n;
        v4u o; o.x = pk2(s[0 * 33], s[1 * 33]); o.y = pk2(s[2 * 33], s[3 * 33]); o.z = pk2(s[4 * 33], s[5 * 33]); o.w = pk2(s[6 * 33], s[7 * 33]);
        *(v4u*)(WT + (size_t)(n0 + n) * K + k0 + 8 * c) = o; }
    asm volatile("s_waitcnt lgkmcnt(0)" ::: "memory");
}

#define XB_TMO      128
#define XB_XCNT(j)  (256  + 64 * (j))
#define XB_XSUB(j)  (1280 + 64 * (j))
#define XB_XGEN(j)  (2304 + 64 * (j))
#define XB_TOP      3328
#define XB_TOPGEN   3392
#define XCD_BAR_WORDS 3456
#define XB_SPIN_CAP (1u << 18)
__device__ __forceinline__ unsigned xb_ld(unsigned* p)              { return __hip_atomic_load(p, __ATOMIC_RELAXED, __HIP_MEMORY_SCOPE_AGENT); }
__device__ __forceinline__ unsigned xb_add(unsigned* p, unsigned v) { return __hip_atomic_fetch_add(p, v, __ATOMIC_RELAXED, __HIP_MEMORY_SCOPE_AGENT); }
__device__ __forceinline__ unsigned xb_xcc_id() { return (unsigned)__builtin_amdgcn_s_getreg((3 << 11) | 20) & 0xFu; }
#define XB_SPIN(cond, bar) do { unsigned _sp = 0; while (cond) { __builtin_amdgcn_s_sleep(1); \
    if ((++_sp & 255u) == 0u) { if (xb_ld(&(bar)[XB_TMO])) break; if (_sp > XB_SPIN_CAP) { atomicAdd(&(bar)[XB_TMO], 1u); break; } } } } while (0)
struct XcdBarrier { unsigned* bar; unsigned x; volatile LAS unsigned* st; };
__device__ __forceinline__ XcdBarrier xcd_barrier_post(unsigned* bar, volatile LAS unsigned* st) {
    XcdBarrier b; b.bar = bar; b.x = xb_xcc_id(); b.st = st;
    if (threadIdx.x == 0) (void)xb_add(&bar[XB_XCNT(b.x)], 1u);
    return b;
}
__device__ __forceinline__ void xcd_barrier_complete(unsigned* bar, unsigned x, unsigned& nloc, unsigned& nx) {
    const unsigned G = gridDim.x * gridDim.y * gridDim.z;
    unsigned sum, cnt, mine, sp = 0u;
    for (;;) {
        sum = 0u; cnt = 0u; mine = 0u;
#pragma unroll
        for (unsigned j = 0; j < 16; ++j) { const unsigned c = xb_ld(&bar[XB_XCNT(j)]); sum += c; cnt += (c > 0u) ? 1u : 0u; mine = (j == x) ? c : mine; }
        if (sum == G) break;
        __builtin_amdgcn_s_sleep(1);
        if ((++sp & 255u) == 0u) { if (xb_ld(&bar[XB_TMO])) break; if (sp > XB_SPIN_CAP) { atomicAdd(&bar[XB_TMO], 1u); break; } }
    }
    nloc = mine > 0u ? mine : 1u; nx = cnt > 0u ? cnt : 1u;
}
__device__ __forceinline__ void xcd_barrier(const XcdBarrier& b) {
    asm volatile("s_waitcnt vmcnt(0)" ::: "memory");
    __syncthreads();
    if (threadIdx.x == 0) {
        unsigned* bar = b.bar;
        __builtin_amdgcn_s_waitcnt(0);
        unsigned nloc = b.st[0], nx = b.st[1];
        if (nloc == 0u) { xcd_barrier_complete(bar, b.x, nloc, nx); b.st[0] = nloc; b.st[1] = nx; }
        const unsigned old = xb_add(&bar[XB_XSUB(b.x)], 1u);
        const unsigned gen = old / nloc;
        if (old + 1u == (gen + 1u) * nloc) {
            __builtin_amdgcn_fence(__ATOMIC_RELEASE, "agent");
            asm volatile("s_waitcnt vmcnt(0)" ::: "memory");
            const unsigned og = xb_add(&bar[XB_TOP], 1u);
            const unsigned tg = og / nx;
            if (og + 1u == (tg + 1u) * nx) xb_add(&bar[XB_TOPGEN], 1u);
            else XB_SPIN(xb_ld(&bar[XB_TOPGEN]) == tg, bar);
            __builtin_amdgcn_fence(__ATOMIC_ACQUIRE, "agent");
            xb_add(&bar[XB_XGEN(b.x)], 1u);
            asm volatile("s_waitcnt vmcnt(0)" ::: "memory");
        } else {
            XB_SPIN(xb_ld(&bar[XB_XGEN(b.x)]) == gen, bar);
            __builtin_amdgcn_fence(__ATOMIC_ACQUIRE, "agent");
            asm volatile("s_waitcnt vmcnt(0)" ::: "memory");
        }
    }
    __syncthreads();
}

#define XB_LOC(j) (3456 + 64 * (j))
__device__ __forceinline__ void xcd_local_barrier(unsigned* bar, unsigned x, unsigned nloc, unsigned epoch) {
    asm volatile("s_waitcnt vmcnt(0)" ::: "memory");
    __syncthreads();
    if (threadIdx.x == 0) {
        __builtin_amdgcn_s_waitcnt(0);
        (void)xb_add(&bar[XB_LOC(x)], 1u);
        const unsigned target = epoch * nloc;
        XB_SPIN(xb_ld(&bar[XB_LOC(x)]) < target, bar);
        __builtin_amdgcn_fence(__ATOMIC_ACQUIRE, "agent");
        asm volatile("s_waitcnt vmcnt(0)" ::: "memory");
    }
    __syncthreads();
}

struct Args {
    const float* x; const float* a_w_in; const float* a_sink; const float* a_w_out; const float* b_w_in; const float* b_w_out;
    const float* norm_mix; const float* norm_ffn; const float* w_gate; const float* w_up; const float* w_down; const float* final_norm;
    float* out; unsigned char* ws; int ph_lo, ph_hi;
};
constexpr int N_PHASES = 13;

__global__ void __launch_bounds__(NTHREADS, 2) mega_fwd(Args a) {
    extern __shared__ __attribute__((aligned(16))) unsigned char lds_raw[];
    LAS unsigned char* lds = (LAS unsigned char*)lds_raw;
    const int tid = threadIdx.x, lane = tid & 63, wave = __builtin_amdgcn_readfirstlane(tid >> 6);
    const int G = gridDim.x, bid = blockIdx.x;
    unsigned char* ws = a.ws;
    bf16* Win0 = (bf16*)(ws + WS_WIN0); bf16* Wout0 = (bf16*)(ws + WS_WOUT0); bf16* Win1 = (bf16*)(ws + WS_WIN1); bf16* Wout1 = (bf16*)(ws + WS_WOUT1);
    bf16* Wgu0 = (bf16*)(ws + WS_WGU0); bf16* Wgu1 = (bf16*)(ws + WS_WGU1); bf16* Wd0 = (bf16*)(ws + WS_WD0); bf16* Wd1 = (bf16*)(ws + WS_WD1);
    float* cosT = (float*)(ws + WS_COS); float* sinT = (float*)(ws + WS_SIN); float* rotT = (float*)(ws + WS_ROT); unsigned* ssq = (unsigned*)(ws + WS_SSQ); float* lse = (float*)(ws + WS_LSE);
    bf16* XB = (bf16*)(ws + WS_XB); bf16* OB = (bf16*)(ws + WS_O); bf16* BIG = (bf16*)(ws + WS_BIG);
    float* X = a.out;
    const int lo = a.ph_lo, hi_ph = a.ph_hi;
    unsigned* ctl = (unsigned*)(ws + WS_CTL);
    LAS unsigned* ldsctl = (LAS unsigned*)(lds + 133120);
    if (tid < 8) ldsctl[tid] = 0u;
    __syncthreads();
    XcdBarrier xbar; xbar.bar = ctl; xbar.x = 0; xbar.st = nullptr;
    if (MK_N_LAUNCHES == 1) { xbar.bar = ctl; xbar.x = xb_xcc_id(); xbar.st = (volatile LAS unsigned*)(ldsctl + 2);
        if (tid == 0) ldsctl[4] = xb_add(&ctl[XB_XCNT(xbar.x)], 1u); }
    int vid = bid, bidA = bid; bool local_mode = false; unsigned lepoch = 0u;
    if (a.ph_lo < 0) cg::this_grid().sync();
#define IN(k) (lo <= (k) && (k) < hi_ph)
#define GSYNC() do { asm volatile("s_waitcnt vmcnt(0) lgkmcnt(0)" ::: "memory"); cg::this_grid().sync(); } while (0)
#define SEAM(k) do { if (IN(k) && IN((k) + 1)) { if (local_mode) { ++lepoch; xcd_local_barrier(ctl, xbar.x, (unsigned)(G / 8), lepoch); } else { xcd_barrier(xbar); } } } while (0)
#define STAGGER() do { if (STAGGER_US > 0) { const unsigned long long t0_ = __builtin_amdgcn_s_memrealtime(); const unsigned long long d_ = (unsigned long long)((bid >> 3) & 7) * (unsigned long long)(STAGGER_US * 100 / 8); \
        while (__builtin_amdgcn_s_memrealtime() - t0_ < d_) __builtin_amdgcn_s_sleep(8); } } while (0)

    if (IN(0)) {
        LAS float* scr = (LAS float*)(lds + wave * 16384);
        const int gw = bid * NWAVES + wave, NGW = G * NWAVES;
        constexpr int I_IN0 = 16 * 48, I_OUT = 16 * 32, I_IN1 = 16 * 144, I_GU = 16 * 176, I_D = 44 * 32;
        constexpr int NITEMS = I_IN0 + 2 * I_OUT + I_IN1 + 2 * I_GU + 2 * I_D;
        for (int it = gw; it < NITEMS; it += NGW) {
            int r = it;
            if (r < I_IN0) { transpose_item(a.a_w_in, nullptr, 1, a.norm_mix, 1024, 1536, Win0, 48, scr, r, lane); continue; } r -= I_IN0;
            if (r < I_OUT) { transpose_item(a.a_w_out, nullptr, 0, nullptr, 1024, 1024, Wout0, 32, scr, r, lane); continue; } r -= I_OUT;
            if (r < I_IN1) { transpose_item(a.b_w_in, nullptr, 1, a.norm_mix + 1024, 1024, 4608, Win1, 144, scr, r, lane); continue; } r -= I_IN1;
            if (r < I_OUT) { transpose_item(a.b_w_out, nullptr, 0, nullptr, 1024, 1024, Wout1, 32, scr, r, lane); continue; } r -= I_OUT;
            if (r < I_GU) { transpose_item(a.w_gate, a.w_up, 2, a.norm_ffn, 1024, 2816, Wgu0, 176, scr, r, lane); continue; } r -= I_GU;
            if (r < I_GU) { transpose_item(a.w_gate + (size_t)1024 * 2816, a.w_up + (size_t)1024 * 2816, 2, a.norm_ffn + 1024, 1024, 2816, Wgu1, 176, scr, r, lane); continue; } r -= I_GU;
            if (r < I_D) { transpose_item(a.w_down, nullptr, 0, nullptr, 2816, 1024, Wd0, 32, scr, r, lane); continue; } r -= I_D;
            transpose_item(a.w_down + (size_t)2816 * 1024, nullptr, 0, nullptr, 2816, 1024, Wd1, 32, scr, r, lane);
        }
        const int gt = bid * NTHREADS + tid, NGT = G * NTHREADS;
        for (int i = gt; i < 2048 * 32; i += NGT) {
            const int t = i >> 5, f = i & 31; double inv = 1.0; for (int k = 0; k < f; ++k) inv *= 0.74989420933245583;
            double rev = (double)t * inv * 0.15915494309189535; rev = rev - __builtin_floor(rev); const float fr = (float)rev;
            cosT[i] = __builtin_amdgcn_cosf(fr); sinT[i] = __builtin_amdgcn_sinf(fr);
        }
        if (gt < 32) { double inv = 1.0; for (int k = 0; k < gt; ++k) inv *= 0.74989420933245583;
            double r16 = 16.0 * inv * 0.15915494309189535; r16 -= __builtin_floor(r16); double r128 = 128.0 * inv * 0.15915494309189535; r128 -= __builtin_floor(r128);
            rotT[gt] = __builtin_amdgcn_cosf((float)r16); rotT[32 + gt] = __builtin_amdgcn_sinf((float)r16); rotT[64 + gt] = __builtin_amdgcn_cosf((float)r128); rotT[96 + gt] = __builtin_amdgcn_sinf((float)r128); }
        for (int i = gt; i < 4 * T; i += NGT) ssq[T + i] = 0u;
        for (int row = gw; row < T; row += 4 * NGW) {
            f32x4 v[4][4];
#pragma unroll
            for (int q = 0; q < 4; ++q) { const int rq = min(row + q * NGW, T - 1); const f32x4* xr = (const f32x4*)(a.x + (size_t)rq * DM) + lane;
#pragma unroll
                for (int j = 0; j < 4; ++j) v[q][j] = xr[64 * j]; }
#pragma unroll
            for (int q = 0; q < 4; ++q) { const int rq = row + q * NGW; if (rq < T) { float s = 0.f;
#pragma unroll
                for (int j = 0; j < 4; ++j) s += (v[q][j].x * v[q][j].x + v[q][j].y * v[q][j].y) + (v[q][j].z * v[q][j].z + v[q][j].w * v[q][j].w);
                s = wave_sum(s); if (lane == 0) ssq[rq] = (unsigned)(s * pg8::SSQ_SCALE + 0.5f);
                unsigned long long* o8 = (unsigned long long*)(XB + (size_t)rq * DM) + lane;
#pragma unroll
                for (int j = 0; j < 4; ++j) o8[64 * j] = (unsigned long long)pk2(v[q][j].x, v[q][j].y) | ((unsigned long long)pk2(v[q][j].z, v[q][j].w) << 32); } }
        }
        __syncthreads();
    }
    SEAM(0);
    if (MK_N_LAUNCHES == 1 && XCD_LOCAL && IN(0) && IN(1)) {
        bool okc = (G % 8) == 0 && (G / 8) == 32;
        for (int j = 0; j < 16; ++j) { const unsigned c = xb_ld(&ctl[XB_XCNT(j)]); okc = okc && (j < 8 ? c == (unsigned)(G / 8) : c == 0u); }
        okc = okc && xbar.x < 8u;
        if (okc) { const int xl = (int)ldsctl[4]; local_mode = true; vid = xl * 8 + (int)xbar.x; bidA = (int)xbar.x * 32 + xl; }
    }
    const size_t SLICE = (size_t)8192 * 4608;
    const size_t xsel = local_mode ? (size_t)xbar.x : 0;
    bf16* BIGQ = BIG + xsel * (SLICE - (size_t)8192 * QKVW);
    bf16* BIGH = BIG + xsel * (SLICE - (size_t)8192 * DFF);
    bf16* BIGP = BIG;
    if (IN(1)) _Pragma("unroll") for (int rep = 0; rep < (PROBE_DUP == 1 ? 2 : 1); ++rep) {
        if (rep) GSYNC();
        pg8::Gemm g{XB, Win0, T, QKVW, DM}; pg8::StaticOrder S; S.init(T, QKVW, G, vid);
        pg8::EpiQKV E{BIGQ, QKVW, ssq, cosT, sinT, rotT};
        STAGGER();
        pg8::gemm_phase<pg8::EpiQKV, pg8::StaticOrder, true, true>(lds, g, S, E);
    }
    SEAM(1);
    if (IN(2)) _Pragma("unroll") for (int rep = 0; rep < (PROBE_DUP == 2 ? 2 : 1); ++rep) {
        if (rep) GSYNC();
        constexpr int NU = BATCH * 4 * 32; const int per = (NU + G - 1) / G;
        const bf16* BIGc = BIGQ; bf16* OBc = OB; const float* sinkp = a.a_sink;
        auto dec = [=](int u) { const int qb = u & 31, kvh = (u >> 5) & 3, b = u >> 7; const bf16* base = BIGc + (size_t)b * SEQ * QKVW;
            return att::AU{base + kvh * 256, base + 1024 + kvh * 64, base + 1280 + kvh * 64, OBc + (size_t)b * SEQ * DM + kvh * 256, (size_t)QKVW, (size_t)DM, SEQ, qb * 64, sinkp + kvh * 4, nullptr, 0}; };
        att::phase<128, true, false>(lds, min(NU, bidA * per), min(NU, (bidA + 1) * per), dec);
    }
    SEAM(2);
    if (IN(3)) {
        pg8::Gemm g{OB, Wout0, T, DM, DM}; pg8::StaticOrder S; S.init(T, DM, G, vid);
        pg8::EpiRes E{XB, ssq + T};
        STAGGER();
        pg8::gemm_phase<pg8::EpiRes, pg8::StaticOrder, true, true>(lds, g, S, E);
    }
    SEAM(3);
    if (IN(4)) _Pragma("unroll") for (int rep = 0; rep < (PROBE_DUP == 4 ? 2 : 1); ++rep) {
        if (rep) GSYNC();
        pg8::Gemm g{XB, Wgu0, T, 2 * DFF, DM}; pg8::StaticOrder S; S.init(T, 2 * DFF, G, vid);
        pg8::EpiSwiGLU E{BIGH, DFF, ssq + T};
        STAGGER();
        pg8::gemm_phase<pg8::EpiSwiGLU, pg8::StaticOrder, true, true>(lds, g, S, E);
    }
    SEAM(4);
    if (IN(5)) {
        pg8::Gemm g{BIGH, Wd0, T, DM, DFF}; pg8::StaticOrder S; S.init(T, DM, G, vid);
        pg8::EpiRes E{XB, ssq + 2 * T};
        STAGGER();
        pg8::gemm_phase<pg8::EpiRes, pg8::StaticOrder, true, true>(lds, g, S, E);
    }
    SEAM(5);
    if (IN(6)) _Pragma("unroll") for (int rep = 0; rep < (PROBE_DUP == 6 ? 2 : 1); ++rep) {
        if (rep) GSYNC();
        pg8::Gemm g{XB, Win1, T, 3 * QKVW, DM}; pg8::StaticOrder S; S.init(T, 3 * QKVW, G, vid);
        pg8::EpiQKV E{BIGP, 3 * QKVW, ssq + 2 * T, cosT, sinT, rotT};
        STAGGER();
        pg8::gemm_phase<pg8::EpiQKV, pg8::StaticOrder, true, true>(lds, g, S, E);
    }
    SEAM(6);
    if (IN(7)) {
        constexpr int NU = 3 * BATCH * 4 * 32; const int per = (NU + G - 1) / G;
        bf16* BIGc = BIGP; float* lsep = lse;
        auto dec = [=](int u) { const int xblk = u / 1536, rem = u % 1536, gidx = rem >> 9, v = rem & 511, b = 4 * xblk + (v >> 7), kvh = (v >> 5) & 3, qa = v & 31;
            const int dsh = 2 * gidx, dil = 1 << dsh, nbk = 32 >> dsh, r = qa / nbk, qb = qa % nbk;
            bf16* base = BIGc + ((size_t)b * SEQ + r) * (3 * QKVW) + gidx * QKVW;
            return att::AU{base + kvh * 256, base + 1024 + kvh * 64, base + 1280 + kvh * 64, base + kvh * 256, (size_t)dil * 3 * QKVW, (size_t)dil * 3 * QKVW, SEQ >> dsh, qb * 64, nullptr,
                           lsep + ((size_t)gidx * T + (size_t)b * SEQ + r) * NH + kvh * 4, (size_t)dil * NH}; };
        att::phase<64, false, true>(lds, min(NU, bidA * per), min(NU, (bidA + 1) * per), dec);
    }
    SEAM(7);
    if (IN(8)) {
        const int gt = bid * NTHREADS + tid, NGT = G * NTHREADS;
        const int tpw = T / G;
#pragma unroll 4
        for (int il = tid; il < tpw * 128; il += NTHREADS) {
            const int i = bidA * tpw * 128 + il;
            const int tok = i >> 7, ch = i & 127, head = ch >> 3;
            const float l0 = lse[(size_t)tok * NH + head], l1 = lse[((size_t)T + tok) * NH + head], l2 = lse[((size_t)2 * T + tok) * NH + head];
            const float mx = fmaxf(l0, fmaxf(l1, l2)); float w0 = __builtin_amdgcn_exp2f(l0 - mx), w1 = __builtin_amdgcn_exp2f(l1 - mx), w2 = __builtin_amdgcn_exp2f(l2 - mx);
            const float inv = 1.0f / (w0 + w1 + w2); w0 *= inv; w1 *= inv; w2 *= inv;
            const bf16* src = BIGP + (size_t)tok * (3 * QKVW) + ch * 8;
            const v4u a0 = *(const v4u*)src, a1 = *(const v4u*)(src + QKVW), a2 = *(const v4u*)(src + 2 * QKVW);
            v4u o;
#pragma unroll
            for (int e = 0; e < 4; ++e) {
                const float x0 = __uint_as_float(a0[e] << 16), y0 = __uint_as_float(a0[e] & 0xffff0000u);
                const float x1 = __uint_as_float(a1[e] << 16), y1 = __uint_as_float(a1[e] & 0xffff0000u);
                const float x2 = __uint_as_float(a2[e] << 16), y2 = __uint_as_float(a2[e] & 0xffff0000u);
                o[e] = pk2(w0 * x0 + w1 * x1 + w2 * x2, w0 * y0 + w1 * y1 + w2 * y2);
            }
            *(v4u*)(OB + (size_t)tok * DM + ch * 8) = o;
        }
    }
    SEAM(8);
    if (IN(9)) {
        pg8::Gemm g{OB, Wout1, T, DM, DM}; pg8::StaticOrder S; S.init(T, DM, G, vid);
        pg8::EpiRes E{XB, ssq + 3 * T};
        STAGGER();
        pg8::gemm_phase<pg8::EpiRes, pg8::StaticOrder, true, true>(lds, g, S, E);
    }
    SEAM(9);
    if (IN(10)) _Pragma("unroll") for (int rep = 0; rep < (PROBE_DUP == 10 ? 2 : 1); ++rep) {
        if (rep) GSYNC();
        pg8::Gemm g{XB, Wgu1, T, 2 * DFF, DM}; pg8::StaticOrder S; S.init(T, 2 * DFF, G, vid);
        pg8::EpiSwiGLU E{BIGH, DFF, ssq + 3 * T};
        STAGGER();
        pg8::gemm_phase<pg8::EpiSwiGLU, pg8::StaticOrder, true, true>(lds, g, S, E);
    }
    SEAM(10);
    if (IN(11)) {
        pg8::Gemm g{BIGH, Wd1, T, DM, DFF}; pg8::StaticOrder S; S.init(T, DM, G, vid);
        pg8::EpiRes E{XB, ssq + 4 * T};
        STAGGER();
        pg8::gemm_phase<pg8::EpiRes, pg8::StaticOrder, true, true>(lds, g, S, E);
    }
    SEAM(11);
    if (IN(12)) {
        const int gt = bid * NTHREADS + tid, NGT = G * NTHREADS;
        const int tpw = T / G;
#pragma unroll 4
        for (int il = tid; il < tpw * 128; il += NTHREADS) {
            const int i = bidA * tpw * 128 + il;
            const int row = i >> 7, ch = i & 127;
            const float rstd = __builtin_amdgcn_rsqf((float)ssq[4 * T + row] * pg8::SSQ_INV + pg8::RMS_EPS);
            const v4u v = *(const v4u*)(XB + (size_t)row * DM + ch * 8);
            const f32x4 g0 = *(const f32x4*)(a.final_norm + ch * 8), g1 = *(const f32x4*)(a.final_norm + ch * 8 + 4);
            const f32x4 o0 = (f32x4){__uint_as_float(v.x << 16), __uint_as_float(v.x & 0xffff0000u), __uint_as_float(v.y << 16), __uint_as_float(v.y & 0xffff0000u)};
            const f32x4 o1 = (f32x4){__uint_as_float(v.z << 16), __uint_as_float(v.z & 0xffff0000u), __uint_as_float(v.w << 16), __uint_as_float(v.w & 0xffff0000u)};
            float* orow = X + (size_t)row * DM + ch * 8;
            *(f32x4*)orow = o0 * rstd * g0; *(f32x4*)(orow + 4) = o1 * rstd * g1;
        }
    }
#undef IN
#undef SEAM
}

extern "C" void kernel_launch(void* const* d_in, const int* in_sizes, int n_in, void* d_out, int out_size, void* d_ws, size_t ws_size, hipStream_t stream) {
    static int grid = 0;
    if (grid == 0) {
        if (n_in != 12 || in_sizes[0] != T * DM || out_size != T * DM || ws_size < WS_END) {
            fprintf(stderr, "kernel_launch: unexpected shapes (n_in %d, in0 %d, out %d, ws %zu, need %zu)\n", n_in, n_in > 0 ? in_sizes[0] : -1, out_size, ws_size, (size_t)WS_END); grid = -1; return; }
        int dev = 0, cus = 0, per_cu = 0;
        hipGetDevice(&dev); hipDeviceGetAttribute(&cus, hipDeviceAttributeMultiprocessorCount, dev);
        if (hipFuncSetAttribute((const void*)mega_fwd, hipFuncAttributeMaxDynamicSharedMemorySize, LDS_BYTES) != hipSuccess) { fprintf(stderr, "kernel_launch: hipFuncSetAttribute failed\n"); grid = -1; return; }
        if (hipOccupancyMaxActiveBlocksPerMultiprocessor(&per_cu, (const void*)mega_fwd, NTHREADS, LDS_BYTES) != hipSuccess || per_cu < 1) { fprintf(stderr, "kernel_launch: occupancy query gave %d\n", per_cu); per_cu = 1; }
        (void)hipGetLastError();
        grid = cus * per_cu;
        if (T % grid != 0) { fprintf(stderr, "kernel_launch: grid %d does not divide the %d tokens\n", grid, T); grid = -1; return; }
    }
    if (grid < 0) return;
    Args a{};
    a.x = (const float*)d_in[0]; a.a_w_in = (const float*)d_in[1]; a.a_sink = (const float*)d_in[2]; a.a_w_out = (const float*)d_in[3];
    a.b_w_in = (const float*)d_in[4]; a.b_w_out = (const float*)d_in[5]; a.norm_mix = (const float*)d_in[6]; a.norm_ffn = (const float*)d_in[7];
    a.w_gate = (const float*)d_in[8]; a.w_up = (const float*)d_in[9]; a.w_down = (const float*)d_in[10]; a.final_norm = (const float*)d_in[11];
    a.out = (float*)d_out; a.ws = (unsigned char*)d_ws;
#if MK_N_LAUNCHES == 1
    (void)hipMemsetAsync((char*)d_ws + WS_CTL, 0, 16384, stream);
    a.ph_lo = 0; a.ph_hi = N_PHASES;
    void* args[] = {&a};
    hipError_t e = hipLaunchCooperativeKernel((const void*)mega_fwd, dim3(grid), dim3(NTHREADS), args, LDS_BYTES, stream);
    if (e != hipSuccess) fprintf(stderr, "cooperative launch failed: %s (grid %d)\n", hipGetErrorString(e), grid);
#else
    for (int p = 0; p < N_PHASES; ++p) { a.ph_lo = p; a.ph_hi = p + 1; hipLaunchKernelGGL(mega_fwd, dim3(grid), dim3(NTHREADS), LDS_BYTES, stream, a); }
#endif
}
```

```cpp
#include <hip/hip_runtime.h>
#include <hip/hip_cooperative_groups.h>
#include <cstdio>
#include <cstdint>
namespace cg = cooperative_groups;

#ifndef PROBE_DUP
#define PROBE_DUP -1
#endif
#ifndef STAGGER_US
#define STAGGER_US 0
#endif
#ifndef XCD_LOCAL
#define XCD_LOCAL 1
#endif
#ifndef MK_N_LAUNCHES
#define MK_N_LAUNCHES 1
#endif

namespace pg8 {
#define PG8_LAS __attribute__((address_space(3)))
typedef unsigned short bf16_t;
typedef short bf16x8 __attribute__((ext_vector_type(8)));
typedef float f32x4 __attribute__((ext_vector_type(4)));
typedef unsigned u32x4 __attribute__((ext_vector_type(4)));
typedef unsigned u32x2 __attribute__((ext_vector_type(2)));
constexpr int BM = 256, BK = 64, HALF = 128, HTB = HALF * BK * 2, STAGE_BYTES = 8 * HTB, NXCD = 8, WGM = 8;

__host__ __device__ __forceinline__ int lds_byte(int r, int c) { const int st = (r >> 4) * 2 + (c >> 5), rr = r & 15, cc = c & 31, ob = rr * 64 + cc * 2; return st * 1024 + (ob ^ (((ob >> 9) & 1) << 5)); }
__host__ __device__ __forceinline__ void stage_rc(int b, int& R, int& C) { const int st = b / 1024, sb = b % 1024, swz = sb ^ (((sb >> 9) & 1) << 5); R = (st >> 1) * 16 + swz / 64; C = (st & 1) * 32 + (swz % 64) / 2; }
__host__ __device__ __forceinline__ int perm32(int rho) { const int n = rho >> 4, i = rho & 15; return 8 * (i >> 2) + 4 * n + (i & 3); }

struct Unit { int pm, pn; };
struct Gemm { const bf16_t* A; const bf16_t* Bt; int M, N, K; };

struct StaticOrder {
    int nM, nN, nwg, G, c;
    __host__ __device__ void init(int M, int N, int G_, int c_) { nM = M / BM; nN = N / BM; nwg = nM * nN; G = G_; c = c_; }
    __host__ __device__ bool next(int i, Unit& u) const {
        const long L = (long)i * G + c; if (L >= nwg) return false;
        int wgid = (int)L; { const int q = nwg / NXCD, r = nwg % NXCD, xcd = wgid % NXCD, off = wgid / NXCD; wgid = (xcd < r ? xcd * (q + 1) : r * (q + 1) + (xcd - r) * q) + off; }
        const int nig = WGM * nN, gid = wgid / nig, fm = gid * WGM, gsz = (nM - fm) < WGM ? (nM - fm) : WGM;
        u.pm = fm + ((wgid % nig) % gsz); u.pn = (wgid % nig) / gsz; return true;
    }
    __device__ __forceinline__ void a_ready(const Unit&) const {}
    __device__ __forceinline__ void done(const Unit&) const {}
};

__device__ __forceinline__ unsigned cvt_pk_bf16(float lo, float hi) { unsigned r; asm volatile("v_cvt_pk_bf16_f32 %0, %1, %2" : "=v"(r) : "v"(lo), "v"(hi)); return r; }

constexpr float RMS_EPS = 1e-6f;
constexpr float SSQ_SCALE = 2048.0f, SSQ_INV = 1.0f / (2048.0f * 1024.0f);
constexpr float QSCALE = 0.125f * 1.4426950408889634f;


struct EpiQKV {
    static constexpr bool PERM = true, AFTER_DRAIN = false;
    bf16_t* O; int ldc; const unsigned* ssq; const float* cosT; const float* sinT; const float* rot;
    __device__ __forceinline__ void operator()(const f32x4 (&acc)[2][2][4][2], const Unit& u, int wr, int wc, int fr, int fq) const {
        const int row0 = u.pm * BM + wr * 64 + fr; const int t6 = u.pn % 6;
        const int col0 = u.pn * BM + wc * 32 + 8 * fq; const int fi = 16 * (wc & 1) + 4 * fq;
        const float qs = t6 < 4 ? QSCALE : 1.0f; const bool rope = t6 < 5;
        unsigned sq[8];
#pragma unroll
        for (int i = 0; i < 8; ++i) { const int row = row0 + (i >> 2) * HALF + (i & 3) * 16; sq[i] = ssq[row]; }
        f32x4 c0 = (f32x4){1.f, 1.f, 1.f, 1.f}, s0 = (f32x4){0.f, 0.f, 0.f, 0.f}, c16 = c0, s16 = s0, c128 = c0, s128 = s0;
        if (rope) { const int t0 = row0 & 2047;
            c0 = *(const f32x4*)(cosT + t0 * 32 + fi); s0 = *(const f32x4*)(sinT + t0 * 32 + fi);
            c16 = *(const f32x4*)(rot + fi); s16 = *(const f32x4*)(rot + 32 + fi); c128 = *(const f32x4*)(rot + 64 + fi); s128 = *(const f32x4*)(rot + 96 + fi); }
        asm volatile("" ::: "memory");
#pragma unroll
        for (int ai = 0; ai < 2; ++ai) {
            f32x4 c = c0, sn = s0;
            if (ai == 1) { c = c0 * c128 - s0 * s128; sn = s0 * c128 + c0 * s128; }
#pragma unroll
            for (int m = 0; m < 4; ++m) {
                const int row = row0 + ai * HALF + m * 16;
                const float s1 = __builtin_amdgcn_rsqf((float)sq[ai * 4 + m] * SSQ_INV + RMS_EPS) * qs; const f32x4 c1 = c * s1, n1 = sn * s1;
                bf16_t* rowp = O + (size_t)row * ldc + col0;
#pragma unroll
                for (int bj = 0; bj < 2; ++bj) {
                    const f32x4 v0 = acc[ai][bj][m][0], v1 = acc[ai][bj][m][1];
                    const f32x4 o0 = v0 * c1 - v1 * n1, o1 = v1 * c1 + v0 * n1;
                    u32x4 w; w.x = cvt_pk_bf16(o0[0], o0[1]); w.y = cvt_pk_bf16(o0[2], o0[3]); w.z = cvt_pk_bf16(o1[0], o1[1]); w.w = cvt_pk_bf16(o1[2], o1[3]);
                    *(u32x4*)(rowp + bj * HALF) = w; }
                if (m < 3) { const f32x4 cn = c * c16 - sn * s16; sn = sn * c16 + c * s16; c = cn; }
            }
        }
    }
};

struct EpiSwiGLU {
    static constexpr bool PERM = true, AFTER_DRAIN = false;
    bf16_t* O; int ldc; const unsigned* ssq;
    __device__ __forceinline__ void operator()(const f32x4 (&acc)[2][2][4][2], const Unit& u, int wr, int wc, int fr, int fq) const {
        const int row0 = u.pm * BM + wr * 64 + fr; const int col0 = u.pn * HALF + wc * 32 + 8 * fq;
        unsigned sq[8];
#pragma unroll
        for (int i = 0; i < 8; ++i) sq[i] = ssq[row0 + (i >> 2) * HALF + (i & 3) * 16];
        asm volatile("" ::: "memory");
#pragma unroll
        for (int i = 0; i < 8; ++i) {
            const int ai = i >> 2, m = i & 3; const int row = row0 + ai * HALF + m * 16;
            const float rstd = __builtin_amdgcn_rsqf((float)sq[i] * SSQ_INV + RMS_EPS), nr = -1.4426950408889634f * rstd, r2 = rstd * rstd;
            float h[8];
#pragma unroll
            for (int n = 0; n < 2; ++n)
#pragma unroll
                for (int e = 0; e < 4; ++e) { const float ag = acc[ai][0][m][n][e], au = acc[ai][1][m][n][e];
                    h[n * 4 + e] = (ag * au) * (r2 * __builtin_amdgcn_rcpf(1.0f + __builtin_amdgcn_exp2f(ag * nr))); }
            u32x4 w; w.x = cvt_pk_bf16(h[0], h[1]); w.y = cvt_pk_bf16(h[2], h[3]); w.z = cvt_pk_bf16(h[4], h[5]); w.w = cvt_pk_bf16(h[6], h[7]);
            *(u32x4*)(O + (size_t)row * ldc + col0) = w;
        }
    }
};

struct EpiRes {
    static constexpr bool PERM = true, AFTER_DRAIN = false;
    bf16_t* xb; unsigned* ssq;
    __device__ __forceinline__ void operator()(const f32x4 (&acc)[2][2][4][2], const Unit& u, int wr, int wc, int fr, int fq) const {
        const int row0 = u.pm * BM + wr * 64 + fr; const int col0 = u.pn * BM + wc * 32 + 8 * fq;
#pragma unroll
        for (int i = 0; i < 8; ++i) {
            const int ai = i >> 2, m = i & 3; const int row = row0 + ai * HALF + m * 16; bf16_t* rowp = xb + (size_t)row * 1024 + col0; float s = 0.f;
            u32x4 xv[2];
#pragma unroll
            for (int bj = 0; bj < 2; ++bj) xv[bj] = *(const u32x4*)(rowp + bj * HALF);
#pragma unroll
            for (int bj = 0; bj < 2; ++bj) {
                float o[8];
#pragma unroll
                for (int e = 0; e < 4; ++e) { o[2 * e] = __uint_as_float(xv[bj][e] << 16) + acc[ai][bj][m][e >> 1][(2 * e) & 3]; o[2 * e + 1] = __uint_as_float(xv[bj][e] & 0xffff0000u) + acc[ai][bj][m][e >> 1][(2 * e + 1) & 3]; }
#pragma unroll
                for (int e = 0; e < 8; ++e) s += o[e] * o[e];
                u32x4 w; w.x = cvt_pk_bf16(o[0], o[1]); w.y = cvt_pk_bf16(o[2], o[3]); w.z = cvt_pk_bf16(o[4], o[5]); w.w = cvt_pk_bf16(o[6], o[7]);
                *(u32x4*)(rowp + bj * HALF) = w;
            }
            s += __shfl_xor(s, 16); s += __shfl_xor(s, 32);
            if (fq == 0) atomicAdd(ssq + row, (unsigned)(s * SSQ_SCALE + 0.5f));
        }
    }
};

template <class Epi, class Sched, bool ALIGN_EPI = false, bool SP2 = false>
__device__ __forceinline__ void gemm_phase(PG8_LAS unsigned char* lds, const Gemm g, const Sched& S, const Epi& E) {
    const int tid = threadIdx.x, wid = __builtin_amdgcn_readfirstlane(tid >> 6), lane = tid & 63, wr = wid >> 2, wc = wid & 3, fr = lane & 15, fq = lane >> 4;
    const int K = g.K, nt = K / BK;
    unsigned voffA[2], voffB[2];
#pragma unroll
    for (int i = 0; i < 2; ++i) { int R, C; stage_rc(tid * 16 + i * 8192, R, C); const int Rb = Epi::PERM ? ((R & ~31) + perm32(R & 31)) : R;
        voffA[i] = (unsigned)(R * K + C) * 2u; voffB[i] = (unsigned)(Rb * K + C) * 2u; }
    const size_t kstep = (size_t)(BK * 2);
    const size_t hstep = (size_t)HALF * K * 2;
    const size_t tstep = 2 * hstep;
    const unsigned ldsw = (unsigned)wid * 1024u;
    const int aoff = lds_byte(wr * 64 + fr, fq * 8), boff = lds_byte(wc * 32 + fr, fq * 8);
#define PG8_SA(b, h) (((b) * 2 + (h)) * HTB)
#define PG8_SB(b, h) ((4 + (b) * 2 + (h)) * HTB)
#define PG8_STAGE(bufoff, gbase, voff) do { _Pragma("unroll") for (int _i = 0; _i < 2; ++_i) \
        __builtin_amdgcn_global_load_lds((const unsigned*)((const char*)(gbase) + (voff)[_i]), (PG8_LAS unsigned*)(lds + (bufoff) + ldsw + _i * 8192), 16, 0, 0); } while (0)
#define PG8_LDA(dst, b, h) do { _Pragma("unroll") for (int m = 0; m < 4; ++m) _Pragma("unroll") for (int k = 0; k < 2; ++k) dst[m][k] = *(const PG8_LAS bf16x8*)(lds + PG8_SA(b, h) + aoff + m * 2048 + k * 1024); } while (0)
#define PG8_LDB(dst, b, h) do { _Pragma("unroll") for (int n = 0; n < 2; ++n) _Pragma("unroll") for (int k = 0; k < 2; ++k) dst[n][k] = *(const PG8_LAS bf16x8*)(lds + PG8_SB(b, h) + boff + n * 2048 + k * 1024); } while (0)
#define PG8_MMA(ai, bj, At, Bt) do { __builtin_amdgcn_s_setprio(1); _Pragma("unroll") for (int m = 0; m < 4; ++m) _Pragma("unroll") for (int n = 0; n < 2; ++n) _Pragma("unroll") for (int k = 0; k < 2; ++k) \
        acc[ai][bj][m][n] = __builtin_amdgcn_mfma_f32_16x16x32_bf16(Bt[n][k], At[m][k], acc[ai][bj][m][n], 0, 0, 0); __builtin_amdgcn_s_setprio(0); } while (0)
#define PG8_WAIT_V(n) asm volatile("s_waitcnt vmcnt(" #n ")" ::: "memory")
#define PG8_WAIT_L(n) asm volatile("s_waitcnt lgkmcnt(" #n ")" ::: "memory")
#define PG8_BAR __builtin_amdgcn_s_barrier()
#define PG8_SCHED __builtin_amdgcn_sched_barrier(0)
    Unit cur, nxt; int ui = 0;
    if (!S.next(0, cur)) return;
    f32x4 acc[2][2][4][2];
#pragma unroll
    for (int a = 0; a < 2; ++a)
#pragma unroll
        for (int b = 0; b < 2; ++b)
#pragma unroll
            for (int m = 0; m < 4; ++m)
#pragma unroll
                for (int n = 0; n < 2; ++n) acc[a][b][m][n] = (f32x4){0.f, 0.f, 0.f, 0.f};
    bf16x8 At[4][2], B0[2][2], B1[2][2];
    const char* cA = (const char*)g.A + (size_t)cur.pm * tstep; const char* cB = (const char*)g.Bt + (size_t)cur.pn * tstep;
    S.a_ready(cur);
    if constexpr (SP2) {
        PG8_STAGE(PG8_SB(0, 0), cB, voffB); PG8_STAGE(PG8_SB(0, 1), cB + hstep, voffB); PG8_STAGE(PG8_SA(0, 0), cA, voffA); PG8_STAGE(PG8_SA(0, 1), cA + hstep, voffA);
        if (wr == 1) PG8_BAR;
        PG8_WAIT_V(2); PG8_BAR;
        PG8_STAGE(PG8_SB(1, 0), cB + kstep, voffB); PG8_STAGE(PG8_SA(1, 0), cA + kstep, voffA); PG8_STAGE(PG8_SB(1, 1), cB + hstep + kstep, voffB);
        PG8_WAIT_V(6); PG8_BAR;
    } else {
        PG8_STAGE(PG8_SB(0, 0), cB, voffB); PG8_STAGE(PG8_SA(0, 0), cA, voffA); PG8_STAGE(PG8_SB(0, 1), cB + hstep, voffB); PG8_STAGE(PG8_SA(0, 1), cA + hstep, voffA);
        if (wr == 1) PG8_BAR;
        PG8_WAIT_V(4); PG8_BAR;
        PG8_STAGE(PG8_SB(1, 0), cB + kstep, voffB); PG8_STAGE(PG8_SA(1, 0), cA + kstep, voffA); PG8_STAGE(PG8_SB(1, 1), cB + hstep + kstep, voffB);
        PG8_WAIT_V(6); PG8_BAR;
    }
    for (;;) {
        const bool has_next = S.next(ui + 1, nxt);
        const char* nA = has_next ? (const char*)g.A + (size_t)nxt.pm * tstep : cA; const char* nB = has_next ? (const char*)g.Bt + (size_t)nxt.pn * tstep : cB;
        for (int t = 0; t < nt; t += 2) {
            const bool last = (t == nt - 2);
            const char* a1 = cA + (size_t)(t + 1) * kstep;
            const char* a2 = last ? nA : cA + (size_t)(t + 2) * kstep; const char* b2 = last ? nB : cB + (size_t)(t + 2) * kstep;
            const char* a3 = a2 + kstep; const char* b3 = b2 + kstep;
            if (last && has_next) S.a_ready(nxt);
            if constexpr (SP2) {
            PG8_LDB(B0, 0, 0); PG8_LDB(B1, 0, 1); PG8_SCHED; PG8_LDA(At, 0, 0); PG8_STAGE(PG8_SA(1, 1), a1 + hstep, voffA);
            PG8_WAIT_V(8); PG8_WAIT_L(0); PG8_BAR; PG8_MMA(0, 0, At, B0); PG8_MMA(0, 1, At, B1); PG8_BAR; PG8_SCHED;
            PG8_LDA(At, 0, 1); PG8_STAGE(PG8_SB(0, 0), b2, voffB); PG8_STAGE(PG8_SB(0, 1), b2 + hstep, voffB); PG8_STAGE(PG8_SA(0, 0), a2, voffA);
            PG8_WAIT_V(8); PG8_WAIT_L(0); PG8_BAR; PG8_MMA(1, 0, At, B0); PG8_MMA(1, 1, At, B1); PG8_BAR; PG8_SCHED;
            PG8_LDB(B0, 1, 0); PG8_LDB(B1, 1, 1); PG8_SCHED; PG8_LDA(At, 1, 0); PG8_STAGE(PG8_SA(0, 1), a2 + hstep, voffA);
            PG8_WAIT_V(8); PG8_WAIT_L(0); PG8_BAR; PG8_MMA(0, 0, At, B0); PG8_MMA(0, 1, At, B1); PG8_BAR; PG8_SCHED;
            PG8_LDA(At, 1, 1); PG8_STAGE(PG8_SB(1, 0), b3, voffB); PG8_STAGE(PG8_SB(1, 1), b3 + hstep, voffB); PG8_STAGE(PG8_SA(1, 0), a3, voffA);
            PG8_WAIT_V(8); PG8_WAIT_L(0); PG8_BAR; PG8_MMA(1, 0, At, B0); PG8_MMA(1, 1, At, B1); PG8_BAR; PG8_SCHED;
            } else {
            PG8_LDB(B0, 0, 0); PG8_SCHED; PG8_LDA(At, 0, 0); PG8_STAGE(PG8_SA(1, 1), a1 + hstep, voffA);
            PG8_WAIT_L(8); PG8_BAR; PG8_WAIT_L(0); PG8_MMA(0, 0, At, B0); PG8_BAR; PG8_SCHED;
            PG8_LDB(B1, 0, 1); PG8_STAGE(PG8_SB(0, 0), b2, voffB);
            PG8_BAR; PG8_WAIT_L(0); PG8_MMA(0, 1, At, B1); PG8_BAR;
            PG8_LDA(At, 0, 1); PG8_STAGE(PG8_SA(0, 0), a2, voffA);
            PG8_BAR; PG8_WAIT_L(0); PG8_MMA(1, 0, At, B0); PG8_BAR; PG8_SCHED;
            PG8_STAGE(PG8_SB(0, 1), b2 + hstep, voffB);
            PG8_WAIT_V(6); PG8_BAR; PG8_MMA(1, 1, At, B1); PG8_BAR;
            PG8_LDB(B0, 1, 0); PG8_SCHED; PG8_LDA(At, 1, 0); PG8_STAGE(PG8_SA(0, 1), a2 + hstep, voffA);
            PG8_WAIT_L(8); PG8_BAR; PG8_WAIT_L(0); PG8_MMA(0, 0, At, B0); PG8_BAR; PG8_SCHED;
            PG8_LDB(B1, 1, 1); PG8_STAGE(PG8_SB(1, 0), b3, voffB);
            PG8_BAR; PG8_WAIT_L(0); PG8_MMA(0, 1, At, B1); PG8_BAR;
            PG8_LDA(At, 1, 1); PG8_STAGE(PG8_SA(1, 0), a3, voffA);
            PG8_BAR; PG8_WAIT_L(0); PG8_MMA(1, 0, At, B0); PG8_BAR; PG8_SCHED;
            PG8_STAGE(PG8_SB(1, 1), b3 + hstep, voffB);
            PG8_WAIT_V(6); PG8_BAR; PG8_MMA(1, 1, At, B1); PG8_BAR;
            }
        }
        if constexpr (ALIGN_EPI) { if (wr == 0) PG8_BAR; }
        if constexpr (!Epi::AFTER_DRAIN) { E(acc, cur, wr, wc, fr, fq); S.done(cur); }
        if (!has_next) break;
#pragma unroll
        for (int a = 0; a < 2; ++a)
#pragma unroll
            for (int b = 0; b < 2; ++b)
#pragma unroll
                for (int m = 0; m < 4; ++m)
#pragma unroll
                    for (int n = 0; n < 2; ++n) acc[a][b][m][n] = (f32x4){0.f, 0.f, 0.f, 0.f};
        cur = nxt; cA = nA; cB = nB; ++ui;
        if constexpr (ALIGN_EPI) { if (wr == 1) PG8_BAR; }
    }
    PG8_WAIT_V(0);
    if constexpr (!ALIGN_EPI) { if (wr == 0) PG8_BAR; }
    PG8_BAR;
#undef PG8_SA
#undef PG8_SB
#undef PG8_STAGE
#undef PG8_LDA
#undef PG8_LDB
#undef PG8_MMA
#undef PG8_WAIT_V
#undef PG8_WAIT_L
#undef PG8_BAR
#undef PG8_SCHED
}
}

namespace att {
#define ATT_LAS __attribute__((address_space(3)))
typedef unsigned short bf16_t;
typedef short bf16x8 __attribute__((ext_vector_type(8)));
typedef short s16x4 __attribute__((ext_vector_type(4)));
typedef float f32x16 __attribute__((ext_vector_type(16)));
typedef unsigned u32x4 __attribute__((ext_vector_type(4)));
typedef unsigned u32x2 __attribute__((ext_vector_type(2)));
__device__ __forceinline__ int crow(int r, int hi) { return (r & 3) + 8 * (r >> 2) + 4 * hi; }
__device__ __forceinline__ unsigned swz(int row, int ch) { return (unsigned)(row * 128 + ((ch ^ ((((row >> 1) & 1) << 2) | ((row >> 2) & 3))) << 4)); }
__device__ __forceinline__ float swap32f(float v) { auto rr = __builtin_amdgcn_permlane32_swap(__float_as_uint(v), __float_as_uint(v), false, false); return (threadIdx.x & 32) ? __uint_as_float(rr[0]) : __uint_as_float(rr[1]); }
__device__ __forceinline__ unsigned pk(float lo, float hi) { unsigned r; asm volatile("v_cvt_pk_bf16_f32 %0, %1, %2" : "=v"(r) : "v"(lo), "v"(hi)); return r; }

struct AU { const bf16_t* Q; const bf16_t* K; const bf16_t* V; bf16_t* O; size_t rstride, ostride; int L, q0; const float* sink; float* lse; size_t lstride; };

template <int W, bool SINK, bool LSEOUT, class Dec, bool SKIPT = false>
__device__ __forceinline__ void phase(ATT_LAS unsigned char* lds, int ub, int ue, const Dec& dec) {
    constexpr int NK = 64 + 2 * W, NCH = NK * 8, PER = NCH / 512, NT = 2 * W / 32 + 1, VOFF = NK * 128;
    static_assert(NCH % 512 == 0, "staging split");
    if (ub >= ue) return;
    const int tid = threadIdx.x, lane = tid & 63, r32 = lane & 31, hi = lane >> 5, wid = __builtin_amdgcn_readfirstlane(tid >> 6), h = wid & 3, sb = wid >> 2;
    const int qq = (lane & 15) >> 2, p = lane & 3, blk = (lane >> 4) & 1;
    const int fk = (((r32 >> 1) & 1) << 2) | ((r32 >> 2) & 3);
    unsigned kaddr[4];
#pragma unroll
    for (int d0 = 0; d0 < 4; ++d0) kaddr[d0] = (unsigned)(r32 * 128 + (((2 * d0 + hi) ^ fk) << 4));
    unsigned vaddr[2][2];
#pragma unroll
    for (int c = 0; c < 2; ++c)
#pragma unroll
        for (int hf = 0; hf < 2; ++hf) { const int fv = ((qq >> 1) << 2) | ((2 * hf + hi) & 3);
            vaddr[c][hf] = (unsigned)(VOFF + (8 * hf + 4 * hi + qq) * 128 + (((4 * c + 2 * blk + (p >> 1)) ^ fv) << 4) + 8 * (p & 1)); }
    u32x4 kreg[PER], vreg[PER]; unsigned kmask[PER]; bf16x8 qn[4]; float sinkn = 0.f;
#define ATT_LOAD(U) do { \
        _Pragma("unroll") for (int i_ = 0; i_ < PER; ++i_) { const int cid_ = tid + 512 * i_, row_ = cid_ >> 3, ch_ = cid_ & 7, kp_ = (U).q0 - W + row_; \
            const int kc_ = min(max(kp_, 0), (U).L - 1); const unsigned ok_ = (kp_ == kc_) ? 0xffffffffu : 0u;     \
            kreg[i_] = *(const u32x4*)((U).K + (size_t)kc_ * (U).rstride + ch_ * 8); vreg[i_] = *(const u32x4*)((U).V + (size_t)kc_ * (U).rstride + ch_ * 8); kmask[i_] = ok_; } \
        { const bf16_t* qp_ = (U).Q + (size_t)((U).q0 + 32 * sb + r32) * (U).rstride + h * 64 + 8 * hi; \
          if (SINK) sinkn = (U).sink[h]; \
          _Pragma("unroll") for (int d0_ = 0; d0_ < 4; ++d0_) qn[d0_] = *(const bf16x8*)(qp_ + 16 * d0_); } } while (0)
#define ATT_PIN() asm volatile("" : "+v"(qn[3]))
    if (wid >= 4) __builtin_amdgcn_s_setprio(1);
    AU cur = dec(ub);
    ATT_LOAD(cur); ATT_PIN();
    for (int u = ub; u < ue; ++u) {
        const float sink2 = sinkn * 1.4426950408889634f;
#pragma unroll
        for (int i = 0; i < PER; ++i) { const int cid = tid + 512 * i, row = cid >> 3, ch = cid & 7; const unsigned o = swz(row, ch);
            *(ATT_LAS u32x4*)(lds + o) = kreg[i] & kmask[i]; *(ATT_LAS u32x4*)(lds + VOFF + o) = vreg[i] & kmask[i]; }
        bf16x8 qf[4];
#pragma unroll
        for (int d0 = 0; d0 < 4; ++d0) qf[d0] = qn[d0];
        asm volatile("s_waitcnt lgkmcnt(0)" ::: "memory"); __builtin_amdgcn_s_barrier(); asm volatile("" ::: "memory");
        const AU nxt = dec(min(u + 1, ue - 1));
        ATT_LOAD(nxt);
        const int q0 = cur.q0, L = cur.L; const int qrow = q0 + 32 * sb + r32;
        float m = 0.f, l = 0.f; f32x16 o0 = {}, o1 = {}, negm = {};
        const float NEG = -INFINITY;
        const int tb = q0 - W + 32 * sb;
        const int j0 = tb < 0 ? (-tb) >> 5 : 0; const int j1 = SKIPT ? j0 - 1 : min(NT - 1, (L - 32 - tb) >> 5);
        bf16x8 kf[4];
        { const unsigned rb0 = (unsigned)((32 * sb + 32 * j0) * 128);
#pragma unroll
          for (int d0 = 0; d0 < 4; ++d0) kf[d0] = *(const ATT_LAS bf16x8*)(lds + rb0 + kaddr[d0]); }
        for (int j = j0; j <= j1; ++j) {
            const unsigned rb = (unsigned)((32 * sb + 32 * j) * 128);
            f32x16 S = negm;
#pragma unroll
            for (int d0 = 0; d0 < 4; ++d0) S = __builtin_amdgcn_mfma_f32_32x32x16_bf16(kf[d0], qf[d0], S, 0, 0, 0);
            s16x4 vv[2][2][2];
#pragma unroll
            for (int s2 = 0; s2 < 2; ++s2)
#pragma unroll
                for (int c = 0; c < 2; ++c)
#pragma unroll
                    for (int hf = 0; hf < 2; ++hf) vv[s2][c][hf] = __builtin_bit_cast(s16x4, __builtin_amdgcn_ds_read_tr16_b64_v4i16((ATT_LAS s16x4*)(lds + rb + s2 * 2048 + vaddr[c][hf])));
            { const unsigned rbn = j < j1 ? rb + 4096u : rb;
#pragma unroll
              for (int d0 = 0; d0 < 4; ++d0) kf[d0] = *(const ATT_LAS bf16x8*)(lds + rbn + kaddr[d0]); }
            __builtin_amdgcn_sched_barrier(0);
            if (j == 0) {
#pragma unroll
                for (int r = 0; r < 16; ++r) if (crow(r, hi) < r32) S[r] = NEG; }
            if (j == NT - 1) {
#pragma unroll
                for (int r = 0; r < 16; ++r) if (crow(r, hi) > r32) S[r] = NEG; }
            float mx = fmaxf(fmaxf(S[0], S[1]), S[2]);
#pragma unroll
            for (int r = 3; r < 15; r += 2) mx = fmaxf(fmaxf(mx, S[r]), S[r + 1]);
            mx = fmaxf(mx, S[15]);
            { auto rr = __builtin_amdgcn_permlane32_swap(__float_as_uint(mx), __float_as_uint(mx), false, false); mx = fmaxf(__uint_as_float(rr[0]), __uint_as_float(rr[1])); }
            if (j == j0) {
                float mr = mx; if (SINK) mr = fmaxf(mr, sink2);
                m = mr; l = 0.f; if (SINK) l = hi == 0 ? __builtin_amdgcn_exp2f(sink2 - mr) : 0.f;
#pragma unroll
                for (int r = 0; r < 16; ++r) { S[r] -= mr; negm[r] = -mr; }
            } else if (__builtin_amdgcn_ballot_w64(mx > 8.0f) != 0ull) {
                const float d = fmaxf(mx, 0.f), alpha = __builtin_amdgcn_exp2f(-d); m += d; l *= alpha;
#pragma unroll
                for (int r = 0; r < 16; ++r) { S[r] -= d; negm[r] = -m; o0[r] *= alpha; o1[r] *= alpha; }
            }
            float ls0 = 0.f, ls1 = 0.f;
#pragma unroll
            for (int r = 0; r < 16; r += 2) { S[r] = __builtin_amdgcn_exp2f(S[r]); S[r + 1] = __builtin_amdgcn_exp2f(S[r + 1]); ls0 += S[r]; ls1 += S[r + 1]; }
            l += ls0 + ls1;
            u32x4 pw0, pw1;
            pw0.x = pk(S[0], S[1]); pw0.y = pk(S[2], S[3]); pw0.z = pk(S[4], S[5]); pw0.w = pk(S[6], S[7]);
            pw1.x = pk(S[8], S[9]); pw1.y = pk(S[10], S[11]); pw1.z = pk(S[12], S[13]); pw1.w = pk(S[14], S[15]);
            const bf16x8 pa0 = __builtin_bit_cast(bf16x8, pw0), pa1 = __builtin_bit_cast(bf16x8, pw1);
#pragma unroll
            for (int s2 = 0; s2 < 2; ++s2) {
                const bf16x8 pa = s2 ? pa1 : pa0;
#pragma unroll
                for (int c = 0; c < 2; ++c) {
                    const s16x4 v0 = vv[s2][c][0], v1 = vv[s2][c][1];
                    const bf16x8 vf = (bf16x8){v0[0], v0[1], v0[2], v0[3], v1[0], v1[1], v1[2], v1[3]};
                    if (c == 0) o0 = __builtin_amdgcn_mfma_f32_32x32x16_bf16(vf, pa, o0, 0, 0, 0); else o1 = __builtin_amdgcn_mfma_f32_32x32x16_bf16(vf, pa, o1, 0, 0, 0);
                }
            }
        }
        float lt; { auto rr = __builtin_amdgcn_permlane32_swap(__float_as_uint(l), __float_as_uint(l), false, false); lt = __uint_as_float(rr[0]) + __uint_as_float(rr[1]); }
        const float inv = 1.0f / lt;
        unsigned char* rbp = (unsigned char*)(cur.O + (size_t)qrow * cur.ostride + h * 64) + (hi ? 16 : 0);
#pragma unroll
        for (int kp = 0; kp < 4; ++kp) {
            const int c = kp >> 1, g0 = 2 * (kp & 1);
            unsigned ax, ay, bx, by;
            if (c == 0) { ax = pk(o0[4 * g0] * inv, o0[4 * g0 + 1] * inv); ay = pk(o0[4 * g0 + 2] * inv, o0[4 * g0 + 3] * inv); bx = pk(o0[4 * g0 + 4] * inv, o0[4 * g0 + 5] * inv); by = pk(o0[4 * g0 + 6] * inv, o0[4 * g0 + 7] * inv); }
            else        { ax = pk(o1[4 * g0] * inv, o1[4 * g0 + 1] * inv); ay = pk(o1[4 * g0 + 2] * inv, o1[4 * g0 + 3] * inv); bx = pk(o1[4 * g0 + 4] * inv, o1[4 * g0 + 5] * inv); by = pk(o1[4 * g0 + 6] * inv, o1[4 * g0 + 7] * inv); }
            { auto r = __builtin_amdgcn_permlane32_swap(ax, bx, false, false); ax = r[0]; bx = r[1]; }
            { auto r = __builtin_amdgcn_permlane32_swap(ay, by, false, false); ay = r[0]; by = r[1]; }
            *(u32x4*)(rbp + 32 * kp) = (u32x4){ax, ay, bx, by};
        }
        if (LSEOUT) { if (hi == 0) cur.lse[(size_t)qrow * cur.lstride + h] = m + __builtin_amdgcn_logf(lt); }
        asm volatile("s_waitcnt lgkmcnt(0)" ::: "memory"); __builtin_amdgcn_s_barrier(); asm volatile("" ::: "memory");
        ATT_PIN();
        cur = nxt;
    }
    __builtin_amdgcn_s_setprio(0);
#undef ATT_LOAD
#undef ATT_PIN
}
}

#define LAS __attribute__((address_space(3)))
typedef unsigned short bf16;
typedef unsigned v4u __attribute__((ext_vector_type(4)));
typedef float f32x4 __attribute__((ext_vector_type(4)));
constexpr int NWAVES = 8, NTHREADS = 512;
constexpr int BATCH = 32, SEQ = 2048, DM = 1024, T = BATCH * SEQ, DFF = 2816, QKVW = 1536, NH = 16;
constexpr int LDS_BYTES = 135168;
constexpr size_t MiB = 1u << 20;
constexpr size_t WS_WIN0 = 0;
constexpr size_t WS_WOUT0 = WS_WIN0 + (size_t)1536 * 1024 * 2;
constexpr size_t WS_WIN1 = WS_WOUT0 + (size_t)1024 * 1024 * 2;
constexpr size_t WS_WOUT1 = WS_WIN1 + (size_t)4608 * 1024 * 2;
constexpr size_t WS_WGU0 = WS_WOUT1 + (size_t)1024 * 1024 * 2;
constexpr size_t WS_WGU1 = WS_WGU0 + (size_t)5632 * 1024 * 2;
constexpr size_t WS_WD0 = WS_WGU1 + (size_t)5632 * 1024 * 2;
constexpr size_t WS_WD1 = WS_WD0 + (size_t)1024 * 2816 * 2;
constexpr size_t WS_COS = WS_WD1 + (size_t)1024 * 2816 * 2;
constexpr size_t WS_SIN = WS_COS + (size_t)2048 * 32 * 4;
constexpr size_t WS_SSQ = WS_SIN + (size_t)2048 * 32 * 4;
constexpr size_t WS_LSE = WS_SSQ + (size_t)5 * T * 4;
constexpr size_t WS_CTL = 71 * MiB;
constexpr size_t WS_ROT = 71 * MiB + 65536;
constexpr size_t WS_XB = 72 * MiB;
constexpr size_t WS_O = WS_XB + 128 * MiB;
constexpr size_t WS_BIG = WS_O + 128 * MiB;
constexpr size_t WS_END = WS_BIG + (size_t)T * 4608 * 2;
static_assert(WS_LSE + (size_t)3 * T * 16 * 4 <= WS_XB, "ws map");

__device__ __forceinline__ unsigned f2bf(float f) { unsigned u = __builtin_bit_cast(unsigned, f); return (u + 0x7fffu + ((u >> 16) & 1u)) >> 16; }
__device__ __forceinline__ unsigned pk2(float lo, float hi) { return f2bf(lo) | (f2bf(hi) << 16); }
__device__ __forceinline__ float wave_sum(float v) {
#pragma unroll
    for (int o = 1; o < 64; o <<= 1) v += __shfl_xor(v, o);
    return v;
}
__device__ __forceinline__ void transpose_item(const float* Wa, const float* Wb, int mode, const float* gain, int K, int Nsrc, bf16* WT, int nblk, LAS float* scr, int item, int lane) {
    const int kb = item / nblk, nb = item % nblk, k0 = 64 * kb, n0 = 32 * nb;
    const int np = n0 + (lane & 31); const float* W = Wa; int ncol = np;
    if (mode == 1) { const int grp = np / 1536; int c = np % 1536;
        if (c < 1280) { const int head = c >> 6, pp = c & 63, j = pp >> 3, e = pp & 7; c = head * 64 + (e < 4 ? 4 * j + e : 32 + 4 * j + (e - 4)); }
        ncol = grp * 1536 + c; }
    else if (mode == 2) { const int pn = np >> 8, wi = np & 255; W = (wi >> 7) ? Wb : Wa; ncol = pn * 128 + (wi & 127); }
    float wv[32], gv[32];
#pragma unroll
    for (int i = 0; i < 32; ++i) { const int kk = 2 * i + (lane >> 5); wv[i] = W[(size_t)(k0 + kk) * Nsrc + ncol]; gv[i] = gain ? gain[k0 + kk] : 1.0f; }
#pragma unroll
    for (int i = 0; i < 32; ++i) { const int kk = 2 * i + (lane >> 5); scr[kk * 33 + (lane & 31)] = wv[i] * gv[i]; }
    asm volatile("s_waitcnt lgkmcnt(0)" ::: "memory");
    const int c = lane & 7;
#pragma unroll
    for (int j = 0; j < 4; ++j) { const int n = (lane >> 3) + 8 * j; const LAS float* s = scr + (8 * c) * 33 + n;
        v4u o; o.x = pk2(s[0 * 33], s[1 * 33]); o.y = pk2(s[2 * 33], s[3 * 33]); o.z = pk2(s[4 * 33], s[5 * 33]); o.w = pk2(s[6 * 33], s[7 * 33]);
        *(v4u*)(WT + (size_t)(n0 + n) * K + k0 + 8 * c) = o; }
    asm volatile("s_waitcnt lgkmcnt(0)" ::: "memory");
}

#define XB_TMO      128
#define XB_XCNT(j)  (256  + 64 * (j))
#define XB_XSUB(j)  (1280 + 64 * (j))
#define XB_XGEN(j)  (2304 + 64 * (j))
#define XB_TOP      3328
#define XB_TOPGEN   3392
#define XCD_BAR_WORDS 3456
#define XB_SPIN_CAP (1u << 18)
__device__ __forceinline__ unsigned xb_ld(unsigned* p)              { return __hip_atomic_load(p, __ATOMIC_RELAXED, __HIP_MEMORY_SCOPE_AGENT); }
__device__ __forceinline__ unsigned xb_add(unsigned* p, unsigned v) { return __hip_atomic_fetch_add(p, v, __ATOMIC_RELAXED, __HIP_MEMORY_SCOPE_AGENT); }
__device__ __forceinline__ unsigned xb_xcc_id() { return (unsigned)__builtin_amdgcn_s_getreg((3 << 11) | 20) & 0xFu; }
#define XB_SPIN(cond, bar) do { unsigned _sp = 0; while (cond) { __builtin_amdgcn_s_sleep(1); \
    if ((++_sp & 255u) == 0u) { if (xb_ld(&(bar)[XB_TMO])) break; if (_sp > XB_SPIN_CAP) { atomicAdd(&(bar)[XB_TMO], 1u); break; } } } } while (0)
struct XcdBarrier { unsigned* bar; unsigned x; volatile LAS unsigned* st; };
__device__ __forceinline__ XcdBarrier xcd_barrier_post(unsigned* bar, volatile LAS unsigned* st) {
    XcdBarrier b; b.bar = bar; b.x = xb_xcc_id(); b.st = st;
    if (threadIdx.x == 0) (void)xb_add(&bar[XB_XCNT(b.x)], 1u);
    return b;
}
__device__ __forceinline__ void xcd_barrier_complete(unsigned* bar, unsigned x, unsigned& nloc, unsigned& nx) {
    const unsigned G = gridDim.x * gridDim.y * gridDim.z;
    unsigned sum, cnt, mine, sp = 0u;
    for (;;) {
        sum = 0u; cnt = 0u; mine = 0u;
#pragma unroll
        for (unsigned j = 0; j < 16; ++j) { const unsigned c = xb_ld(&bar[XB_XCNT(j)]); sum += c; cnt += (c > 0u) ? 1u : 0u; mine = (j == x) ? c : mine; }
        if (sum == G) break;
        __builtin_amdgcn_s_sleep(1);
        if ((++sp & 255u) == 0u) { if (xb_ld(&bar[XB_TMO])) break; if (sp > XB_SPIN_CAP) { atomicAdd(&bar[XB_TMO], 1u); break; } }
    }
    nloc = mine > 0u ? mine : 1u; nx = cnt > 0u ? cnt : 1u;
}
__device__ __forceinline__ void xcd_barrier(const XcdBarrier& b) {
    asm volatile("s_waitcnt vmcnt(0)" ::: "memory");
    __syncthreads();
    if (threadIdx.x == 0) {
        unsigned* bar = b.bar;
        __builtin_amdgcn_s_waitcnt(0);
        unsigned nloc = b.st[0], nx = b.st[1];
        if (nloc == 0u) { xcd_barrier_complete(bar, b.x, nloc, nx); b.st[0] = nloc; b.st[1] = nx; }
        const unsigned old = xb_add(&bar[XB_XSUB(b.x)], 1u);
        const unsigned gen = old / nloc;
        if (old + 1u == (gen + 1u) * nloc) {
            __builtin_amdgcn_fence(__ATOMIC_RELEASE, "agent");
            asm volatile("s_waitcnt vmcnt(0)" ::: "memory");
            const unsigned og = xb_add(&bar[XB_TOP], 1u);
            const unsigned tg = og / nx;
            if (og + 1u == (tg + 1u) * nx) xb_add(&bar[XB_TOPGEN], 1u);
            else XB_SPIN(xb_ld(&bar[XB_TOPGEN]) == tg, bar);
            __builtin_amdgcn_fence(__ATOMIC_ACQUIRE, "agent");
            xb_add(&bar[XB_XGEN(b.x)], 1u);
            asm volatile("s_waitcnt vmcnt(0)" ::: "memory");
        } else {
            XB_SPIN(xb_ld(&bar[XB_XGEN(b.x)]) == gen, bar);
            __builtin_amdgcn_fence(__ATOMIC_ACQUIRE, "agent");
            asm volatile("s_waitcnt vmcnt(0)" ::: "memory");
        }
    }
    __syncthreads();
}

#define XB_LOC(j) (3456 + 64 * (j))
__device__ __forceinline__ void xcd_local_barrier(unsigned* bar, unsigned x, unsigned nloc, unsigned epoch) {
    asm volatile("s_waitcnt vmcnt(0)" ::: "memory");
    __syncthreads();
    if (threadIdx.x == 0) {
        __builtin_amdgcn_s_waitcnt(0);
        (void)xb_add(&bar[XB_LOC(x)], 1u);
        const unsigned target = epoch * nloc;
        XB_SPIN(xb_ld(&bar[XB_LOC(x)]) < target, bar);
        __builtin_amdgcn_fence(__ATOMIC_ACQUIRE, "agent");
        asm volatile("s_waitcnt vmcnt(0)" ::: "memory");
    }
    __syncthreads();
}

struct Args {
    const float* x; const float* a_w_in; const float* a_sink; const float* a_w_out; const float* b_w_in; const float* b_w_out;
    const float* norm_mix; const float* norm_ffn; const float* w_gate; const float* w_up; const float* w_down; const float* final_norm;
    float* out; unsigned char* ws; int ph_lo, ph_hi;
};
constexpr int N_PHASES = 13;

__global__ void __launch_bounds__(NTHREADS, 2) mega_fwd(Args a) {
    extern __shared__ __attribute__((aligned(16))) unsigned char lds_raw[];
    LAS unsigned char* lds = (LAS unsigned char*)lds_raw;
    const int tid = threadIdx.x, lane = tid & 63, wave = __builtin_amdgcn_readfirstlane(tid >> 6);
    const int G = gridDim.x, bid = blockIdx.x;
    unsigned char* ws = a.ws;
    bf16* Win0 = (bf16*)(ws + WS_WIN0); bf16* Wout0 = (bf16*)(ws + WS_WOUT0); bf16* Win1 = (bf16*)(ws + WS_WIN1); bf16* Wout1 = (bf16*)(ws + WS_WOUT1);
    bf16* Wgu0 = (bf16*)(ws + WS_WGU0); bf16* Wgu1 = (bf16*)(ws + WS_WGU1); bf16* Wd0 = (bf16*)(ws + WS_WD0); bf16* Wd1 = (bf16*)(ws + WS_WD1);
    float* cosT = (float*)(ws + WS_COS); float* sinT = (float*)(ws + WS_SIN); float* rotT = (float*)(ws + WS_ROT); unsigned* ssq = (unsigned*)(ws + WS_SSQ); float* lse = (float*)(ws + WS_LSE);
    bf16* XB = (bf16*)(ws + WS_XB); bf16* OB = (bf16*)(ws + WS_O); bf16* BIG = (bf16*)(ws + WS_BIG);
    float* X = a.out;
    const int lo = a.ph_lo, hi_ph = a.ph_hi;
    unsigned* ctl = (unsigned*)(ws + WS_CTL);
    LAS unsigned* ldsctl = (LAS unsigned*)(lds + 133120);
    if (tid < 8) ldsctl[tid] = 0u;
    __syncthreads();
    XcdBarrier xbar; xbar.bar = ctl; xbar.x = 0; xbar.st = nullptr;
    if (MK_N_LAUNCHES == 1) { xbar.bar = ctl; xbar.x = xb_xcc_id(); xbar.st = (volatile LAS unsigned*)(ldsctl + 2);
        if (tid == 0) ldsctl[4] = xb_add(&ctl[XB_XCNT(xbar.x)], 1u); }
    int vid = bid, bidA = bid; bool local_mode = false; unsigned lepoch = 0u;
    if (a.ph_lo < 0) cg::this_grid().sync();
#define IN(k) (lo <= (k) && (k) < hi_ph)
#define GSYNC() do { asm volatile("s_waitcnt vmcnt(0) lgkmcnt(0)" ::: "memory"); cg::this_grid().sync(); } while (0)
#define SEAM(k) do { if (IN(k) && IN((k) + 1)) { if (local_mode) { ++lepoch; xcd_local_barrier(ctl, xbar.x, (unsigned)(G / 8), lepoch); } else { xcd_barrier(xbar); } } } while (0)
#define STAGGER() do { if (STAGGER_US > 0) { const unsigned long long t0_ = __builtin_amdgcn_s_memrealtime(); const unsigned long long d_ = (unsigned long long)((bid >> 3) & 7) * (unsigned long long)(STAGGER_US * 100 / 8); \
        while (__builtin_amdgcn_s_memrealtime() - t0_ < d_) __builtin_amdgcn_s_sleep(8); } } while (0)

    if (IN(0)) {
        LAS float* scr = (LAS float*)(lds + wave * 16384);
        const int gw = bid * NWAVES + wave, NGW = G * NWAVES;
        constexpr int I_IN0 = 16 * 48, I_OUT = 16 * 32, I_IN1 = 16 * 144, I_GU = 16 * 176, I_D = 44 * 32;
        constexpr int NITEMS = I_IN0 + 2 * I_OUT + I_IN1 + 2 * I_GU + 2 * I_D;
        for (int it = gw; it < NITEMS; it += NGW) {
            int r = it;
            if (r < I_IN0) { transpose_item(a.a_w_in, nullptr, 1, a.norm_mix, 1024, 1536, Win0, 48, scr, r, lane); continue; } r -= I_IN0;
            if (r < I_OUT) { transpose_item(a.a_w_out, nullptr, 0, nullptr, 1024, 1024, Wout0, 32, scr, r, lane); continue; } r -= I_OUT;
            if (r < I_IN1) { transpose_item(a.b_w_in, nullptr, 1, a.norm_mix + 1024, 1024, 4608, Win1, 144, scr, r, lane); continue; } r -= I_IN1;
            if (r < I_OUT) { transpose_item(a.b_w_out, nullptr, 0, nullptr, 1024, 1024, Wout1, 32, scr, r, lane); continue; } r -= I_OUT;
            if (r < I_GU) { transpose_item(a.w_gate, a.w_up, 2, a.norm_ffn, 1024, 2816, Wgu0, 176, scr, r, lane); continue; } r -= I_GU;
            if (r < I_GU) { transpose_item(a.w_gate + (size_t)1024 * 2816, a.w_up + (size_t)1024 * 2816, 2, a.norm_ffn + 1024, 1024, 2816, Wgu1, 176, scr, r, lane); continue; } r -= I_GU;
            if (r < I_D) { transpose_item(a.w_down, nullptr, 0, nullptr, 2816, 1024, Wd0, 32, scr, r, lane); continue; } r -= I_D;
            transpose_item(a.w_down + (size_t)2816 * 1024, nullptr, 0, nullptr, 2816, 1024, Wd1, 32, scr, r, lane);
        }
        const int gt = bid * NTHREADS + tid, NGT = G * NTHREADS;
        for (int i = gt; i < 2048 * 32; i += NGT) {
            const int t = i >> 5, f = i & 31; double inv = 1.0; for (int k = 0; k < f; ++k) inv *= 0.74989420933245583;
            double rev = (double)t * inv * 0.15915494309189535; rev = rev - __builtin_floor(rev); const float fr = (float)rev;
            cosT[i] = __builtin_amdgcn_cosf(fr); sinT[i] = __builtin_amdgcn_sinf(fr);
        }
        if (gt < 32) { double inv = 1.0; for (int k = 0; k < gt; ++k) inv *= 0.74989420933245583;
            double r16 = 16.0 * inv * 0.15915494309189535; r16 -= __builtin_floor(r16); double r128 = 128.0 * inv * 0.15915494309189535; r128 -= __builtin_floor(r128);
            rotT[gt] = __builtin_amdgcn_cosf((float)r16); rotT[32 + gt] = __builtin_amdgcn_sinf((float)r16); rotT[64 + gt] = __builtin_amdgcn_cosf((float)r128); rotT[96 + gt] = __builtin_amdgcn_sinf((float)r128); }
        for (int i = gt; i < 4 * T; i += NGT) ssq[T + i] = 0u;
        for (int row = gw; row < T; row += 4 * NGW) {
            f32x4 v[4][4];
#pragma unroll
            for (int q = 0; q < 4; ++q) { const int rq = min(row + q * NGW, T - 1); const f32x4* xr = (const f32x4*)(a.x + (size_t)rq * DM) + lane;
#pragma unroll
                for (int j = 0; j < 4; ++j) v[q][j] = xr[64 * j]; }
#pragma unroll
            for (int q = 0; q < 4; ++q) { const int rq = row + q * NGW; if (rq < T) { float s = 0.f;
#pragma unroll
                for (int j = 0; j < 4; ++j) s += (v[q][j].x * v[q][j].x + v[q][j].y * v[q][j].y) + (v[q][j].z * v[q][j].z + v[q][j].w * v[q][j].w);
                s = wave_sum(s); if (lane == 0) ssq[rq] = (unsigned)(s * pg8::SSQ_SCALE + 0.5f);
                unsigned long long* o8 = (unsigned long long*)(XB + (size_t)rq * DM) + lane;
#pragma unroll
                for (int j = 0; j < 4; ++j) o8[64 * j] = (unsigned long long)pk2(v[q][j].x, v[q][j].y) | ((unsigned long long)pk2(v[q][j].z, v[q][j].w) << 32); } }
        }
        __syncthreads();
    }
    SEAM(0);
    if (MK_N_LAUNCHES == 1 && XCD_LOCAL && IN(0) && IN(1)) {
        bool okc = (G % 8) == 0 && (G / 8) == 32;
        for (int j = 0; j < 16; ++j) { const unsigned c = xb_ld(&ctl[XB_XCNT(j)]); okc = okc && (j < 8 ? c == (unsigned)(G / 8) : c == 0u); }
        okc = okc && xbar.x < 8u;
        if (okc) { const int xl = (int)ldsctl[4]; local_mode = true; vid = xl * 8 + (int)xbar.x; bidA = (int)xbar.x * 32 + xl; }
    }
    const size_t SLICE = (size_t)8192 * 4608;
    const size_t xsel = local_mode ? (size_t)xbar.x : 0;
    bf16* BIGQ = BIG + xsel * (SLICE - (size_t)8192 * QKVW);
    bf16* BIGH = BIG + xsel * (SLICE - (size_t)8192 * DFF);
    bf16* BIGP = BIG;
    if (IN(1)) _Pragma("unroll") for (int rep = 0; rep < (PROBE_DUP == 1 ? 2 : 1); ++rep) {
        if (rep) GSYNC();
        pg8::Gemm g{XB, Win0, T, QKVW, DM}; pg8::StaticOrder S; S.init(T, QKVW, G, vid);
        pg8::EpiQKV E{BIGQ, QKVW, ssq, cosT, sinT, rotT};
        STAGGER();
        pg8::gemm_phase<pg8::EpiQKV, pg8::StaticOrder, true, true>(lds, g, S, E);
    }
    SEAM(1);
    if (IN(2)) _Pragma("unroll") for (int rep = 0; rep < (PROBE_DUP == 2 ? 2 : 1); ++rep) {
        if (rep) GSYNC();
        constexpr int NU = BATCH * 4 * 32; const int per = (NU + G - 1) / G;
        const bf16* BIGc = BIGQ; bf16* OBc = OB; const float* sinkp = a.a_sink;
        auto dec = [=](int u) { const int qb = u & 31, kvh = (u >> 5) & 3, b = u >> 7; const bf16* base = BIGc + (size_t)b * SEQ * QKVW;
            return att::AU{base + kvh * 256, base + 1024 + kvh * 64, base + 1280 + kvh * 64, OBc + (size_t)b * SEQ * DM + kvh * 256, (size_t)QKVW, (size_t)DM, SEQ, qb * 64, sinkp + kvh * 4, nullptr, 0}; };
        att::phase<128, true, false>(lds, min(NU, bidA * per), min(NU, (bidA + 1) * per), dec);
    }
    SEAM(2);
    if (IN(3)) {
        pg8::Gemm g{OB, Wout0, T, DM, DM}; pg8::StaticOrder S; S.init(T, DM, G, vid);
        pg8::EpiRes E{XB, ssq + T};
        STAGGER();
        pg8::gemm_phase<pg8::EpiRes, pg8::StaticOrder, true, true>(lds, g, S, E);
    }
    SEAM(3);
    if (IN(4)) _Pragma("unroll") for (int rep = 0; rep < (PROBE_DUP == 4 ? 2 : 1); ++rep) {
        if (rep) GSYNC();
        pg8::Gemm g{XB, Wgu0, T, 2 * DFF, DM}; pg8::StaticOrder S; S.init(T, 2 * DFF, G, vid);
        pg8::EpiSwiGLU E{BIGH, DFF, ssq + T};
        STAGGER();
        pg8::gemm_phase<pg8::EpiSwiGLU, pg8::StaticOrder, true, true>(lds, g, S, E);
    }
    SEAM(4);
    if (IN(5)) {
        pg8::Gemm g{BIGH, Wd0, T, DM, DFF}; pg8::StaticOrder S; S.init(T, DM, G, vid);
        pg8::EpiRes E{XB, ssq + 2 * T};
        STAGGER();
        pg8::gemm_phase<pg8::EpiRes, pg8::StaticOrder, true, true>(lds, g, S, E);
    }
    SEAM(5);
    if (IN(6)) _Pragma("unroll") for (int rep = 0; rep < (PROBE_DUP == 6 ? 2 : 1); ++rep) {
        if (rep) GSYNC();
        pg8::Gemm g{XB, Win1, T, 3 * QKVW, DM}; pg8::StaticOrder S; S.init(T, 3 * QKVW, G, vid);
        pg8::EpiQKV E{BIGP, 3 * QKVW, ssq + 2 * T, cosT, sinT, rotT};
        STAGGER();
        pg8::gemm_phase<pg8::EpiQKV, pg8::StaticOrder, true, true>(lds, g, S, E);
    }
    SEAM(6);
    if (IN(7)) {
        constexpr int NU = 3 * BATCH * 4 * 32; const int per = (NU + G - 1) / G;
        bf16* BIGc = BIGP; float* lsep = lse;
        auto dec = [=](int u) { const int xblk = u / 1536, rem = u % 1536, gidx = rem >> 9, v = rem & 511, b = 4 * xblk + (v >> 7), kvh = (v >> 5) & 3, qa = v & 31;
            const int dsh = 2 * gidx, dil = 1 << dsh, nbk = 32 >> dsh, r = qa / nbk, qb = qa % nbk;
            bf16* base = BIGc + ((size_t)b * SEQ + r) * (3 * QKVW) + gidx * QKVW;
            return att::AU{base + kvh * 256, base + 1024 + kvh * 64, base + 1280 + kvh * 64, base + kvh * 256, (size_t)dil * 3 * QKVW, (size_t)dil * 3 * QKVW, SEQ >> dsh, qb * 64, nullptr,
                           lsep + ((size_t)gidx * T + (size_t)b * SEQ + r) * NH + kvh * 4, (size_t)dil * NH}; };
        att::phase<64, false, true>(lds, min(NU, bidA * per), min(NU, (bidA + 1) * per), dec);
    }
    SEAM(7);
    if (IN(8)) {
        const int gt = bid * NTHREADS + tid, NGT = G * NTHREADS;
        const int tpw = T / G;
#pragma unroll 4
        for (int il = tid; il < tpw * 128; il += NTHREADS) {
            const int i = bidA * tpw * 128 + il;
            const int tok = i >> 7, ch = i & 127, head = ch >> 3;
            const float l0 = lse[(size_t)tok * NH + head], l1 = lse[((size_t)T + tok) * NH + head], l2 = lse[((size_t)2 * T + tok) * NH + head];
            const float mx = fmaxf(l0, fmaxf(l1, l2)); float w0 = __builtin_amdgcn_exp2f(l0 - mx), w1 = __builtin_amdgcn_exp2f(l1 - mx), w2 = __builtin_amdgcn_exp2f(l2 - mx);
            const float inv = 1.0f / (w0 + w1 + w2); w0 *= inv; w1 *= inv; w2 *= inv;
            const bf16* src = BIGP + (size_t)tok * (3 * QKVW) + ch * 8;
            const v4u a0 = *(const v4u*)src, a1 = *(const v4u*)(src + QKVW), a2 = *(const v4u*)(src + 2 * QKVW);
            v4u o;
#pragma unroll
            for (int e = 0; e < 4; ++e) {
                const float x0 = __uint_as_float(a0[e] << 16), y0 = __uint_as_float(a0[e] & 0xffff0000u);
                const float x1 = __uint_as_float(a1[e] << 16), y1 = __uint_as_float(a1[e] & 0xffff0000u);
                const float x2 = __uint_as_float(a2[e] << 16), y2 = __uint_as_float(a2[e] & 0xffff0000u);
                o[e] = pk2(w0 * x0 + w1 * x1 + w2 * x2, w0 * y0 + w1 * y1 + w2 * y2);
            }
            *(v4u*)(OB + (size_t)tok * DM + ch * 8) = o;
        }
    }
    SEAM(8);
    if (IN(9)) {
        pg8::Gemm g{OB, Wout1, T, DM, DM}; pg8::StaticOrder S; S.init(T, DM, G, vid);
        pg8::EpiRes E{XB, ssq + 3 * T};
        STAGGER();
        pg8::gemm_phase<pg8::EpiRes, pg8::StaticOrder, true, true>(lds, g, S, E);
    }
    SEAM(9);
    if (IN(10)) _Pragma("unroll") for (int rep = 0; rep < (PROBE_DUP == 10 ? 2 : 1); ++rep) {
        if (rep) GSYNC();
        pg8::Gemm g{XB, Wgu1, T, 2 * DFF, DM}; pg8::StaticOrder S; S.init(T, 2 * DFF, G, vid);
        pg8::EpiSwiGLU E{BIGH, DFF, ssq + 3 * T};
        STAGGER();
        pg8::gemm_phase<pg8::EpiSwiGLU, pg8::StaticOrder, true, true>(lds, g, S, E);
    }
    SEAM(10);
    if (IN(11)) {
        pg8::Gemm g{BIGH, Wd1, T, DM, DFF}; pg8::StaticOrder S; S.init(T, DM, G, vid);
        pg8::EpiRes E{XB, ssq + 4 * T};
        STAGGER();
        pg8::gemm_phase<pg8::EpiRes, pg8::StaticOrder, true, true>(lds, g, S, E);
    }
    SEAM(11);
    if (IN(12)) {
        const int gt = bid * NTHREADS + tid, NGT = G * NTHREADS;
        const int tpw = T / G;
#pragma unroll 4
        for (int il = tid; il < tpw * 128; il += NTHREADS) {
            const int i = bidA * tpw * 128 + il;
            const int row = i >> 7, ch = i & 127;
            const float rstd = __builtin_amdgcn_rsqf((float)ssq[4 * T + row] * pg8::SSQ_INV + pg8::RMS_EPS);
            const v4u v = *(const v4u*)(XB + (size_t)row * DM + ch * 8);
            const f32x4 g0 = *(const f32x4*)(a.final_norm + ch * 8), g1 = *(const f32x4*)(a.final_norm + ch * 8 + 4);
            const f32x4 o0 = (f32x4){__uint_as_float(v.x << 16), __uint_as_float(v.x & 0xffff0000u), __uint_as_float(v.y << 16), __uint_as_float(v.y & 0xffff0000u)};
            const f32x4 o1 = (f32x4){__uint_as_float(v.z << 16), __uint_as_float(v.z & 0xffff0000u), __uint_as_float(v.w << 16), __uint_as_float(v.w & 0xffff0000u)};
            float* orow = X + (size_t)row * DM + ch * 8;
            *(f32x4*)orow = o0 * rstd * g0; *(f32x4*)(orow + 4) = o1 * rstd * g1;
        }
    }
#undef IN
#undef SEAM
}

extern "C" void kernel_launch(void* const* d_in, const int* in_sizes, int n_in, void* d_out, int out_size, void* d_ws, size_t ws_size, hipStream_t stream) {
    static int grid = 0;
    if (grid == 0) {
        if (n_in != 12 || in_sizes[0] != T * DM || out_size != T * DM || ws_size < WS_END) {
            fprintf(stderr, "kernel_launch: unexpected shapes (n_in %d, in0 %d, out %d, ws %zu, need %zu)\n", n_in, n_in > 0 ? in_sizes[0] : -1, out_size, ws_size, (size_t)WS_END); grid = -1; return; }
        int dev = 0, cus = 0, per_cu = 0;
        hipGetDevice(&dev); hipDeviceGetAttribute(&cus, hipDeviceAttributeMultiprocessorCount, dev);
        if (hipFuncSetAttribute((const void*)mega_fwd, hipFuncAttributeMaxDynamicSharedMemorySize, LDS_BYTES) != hipSuccess) { fprintf(stderr, "kernel_launch: hipFuncSetAttribute failed\n"); grid = -1; return; }
        if (hipOccupancyMaxActiveBlocksPerMultiprocessor(&per_cu, (const void*)mega_fwd, NTHREADS, LDS_BYTES) != hipSuccess || per_cu < 1) { fprintf(stderr, "kernel_launch: occupancy query gave %d\n", per_cu); per_cu = 1; }
        (void)hipGetLastError();
        grid = cus * per_cu;
        if (T % grid != 0) { fprintf(stderr, "kernel_launch: grid %d does not divide the %d tokens\n", grid, T); grid = -1; return; }
    }
    if (grid < 0) return;
    Args a{};
    a.x = (const float*)d_in[0]; a.a_w_in = (const float*)d_in[1]; a.a_sink = (const float*)d_in[2]; a.a_w_out = (const float*)d_in[3];
    a.b_w_in = (const float*)d_in[4]; a.b_w_out = (const float*)d_in[5]; a.norm_mix = (const float*)d_in[6]; a.norm_ffn = (const float*)d_in[7];
    a.w_gate = (const float*)d_in[8]; a.w_up = (const float*)d_in[9]; a.w_down = (const float*)d_in[10]; a.final_norm = (const float*)d_in[11];
    a.out = (float*)d_out; a.ws = (unsigned char*)d_ws;
#if MK_N_LAUNCHES == 1
    (void)hipMemsetAsync((char*)d_ws + WS_CTL, 0, 16384, stream);
    a.ph_lo = 0; a.ph_hi = N_PHASES;
    void* args[] = {&a};
    hipError_t e = hipLaunchCooperativeKernel((const void*)mega_fwd, dim3(grid), dim3(NTHREADS), args, LDS_BYTES, stream);
    if (e != hipSuccess) fprintf(stderr, "cooperative launch failed: %s (grid %d)\n", hipGetErrorString(e), grid);
#else
    for (int p = 0; p < N_PHASES; ++p) { a.ph_lo = p; a.ph_hi = p + 1; hipLaunchKernelGGL(mega_fwd, dim3(grid), dim3(NTHREADS), LDS_BYTES, stream, a); }
#endif
}
```

```cpp
#include <hip/hip_runtime.h>
#include <hip/hip_cooperative_groups.h>
#include <cstdio>
#include <cstdint>
namespace cg = cooperative_groups;

#ifndef PROBE_DUP
#define PROBE_DUP -1
#endif
#ifndef STAGGER_US
#define STAGGER_US 0
#endif
#ifndef XCD_LOCAL
#define XCD_LOCAL 1
#endif
#ifndef MK_N_LAUNCHES
#define MK_N_LAUNCHES 1
#endif

namespace pg8 {
#define PG8_LAS __attribute__((address_space(3)))
typedef unsigned short bf16_t;
typedef short bf16x8 __attribute__((ext_vector_type(8)));
typedef float f32x4 __attribute__((ext_vector_type(4)));
typedef unsigned u32x4 __attribute__((ext_vector_type(4)));
typedef unsigned u32x2 __attribute__((ext_vector_type(2)));
constexpr int BM = 256, BK = 64, HALF = 128, HTB = HALF * BK * 2, STAGE_BYTES = 8 * HTB, NXCD = 8, WGM = 8;

__host__ __device__ __forceinline__ int lds_byte(int r, int c) { const int st = (r >> 4) * 2 + (c >> 5), rr = r & 15, cc = c & 31, ob = rr * 64 + cc * 2; return st * 1024 + (ob ^ (((ob >> 9) & 1) << 5)); }
__host__ __device__ __forceinline__ void stage_rc(int b, int& R, int& C) { const int st = b / 1024, sb = b % 1024, swz = sb ^ (((sb >> 9) & 1) << 5); R = (st >> 1) * 16 + swz / 64; C = (st & 1) * 32 + (swz % 64) / 2; }
__host__ __device__ __forceinline__ int perm32(int rho) { const int n = rho >> 4, i = rho & 15; return 8 * (i >> 2) + 4 * n + (i & 3); }

struct Unit { int pm, pn; };
struct Gemm { const bf16_t* A; const bf16_t* Bt; int M, N, K; };

struct StaticOrder {
    int nM, nN, nwg, G, c;
    __host__ __device__ void init(int M, int N, int G_, int c_) { nM = M / BM; nN = N / BM; nwg = nM * nN; G = G_; c = c_; }
    __host__ __device__ bool next(int i, Unit& u) const {
        const long L = (long)i * G + c; if (L >= nwg) return false;
        int wgid = (int)L; { const int q = nwg / NXCD, r = nwg % NXCD, xcd = wgid % NXCD, off = wgid / NXCD; wgid = (xcd < r ? xcd * (q + 1) : r * (q + 1) + (xcd - r) * q) + off; }
        const int nig = WGM * nN, gid = wgid / nig, fm = gid * WGM, gsz = (nM - fm) < WGM ? (nM - fm) : WGM;
        u.pm = fm + ((wgid % nig) % gsz); u.pn = (wgid % nig) / gsz; return true;
    }
    __device__ __forceinline__ void a_ready(const Unit&) const {}
    __device__ __forceinline__ void done(const Unit&) const {}
};

__device__ __forceinline__ unsigned cvt_pk_bf16(float lo, float hi) { unsigned r; asm volatile("v_cvt_pk_bf16_f32 %0, %1, %2" : "=v"(r) : "v"(lo), "v"(hi)); return r; }

constexpr float RMS_EPS = 1e-6f;
constexpr float SSQ_SCALE = 2048.0f, SSQ_INV = 1.0f / (2048.0f * 1024.0f);
constexpr float QSCALE = 0.125f * 1.4426950408889634f;


struct EpiQKV {
    static constexpr bool PERM = true, AFTER_DRAIN = false;
    bf16_t* O; int ldc; const unsigned* ssq; const float* cosT; const float* sinT; const float* rot;
    __device__ __forceinline__ void operator()(const f32x4 (&acc)[2][2][4][2], const Unit& u, int wr, int wc, int fr, int fq) const {
        const int row0 = u.pm * BM + wr * 64 + fr; const int t6 = u.pn % 6;
        const int col0 = u.pn * BM + wc * 32 + 8 * fq; const int fi = 16 * (wc & 1) + 4 * fq;
        const float qs = t6 < 4 ? QSCALE : 1.0f; const bool rope = t6 < 5;
        unsigned sq[8];
#pragma unroll
        for (int i = 0; i < 8; ++i) { const int row = row0 + (i >> 2) * HALF + (i & 3) * 16; sq[i] = ssq[row]; }
        f32x4 c0 = (f32x4){1.f, 1.f, 1.f, 1.f}, s0 = (f32x4){0.f, 0.f, 0.f, 0.f}, c16 = c0, s16 = s0, c128 = c0, s128 = s0;
        if (rope) { const int t0 = row0 & 2047;
            c0 = *(const f32x4*)(cosT + t0 * 32 + fi); s0 = *(const f32x4*)(sinT + t0 * 32 + fi);
            c16 = *(const f32x4*)(rot + fi); s16 = *(const f32x4*)(rot + 32 + fi); c128 = *(const f32x4*)(rot + 64 + fi); s128 = *(const f32x4*)(rot + 96 + fi); }
        asm volatile("" ::: "memory");
#pragma unroll
        for (int ai = 0; ai < 2; ++ai) {
            f32x4 c = c0, sn = s0;
            if (ai == 1) { c = c0 * c128 - s0 * s128; sn = s0 * c128 + c0 * s128; }
#pragma unroll
            for (int m = 0; m < 4; ++m) {
                const int row = row0 + ai * HALF + m * 16;
                const float s1 = __builtin_amdgcn_rsqf((float)sq[ai * 4 + m] * SSQ_INV + RMS_EPS) * qs; const f32x4 c1 = c * s1, n1 = sn * s1;
                bf16_t* rowp = O + (size_t)row * ldc + col0;
#pragma unroll
                for (int bj = 0; bj < 2; ++bj) {
                    const f32x4 v0 = acc[ai][bj][m][0], v1 = acc[ai][bj][m][1];
                    const f32x4 o0 = v0 * c1 - v1 * n1, o1 = v1 * c1 + v0 * n1;
                    u32x4 w; w.x = cvt_pk_bf16(o0[0], o0[1]); w.y = cvt_pk_bf16(o0[2], o0[3]); w.z = cvt_pk_bf16(o1[0], o1[1]); w.w = cvt_pk_bf16(o1[2], o1[3]);
                    *(u32x4*)(rowp + bj * HALF) = w; }
                if (m < 3) { const f32x4 cn = c * c16 - sn * s16; sn = sn * c16 + c * s16; c = cn; }
            }
        }
    }
};

struct EpiSwiGLU {
    static constexpr bool PERM = true, AFTER_DRAIN = false;
    bf16_t* O; int ldc; const unsigned* ssq;
    __device__ __forceinline__ void operator()(const f32x4 (&acc)[2][2][4][2], const Unit& u, int wr, int wc, int fr, int fq) const {
        const int row0 = u.pm * BM + wr * 64 + fr; const int col0 = u.pn * HALF + wc * 32 + 8 * fq;
        unsigned sq[8];
#pragma unroll
        for (int i = 0; i < 8; ++i) sq[i] = ssq[row0 + (i >> 2) * HALF + (i & 3) * 16];
        asm volatile("" ::: "memory");
#pragma unroll
        for (int i = 0; i < 8; ++i) {
            const int ai = i >> 2, m = i & 3; const int row = row0 + ai * HALF + m * 16;
            const float rstd = __builtin_amdgcn_rsqf((float)sq[i] * SSQ_INV + RMS_EPS), nr = -1.4426950408889634f * rstd, r2 = rstd * rstd;
            float h[8];
            typedef float f32x2 __attribute__((ext_vector_type(2)));
#pragma unroll
            for (int n = 0; n < 2; ++n)
#pragma unroll
                for (int e = 0; e < 4; e += 2) { const f32x2 ag = {acc[ai][0][m][n][e], acc[ai][0][m][n][e + 1]}, au = {acc[ai][1][m][n][e], acc[ai][1][m][n][e + 1]};
                    const f32x2 t = ag * nr; f32x2 ex; ex.x = __builtin_amdgcn_exp2f(t.x); ex.y = __builtin_amdgcn_exp2f(t.y);
                    const f32x2 d = ex + 1.0f; f32x2 rc; rc.x = __builtin_amdgcn_rcpf(d.x); rc.y = __builtin_amdgcn_rcpf(d.y);
                    const f32x2 hv = (ag * au) * (rc * r2); h[n * 4 + e] = hv.x; h[n * 4 + e + 1] = hv.y; }
            u32x4 w; w.x = cvt_pk_bf16(h[0], h[1]); w.y = cvt_pk_bf16(h[2], h[3]); w.z = cvt_pk_bf16(h[4], h[5]); w.w = cvt_pk_bf16(h[6], h[7]);
            *(u32x4*)(O + (size_t)row * ldc + col0) = w;
        }
    }
};

struct EpiRes {
    static constexpr bool PERM = true, AFTER_DRAIN = false;
    bf16_t* xb; unsigned* ssq;
    __device__ __forceinline__ void operator()(const f32x4 (&acc)[2][2][4][2], const Unit& u, int wr, int wc, int fr, int fq) const {
        const int row0 = u.pm * BM + wr * 64 + fr; const int col0 = u.pn * BM + wc * 32 + 8 * fq;
#pragma unroll
        for (int i = 0; i < 8; ++i) {
            const int ai = i >> 2, m = i & 3; const int row = row0 + ai * HALF + m * 16; bf16_t* rowp = xb + (size_t)row * 1024 + col0; float s = 0.f;
            u32x4 xv[2];
#pragma unroll
            for (int bj = 0; bj < 2; ++bj) xv[bj] = *(const u32x4*)(rowp + bj * HALF);
#pragma unroll
            for (int bj = 0; bj < 2; ++bj) {
                float o[8];
#pragma unroll
                for (int e = 0; e < 4; ++e) { o[2 * e] = __uint_as_float(xv[bj][e] << 16) + acc[ai][bj][m][e >> 1][(2 * e) & 3]; o[2 * e + 1] = __uint_as_float(xv[bj][e] & 0xffff0000u) + acc[ai][bj][m][e >> 1][(2 * e + 1) & 3]; }
#pragma unroll
                for (int e = 0; e < 8; ++e) s += o[e] * o[e];
                u32x4 w; w.x = cvt_pk_bf16(o[0], o[1]); w.y = cvt_pk_bf16(o[2], o[3]); w.z = cvt_pk_bf16(o[4], o[5]); w.w = cvt_pk_bf16(o[6], o[7]);
                *(u32x4*)(rowp + bj * HALF) = w;
            }
            s += __shfl_xor(s, 16); s += __shfl_xor(s, 32);
            if (fq == 0) atomicAdd(ssq + row, (unsigned)(s * SSQ_SCALE + 0.5f));
        }
    }
};

template <class Epi, class Sched, bool ALIGN_EPI = false, bool SP2 = false>
__device__ __forceinline__ void gemm_phase(PG8_LAS unsigned char* lds, const Gemm g, const Sched& S, const Epi& E) {
    const int tid = threadIdx.x, wid = __builtin_amdgcn_readfirstlane(tid >> 6), lane = tid & 63, wr = wid >> 2, wc = wid & 3, fr = lane & 15, fq = lane >> 4;
    const int K = g.K, nt = K / BK;
    unsigned voffA[2], voffB[2];
#pragma unroll
    for (int i = 0; i < 2; ++i) { int R, C; stage_rc(tid * 16 + i * 8192, R, C); const int Rb = Epi::PERM ? ((R & ~31) + perm32(R & 31)) : R;
        voffA[i] = (unsigned)(R * K + C) * 2u; voffB[i] = (unsigned)(Rb * K + C) * 2u; }
    const size_t kstep = (size_t)(BK * 2);
    const size_t hstep = (size_t)HALF * K * 2;
    const size_t tstep = 2 * hstep;
    const unsigned ldsw = (unsigned)wid * 1024u;
    const int aoff = lds_byte(wr * 64 + fr, fq * 8), boff = lds_byte(wc * 32 + fr, fq * 8);
#define PG8_SA(b, h) (((b) * 2 + (h)) * HTB)
#define PG8_SB(b, h) ((4 + (b) * 2 + (h)) * HTB)
#define PG8_STAGE(bufoff, gbase, voff) do { _Pragma("unroll") for (int _i = 0; _i < 2; ++_i) \
        __builtin_amdgcn_global_load_lds((const unsigned*)((const char*)(gbase) + (voff)[_i]), (PG8_LAS unsigned*)(lds + (bufoff) + ldsw + _i * 8192), 16, 0, 0); } while (0)
#define PG8_LDA(dst, b, h) do { _Pragma("unroll") for (int m = 0; m < 4; ++m) _Pragma("unroll") for (int k = 0; k < 2; ++k) dst[m][k] = *(const PG8_LAS bf16x8*)(lds + PG8_SA(b, h) + aoff + m * 2048 + k * 1024); } while (0)
#define PG8_LDB(dst, b, h) do { _Pragma("unroll") for (int n = 0; n < 2; ++n) _Pragma("unroll") for (int k = 0; k < 2; ++k) dst[n][k] = *(const PG8_LAS bf16x8*)(lds + PG8_SB(b, h) + boff + n * 2048 + k * 1024); } while (0)
#define PG8_MMA(ai, bj, At, Bt) do { __builtin_amdgcn_s_setprio(1); _Pragma("unroll") for (int m = 0; m < 4; ++m) _Pragma("unroll") for (int n = 0; n < 2; ++n) _Pragma("unroll") for (int k = 0; k < 2; ++k) \
        acc[ai][bj][m][n] = __builtin_amdgcn_mfma_f32_16x16x32_bf16(Bt[n][k], At[m][k], acc[ai][bj][m][n], 0, 0, 0); __builtin_amdgcn_s_setprio(0); } while (0)
#define PG8_WAIT_V(n) asm volatile("s_waitcnt vmcnt(" #n ")" ::: "memory")
#define PG8_WAIT_L(n) asm volatile("s_waitcnt lgkmcnt(" #n ")" ::: "memory")
#define PG8_BAR __builtin_amdgcn_s_barrier()
#define PG8_SCHED __builtin_amdgcn_sched_barrier(0)
    Unit cur, nxt; int ui = 0;
    if (!S.next(0, cur)) return;
    f32x4 acc[2][2][4][2];
#pragma unroll
    for (int a = 0; a < 2; ++a)
#pragma unroll
        for (int b = 0; b < 2; ++b)
#pragma unroll
            for (int m = 0; m < 4; ++m)
#pragma unroll
                for (int n = 0; n < 2; ++n) acc[a][b][m][n] = (f32x4){0.f, 0.f, 0.f, 0.f};
    bf16x8 At[4][2], B0[2][2], B1[2][2];
    const char* cA = (const char*)g.A + (size_t)cur.pm * tstep; const char* cB = (const char*)g.Bt + (size_t)cur.pn * tstep;
    S.a_ready(cur);
    if constexpr (SP2) {
        PG8_STAGE(PG8_SB(0, 0), cB, voffB); PG8_STAGE(PG8_SB(0, 1), cB + hstep, voffB); PG8_STAGE(PG8_SA(0, 0), cA, voffA); PG8_STAGE(PG8_SA(0, 1), cA + hstep, voffA);
        if (wr == 1) PG8_BAR;
        PG8_WAIT_V(2); PG8_BAR;
        PG8_STAGE(PG8_SB(1, 0), cB + kstep, voffB); PG8_STAGE(PG8_SA(1, 0), cA + kstep, voffA); PG8_STAGE(PG8_SB(1, 1), cB + hstep + kstep, voffB);
        PG8_WAIT_V(6); PG8_BAR;
    } else {
        PG8_STAGE(PG8_SB(0, 0), cB, voffB); PG8_STAGE(PG8_SA(0, 0), cA, voffA); PG8_STAGE(PG8_SB(0, 1), cB + hstep, voffB); PG8_STAGE(PG8_SA(0, 1), cA + hstep, voffA);
        if (wr == 1) PG8_BAR;
        PG8_WAIT_V(4); PG8_BAR;
        PG8_STAGE(PG8_SB(1, 0), cB + kstep, voffB); PG8_STAGE(PG8_SA(1, 0), cA + kstep, voffA); PG8_STAGE(PG8_SB(1, 1), cB + hstep + kstep, voffB);
        PG8_WAIT_V(6); PG8_BAR;
    }
    for (;;) {
        const bool has_next = S.next(ui + 1, nxt);
        const char* nA = has_next ? (const char*)g.A + (size_t)nxt.pm * tstep : cA; const char* nB = has_next ? (const char*)g.Bt + (size_t)nxt.pn * tstep : cB;
        for (int t = 0; t < nt; t += 2) {
            const bool last = (t == nt - 2);
            const char* a1 = cA + (size_t)(t + 1) * kstep;
            const char* a2 = last ? nA : cA + (size_t)(t + 2) * kstep; const char* b2 = last ? nB : cB + (size_t)(t + 2) * kstep;
            const char* a3 = a2 + kstep; const char* b3 = b2 + kstep;
            if (last && has_next) S.a_ready(nxt);
            if constexpr (SP2) {
            PG8_LDB(B0, 0, 0); PG8_LDB(B1, 0, 1); PG8_SCHED; PG8_LDA(At, 0, 0); PG8_STAGE(PG8_SA(1, 1), a1 + hstep, voffA);
            PG8_WAIT_V(8); PG8_WAIT_L(0); PG8_BAR; PG8_MMA(0, 0, At, B0); PG8_MMA(0, 1, At, B1); PG8_BAR; PG8_SCHED;
            PG8_LDA(At, 0, 1); PG8_STAGE(PG8_SB(0, 0), b2, voffB); PG8_STAGE(PG8_SB(0, 1), b2 + hstep, voffB); PG8_STAGE(PG8_SA(0, 0), a2, voffA);
            PG8_WAIT_V(8); PG8_WAIT_L(0); PG8_BAR; PG8_MMA(1, 0, At, B0); PG8_MMA(1, 1, At, B1); PG8_BAR; PG8_SCHED;
            PG8_LDB(B0, 1, 0); PG8_LDB(B1, 1, 1); PG8_SCHED; PG8_LDA(At, 1, 0); PG8_STAGE(PG8_SA(0, 1), a2 + hstep, voffA);
            PG8_WAIT_V(8); PG8_WAIT_L(0); PG8_BAR; PG8_MMA(0, 0, At, B0); PG8_MMA(0, 1, At, B1); PG8_BAR; PG8_SCHED;
            PG8_LDA(At, 1, 1); PG8_STAGE(PG8_SB(1, 0), b3, voffB); PG8_STAGE(PG8_SB(1, 1), b3 + hstep, voffB); PG8_STAGE(PG8_SA(1, 0), a3, voffA);
            PG8_WAIT_V(8); PG8_WAIT_L(0); PG8_BAR; PG8_MMA(1, 0, At, B0); PG8_MMA(1, 1, At, B1); PG8_BAR; PG8_SCHED;
            } else {
            PG8_LDB(B0, 0, 0); PG8_SCHED; PG8_LDA(At, 0, 0); PG8_STAGE(PG8_SA(1, 1), a1 + hstep, voffA);
            PG8_WAIT_L(8); PG8_BAR; PG8_WAIT_L(0); PG8_MMA(0, 0, At, B0); PG8_BAR; PG8_SCHED;
            PG8_LDB(B1, 0, 1); PG8_STAGE(PG8_SB(0, 0), b2, voffB);
            PG8_BAR; PG8_WAIT_L(0); PG8_MMA(0, 1, At, B1); PG8_BAR;
            PG8_LDA(At, 0, 1); PG8_STAGE(PG8_SA(0, 0), a2, voffA);
            PG8_BAR; PG8_WAIT_L(0); PG8_MMA(1, 0, At, B0); PG8_BAR; PG8_SCHED;
            PG8_STAGE(PG8_SB(0, 1), b2 + hstep, voffB);
            PG8_WAIT_V(6); PG8_BAR; PG8_MMA(1, 1, At, B1); PG8_BAR;
            PG8_LDB(B0, 1, 0); PG8_SCHED; PG8_LDA(At, 1, 0); PG8_STAGE(PG8_SA(0, 1), a2 + hstep, voffA);
            PG8_WAIT_L(8); PG8_BAR; PG8_WAIT_L(0); PG8_MMA(0, 0, At, B0); PG8_BAR; PG8_SCHED;
            PG8_LDB(B1, 1, 1); PG8_STAGE(PG8_SB(1, 0), b3, voffB);
            PG8_BAR; PG8_WAIT_L(0); PG8_MMA(0, 1, At, B1); PG8_BAR;
            PG8_LDA(At, 1, 1); PG8_STAGE(PG8_SA(1, 0), a3, voffA);
            PG8_BAR; PG8_WAIT_L(0); PG8_MMA(1, 0, At, B0); PG8_BAR; PG8_SCHED;
            PG8_STAGE(PG8_SB(1, 1), b3 + hstep, voffB);
            PG8_WAIT_V(6); PG8_BAR; PG8_MMA(1, 1, At, B1); PG8_BAR;
            }
        }
        if constexpr (ALIGN_EPI) { if (wr == 0) PG8_BAR; }
        if constexpr (!Epi::AFTER_DRAIN) { E(acc, cur, wr, wc, fr, fq); S.done(cur); }
        if (!has_next) break;
#pragma unroll
        for (int a = 0; a < 2; ++a)
#pragma unroll
            for (int b = 0; b < 2; ++b)
#pragma unroll
                for (int m = 0; m < 4; ++m)
#pragma unroll
                    for (int n = 0; n < 2; ++n) acc[a][b][m][n] = (f32x4){0.f, 0.f, 0.f, 0.f};
        cur = nxt; cA = nA; cB = nB; ++ui;
        if constexpr (ALIGN_EPI) { if (wr == 1) PG8_BAR; }
    }
    PG8_WAIT_V(0);
    if constexpr (!ALIGN_EPI) { if (wr == 0) PG8_BAR; }
    PG8_BAR;
#undef PG8_SA
#undef PG8_SB
#undef PG8_STAGE
#undef PG8_LDA
#undef PG8_LDB
#undef PG8_MMA
#undef PG8_WAIT_V
#undef PG8_WAIT_L
#undef PG8_BAR
#undef PG8_SCHED
}
}

namespace att {
#define ATT_LAS __attribute__((address_space(3)))
typedef unsigned short bf16_t;
typedef short bf16x8 __attribute__((ext_vector_type(8)));
typedef short s16x4 __attribute__((ext_vector_type(4)));
typedef float f32x16 __attribute__((ext_vector_type(16)));
typedef unsigned u32x4 __attribute__((ext_vector_type(4)));
typedef unsigned u32x2 __attribute__((ext_vector_type(2)));
__device__ __forceinline__ int crow(int r, int hi) { return (r & 3) + 8 * (r >> 2) + 4 * hi; }
__device__ __forceinline__ unsigned swz(int row, int ch) { return (unsigned)(row * 128 + ((ch ^ ((((row >> 1) & 1) << 2) | ((row >> 2) & 3))) << 4)); }
__device__ __forceinline__ float swap32f(float v) { auto rr = __builtin_amdgcn_permlane32_swap(__float_as_uint(v), __float_as_uint(v), false, false); return (threadIdx.x & 32) ? __uint_as_float(rr[0]) : __uint_as_float(rr[1]); }
__device__ __forceinline__ unsigned pk(float lo, float hi) { unsigned r; asm volatile("v_cvt_pk_bf16_f32 %0, %1, %2" : "=v"(r) : "v"(lo), "v"(hi)); return r; }

struct AU { const bf16_t* Q; const bf16_t* K; const bf16_t* V; bf16_t* O; size_t rstride, ostride; int L, q0; const float* sink; float* lse; size_t lstride; };

template <int W, bool SINK, bool LSEOUT, class Dec, bool SKIPT = false>
__device__ __forceinline__ void phase(ATT_LAS unsigned char* lds, int ub, int ue, const Dec& dec) {
    constexpr int NK = 64 + 2 * W, NCH = NK * 8, PER = NCH / 512, NT = 2 * W / 32 + 1, VOFF = NK * 128;
    static_assert(NCH % 512 == 0, "staging split");
    if (ub >= ue) return;
    const int tid = threadIdx.x, lane = tid & 63, r32 = lane & 31, hi = lane >> 5, wid = __builtin_amdgcn_readfirstlane(tid >> 6), h = wid & 3, sb = wid >> 2;
    const int qq = (lane & 15) >> 2, p = lane & 3, blk = (lane >> 4) & 1;
    const int fk = (((r32 >> 1) & 1) << 2) | ((r32 >> 2) & 3);
    unsigned kaddr[4];
#pragma unroll
    for (int d0 = 0; d0 < 4; ++d0) kaddr[d0] = (unsigned)(r32 * 128 + (((2 * d0 + hi) ^ fk) << 4));
    unsigned vaddr[2][2];
#pragma unroll
    for (int c = 0; c < 2; ++c)
#pragma unroll
        for (int hf = 0; hf < 2; ++hf) { const int fv = ((qq >> 1) << 2) | ((2 * hf + hi) & 3);
            vaddr[c][hf] = (unsigned)(VOFF + (8 * hf + 4 * hi + qq) * 128 + (((4 * c + 2 * blk + (p >> 1)) ^ fv) << 4) + 8 * (p & 1)); }
    u32x4 kreg[PER], vreg[PER]; unsigned kmask[PER]; bf16x8 qn[4]; float sinkn = 0.f;
#define ATT_LOAD(U) do { \
        _Pragma("unroll") for (int i_ = 0; i_ < PER; ++i_) { const int cid_ = tid + 512 * i_, row_ = cid_ >> 3, ch_ = cid_ & 7, kp_ = (U).q0 - W + row_; \
            const int kc_ = min(max(kp_, 0), (U).L - 1); const unsigned ok_ = (kp_ == kc_) ? 0xffffffffu : 0u;     \
            kreg[i_] = *(const u32x4*)((U).K + (size_t)kc_ * (U).rstride + ch_ * 8); vreg[i_] = *(const u32x4*)((U).V + (size_t)kc_ * (U).rstride + ch_ * 8); kmask[i_] = ok_; } \
        { const bf16_t* qp_ = (U).Q + (size_t)((U).q0 + 32 * sb + r32) * (U).rstride + h * 64 + 8 * hi; \
          if (SINK) sinkn = (U).sink[h]; \
          _Pragma("unroll") for (int d0_ = 0; d0_ < 4; ++d0_) qn[d0_] = *(const bf16x8*)(qp_ + 16 * d0_); } } while (0)
#define ATT_PIN() asm volatile("" : "+v"(qn[3]))
    if (wid >= 4) __builtin_amdgcn_s_setprio(1);
    AU cur = dec(ub);
    ATT_LOAD(cur); ATT_PIN();
    for (int u = ub; u < ue; ++u) {
        const float sink2 = sinkn * 1.4426950408889634f;
#pragma unroll
        for (int i = 0; i < PER; ++i) { const int cid = tid + 512 * i, row = cid >> 3, ch = cid & 7; const unsigned o = swz(row, ch);
            *(ATT_LAS u32x4*)(lds + o) = kreg[i] & kmask[i]; *(ATT_LAS u32x4*)(lds + VOFF + o) = vreg[i] & kmask[i]; }
        bf16x8 qf[4];
#pragma unroll
        for (int d0 = 0; d0 < 4; ++d0) qf[d0] = qn[d0];
        asm volatile("s_waitcnt lgkmcnt(0)" ::: "memory"); __builtin_amdgcn_s_barrier(); asm volatile("" ::: "memory");
        const AU nxt = dec(min(u + 1, ue - 1));
        ATT_LOAD(nxt);
        const int q0 = cur.q0, L = cur.L; const int qrow = q0 + 32 * sb + r32;
        float m = 0.f, l = 0.f; f32x16 o0 = {}, o1 = {}, negm = {};
        const float NEG = -INFINITY;
        const int tb = q0 - W + 32 * sb;
        const int j0 = tb < 0 ? (-tb) >> 5 : 0; const int j1 = SKIPT ? j0 - 1 : min(NT - 1, (L - 32 - tb) >> 5);
        bf16x8 kf[4];
        { const unsigned rb0 = (unsigned)((32 * sb + 32 * j0) * 128);
#pragma unroll
          for (int d0 = 0; d0 < 4; ++d0) kf[d0] = *(const ATT_LAS bf16x8*)(lds + rb0 + kaddr[d0]); }
        for (int j = j0; j <= j1; ++j) {
            const unsigned rb = (unsigned)((32 * sb + 32 * j) * 128);
            f32x16 S = negm;
#pragma unroll
            for (int d0 = 0; d0 < 4; ++d0) S = __builtin_amdgcn_mfma_f32_32x32x16_bf16(kf[d0], qf[d0], S, 0, 0, 0);
            s16x4 vv[2][2][2];
#pragma unroll
            for (int s2 = 0; s2 < 2; ++s2)
#pragma unroll
                for (int c = 0; c < 2; ++c)
#pragma unroll
                    for (int hf = 0; hf < 2; ++hf) vv[s2][c][hf] = __builtin_bit_cast(s16x4, __builtin_amdgcn_ds_read_tr16_b64_v4i16((ATT_LAS s16x4*)(lds + rb + s2 * 2048 + vaddr[c][hf])));
            { const unsigned rbn = j < j1 ? rb + 4096u : rb;
#pragma unroll
              for (int d0 = 0; d0 < 4; ++d0) kf[d0] = *(const ATT_LAS bf16x8*)(lds + rbn + kaddr[d0]); }
            __builtin_amdgcn_sched_barrier(0);
            if (j == 0) {
#pragma unroll
                for (int r = 0; r < 16; ++r) if (crow(r, hi) < r32) S[r] = NEG; }
            if (j == NT - 1) {
#pragma unroll
                for (int r = 0; r < 16; ++r) if (crow(r, hi) > r32) S[r] = NEG; }
            float mx = fmaxf(fmaxf(S[0], S[1]), S[2]);
#pragma unroll
            for (int r = 3; r < 15; r += 2) mx = fmaxf(fmaxf(mx, S[r]), S[r + 1]);
            mx = fmaxf(mx, S[15]);
            { auto rr = __builtin_amdgcn_permlane32_swap(__float_as_uint(mx), __float_as_uint(mx), false, false); mx = fmaxf(__uint_as_float(rr[0]), __uint_as_float(rr[1])); }
            if (j == j0) {
                float mr = mx; if (SINK) mr = fmaxf(mr, sink2);
                m = mr; l = 0.f; if (SINK) l = hi == 0 ? __builtin_amdgcn_exp2f(sink2 - mr) : 0.f;
#pragma unroll
                for (int r = 0; r < 16; ++r) { S[r] -= mr; negm[r] = -mr; }
            } else if (__builtin_amdgcn_ballot_w64(mx > 8.0f) != 0ull) {
                const float d = fmaxf(mx, 0.f), alpha = __builtin_amdgcn_exp2f(-d); m += d; l *= alpha;
#pragma unroll
                for (int r = 0; r < 16; ++r) { S[r] -= d; negm[r] = -m; o0[r] *= alpha; o1[r] *= alpha; }
            }
            float ls0 = 0.f, ls1 = 0.f;
#pragma unroll
            for (int r = 0; r < 16; r += 2) { S[r] = __builtin_amdgcn_exp2f(S[r]); S[r + 1] = __builtin_amdgcn_exp2f(S[r + 1]); ls0 += S[r]; ls1 += S[r + 1]; }
            l += ls0 + ls1;
            u32x4 pw0, pw1;
            pw0.x = pk(S[0], S[1]); pw0.y = pk(S[2], S[3]); pw0.z = pk(S[4], S[5]); pw0.w = pk(S[6], S[7]);
            pw1.x = pk(S[8], S[9]); pw1.y = pk(S[10], S[11]); pw1.z = pk(S[12], S[13]); pw1.w = pk(S[14], S[15]);
            const bf16x8 pa0 = __builtin_bit_cast(bf16x8, pw0), pa1 = __builtin_bit_cast(bf16x8, pw1);
#pragma unroll
            for (int s2 = 0; s2 < 2; ++s2) {
                const bf16x8 pa = s2 ? pa1 : pa0;
#pragma unroll
                for (int c = 0; c < 2; ++c) {
                    const s16x4 v0 = vv[s2][c][0], v1 = vv[s2][c][1];
                    const bf16x8 vf = (bf16x8){v0[0], v0[1], v0[2], v0[3], v1[0], v1[1], v1[2], v1[3]};
                    if (c == 0) o0 = __builtin_amdgcn_mfma_f32_32x32x16_bf16(vf, pa, o0, 0, 0, 0); else o1 = __builtin_amdgcn_mfma_f32_32x32x16_bf16(vf, pa, o1, 0, 0, 0);
                }
            }
        }
        float lt; { auto rr = __builtin_amdgcn_permlane32_swap(__float_as_uint(l), __float_as_uint(l), false, false); lt = __uint_as_float(rr[0]) + __uint_as_float(rr[1]); }
        const float inv = 1.0f / lt;
        unsigned char* rbp = (unsigned char*)(cur.O + (size_t)qrow * cur.ostride + h * 64) + (hi ? 16 : 0);
#pragma unroll
        for (int kp = 0; kp < 4; ++kp) {
            const int c = kp >> 1, g0 = 2 * (kp & 1);
            unsigned ax, ay, bx, by;
            if (c == 0) { ax = pk(o0[4 * g0] * inv, o0[4 * g0 + 1] * inv); ay = pk(o0[4 * g0 + 2] * inv, o0[4 * g0 + 3] * inv); bx = pk(o0[4 * g0 + 4] * inv, o0[4 * g0 + 5] * inv); by = pk(o0[4 * g0 + 6] * inv, o0[4 * g0 + 7] * inv); }
            else        { ax = pk(o1[4 * g0] * inv, o1[4 * g0 + 1] * inv); ay = pk(o1[4 * g0 + 2] * inv, o1[4 * g0 + 3] * inv); bx = pk(o1[4 * g0 + 4] * inv, o1[4 * g0 + 5] * inv); by = pk(o1[4 * g0 + 6] * inv, o1[4 * g0 + 7] * inv); }
            { auto r = __builtin_amdgcn_permlane32_swap(ax, bx, false, false); ax = r[0]; bx = r[1]; }
            { auto r = __builtin_amdgcn_permlane32_swap(ay, by, false, false); ay = r[0]; by = r[1]; }
            *(u32x4*)(rbp + 32 * kp) = (u32x4){ax, ay, bx, by};
        }
        if (LSEOUT) { if (hi == 0) cur.lse[(size_t)qrow * cur.lstride + h] = m + __builtin_amdgcn_logf(lt); }
        asm volatile("s_waitcnt lgkmcnt(0)" ::: "memory"); __builtin_amdgcn_s_barrier(); asm volatile("" ::: "memory");
        ATT_PIN();
        cur = nxt;
    }
    __builtin_amdgcn_s_setprio(0);
#undef ATT_LOAD
#undef ATT_PIN
}
}

#define LAS __attribute__((address_space(3)))
typedef unsigned short bf16;
typedef unsigned v4u __attribute__((ext_vector_type(4)));
typedef float f32x4 __attribute__((ext_vector_type(4)));
constexpr int NWAVES = 8, NTHREADS = 512;
constexpr int BATCH = 32, SEQ = 2048, DM = 1024, T = BATCH * SEQ, DFF = 2816, QKVW = 1536, NH = 16;
constexpr int LDS_BYTES = 135168;
constexpr size_t MiB = 1u << 20;
constexpr size_t WS_WIN0 = 0;
constexpr size_t WS_WOUT0 = WS_WIN0 + (size_t)1536 * 1024 * 2;
constexpr size_t WS_WIN1 = WS_WOUT0 + (size_t)1024 * 1024 * 2;
constexpr size_t WS_WOUT1 = WS_WIN1 + (size_t)4608 * 1024 * 2;
constexpr size_t WS_WGU0 = WS_WOUT1 + (size_t)1024 * 1024 * 2;
constexpr size_t WS_WGU1 = WS_WGU0 + (size_t)5632 * 1024 * 2;
constexpr size_t WS_WD0 = WS_WGU1 + (size_t)5632 * 1024 * 2;
constexpr size_t WS_WD1 = WS_WD0 + (size_t)1024 * 2816 * 2;
constexpr size_t WS_COS = WS_WD1 + (size_t)1024 * 2816 * 2;
constexpr size_t WS_SIN = WS_COS + (size_t)2048 * 32 * 4;
constexpr size_t WS_SSQ = WS_SIN + (size_t)2048 * 32 * 4;
constexpr size_t WS_LSE = WS_SSQ + (size_t)5 * T * 4;
constexpr size_t WS_CTL = 71 * MiB;
constexpr size_t WS_ROT = 71 * MiB + 65536;
constexpr size_t WS_XB = 72 * MiB;
constexpr size_t WS_O = WS_XB + 128 * MiB;
constexpr size_t WS_BIG = WS_O + 128 * MiB;
constexpr size_t WS_END = WS_BIG + (size_t)T * 4608 * 2;
static_assert(WS_LSE + (size_t)3 * T * 16 * 4 <= WS_XB, "ws map");

__device__ __forceinline__ unsigned f2bf(float f) { unsigned u = __builtin_bit_cast(unsigned, f); return (u + 0x7fffu + ((u >> 16) & 1u)) >> 16; }
__device__ __forceinline__ unsigned pk2(float lo, float hi) { return f2bf(lo) | (f2bf(hi) << 16); }
__device__ __forceinline__ float wave_sum(float v) {
#pragma unroll
    for (int o = 1; o < 64; o <<= 1) v += __shfl_xor(v, o);
    return v;
}
__device__ __forceinline__ void transpose_item(const float* Wa, const float* Wb, int mode, const float* gain, int K, int Nsrc, bf16* WT, int nblk, LAS float* scr, int item, int lane) {
    const int kb = item / nblk, nb = item % nblk, k0 = 64 * kb, n0 = 32 * nb;
    const int np = n0 + (lane & 31); const float* W = Wa; int ncol = np;
    if (mode == 1) { const int grp = np / 1536; int c = np % 1536;
        if (c < 1280) { const int head = c >> 6, pp = c & 63, j = pp >> 3, e = pp & 7; c = head * 64 + (e < 4 ? 4 * j + e : 32 + 4 * j + (e - 4)); }
        ncol = grp * 1536 + c; }
    else if (mode == 2) { const int pn = np >> 8, wi = np & 255; W = (wi >> 7) ? Wb : Wa; ncol = pn * 128 + (wi & 127); }
    float wv[32], gv[32];
#pragma unroll
    for (int i = 0; i < 32; ++i) { const int kk = 2 * i + (lane >> 5); wv[i] = W[(size_t)(k0 + kk) * Nsrc + ncol]; gv[i] = gain ? gain[k0 + kk] : 1.0f; }
#pragma unroll
    for (int i = 0; i < 32; ++i) { const int kk = 2 * i + (lane >> 5); scr[kk * 33 + (lane & 31)] = wv[i] * gv[i]; }
    asm volatile("s_waitcnt lgkmcnt(0)" ::: "memory");
    const int c = lane & 7;
#pragma unroll
    for (int j = 0; j < 4; ++j) { const int n = (lane >> 3) + 8 * j; const LAS float* s = scr + (8 * c) * 33 + n;
        v4u o; o.x = pk2(s[0 * 33], s[1 * 33]); o.y = pk2(s[2 * 33], s[3 * 33]); o.z = pk2(s[4 * 33], s[5 * 33]); o.w = pk2(s[6 * 33], s[7 * 33]);
        *(v4u*)(WT + (size_t)(n0 + n) * K + k0 + 8 * c) = o; }
    asm volatile("s_waitcnt lgkmcnt(0)" ::: "memory");
}

#define XB_TMO      128
#define XB_XCNT(j)  (256  + 64 * (j))
#define XB_XSUB(j)  (1280 + 64 * (j))
#define XB_XGEN(j)  (2304 + 64 * (j))
#define XB_TOP      3328
#define XB_TOPGEN   3392
#define XCD_BAR_WORDS 3456
#define XB_SPIN_CAP (1u << 18)
__device__ __forceinline__ unsigned xb_ld(unsigned* p)              { return __hip_atomic_load(p, __ATOMIC_RELAXED, __HIP_MEMORY_SCOPE_AGENT); }
__device__ __forceinline__ unsigned xb_add(unsigned* p, unsigned v) { return __hip_atomic_fetch_add(p, v, __ATOMIC_RELAXED, __HIP_MEMORY_SCOPE_AGENT); }
__device__ __forceinline__ unsigned xb_xcc_id() { return (unsigned)__builtin_amdgcn_s_getreg((3 << 11) | 20) & 0xFu; }
#define XB_SPIN(cond, bar) do { unsigned _sp = 0; while (cond) { __builtin_amdgcn_s_sleep(1); \
    if ((++_sp & 255u) == 0u) { if (xb_ld(&(bar)[XB_TMO])) break; if (_sp > XB_SPIN_CAP) { atomicAdd(&(bar)[XB_TMO], 1u); break; } } } } while (0)
struct XcdBarrier { unsigned* bar; unsigned x; volatile LAS unsigned* st; };
__device__ __forceinline__ XcdBarrier xcd_barrier_post(unsigned* bar, volatile LAS unsigned* st) {
    XcdBarrier b; b.bar = bar; b.x = xb_xcc_id(); b.st = st;
    if (threadIdx.x == 0) (void)xb_add(&bar[XB_XCNT(b.x)], 1u);
    return b;
}
__device__ __forceinline__ void xcd_barrier_complete(unsigned* bar, unsigned x, unsigned& nloc, unsigned& nx) {
    const unsigned G = gridDim.x * gridDim.y * gridDim.z;
    unsigned sum, cnt, mine, sp = 0u;
    for (;;) {
        sum = 0u; cnt = 0u; mine = 0u;
#pragma unroll
        for (unsigned j = 0; j < 16; ++j) { const unsigned c = xb_ld(&bar[XB_XCNT(j)]); sum += c; cnt += (c > 0u) ? 1u : 0u; mine = (j == x) ? c : mine; }
        if (sum == G) break;
        __builtin_amdgcn_s_sleep(1);
        if ((++sp & 255u) == 0u) { if (xb_ld(&bar[XB_TMO])) break; if (sp > XB_SPIN_CAP) { atomicAdd(&bar[XB_TMO], 1u); break; } }
    }
    nloc = mine > 0u ? mine : 1u; nx = cnt > 0u ? cnt : 1u;
}
__device__ __forceinline__ void xcd_barrier(const XcdBarrier& b) {
    asm volatile("s_waitcnt vmcnt(0)" ::: "memory");
    __syncthreads();
    if (threadIdx.x == 0) {
        unsigned* bar = b.bar;
        __builtin_amdgcn_s_waitcnt(0);
        unsigned nloc = b.st[0], nx = b.st[1];
        if (nloc == 0u) { xcd_barrier_complete(bar, b.x, nloc, nx); b.st[0] = nloc; b.st[1] = nx; }
        const unsigned old = xb_add(&bar[XB_XSUB(b.x)], 1u);
        const unsigned gen = old / nloc;
        if (old + 1u == (gen + 1u) * nloc) {
            __builtin_amdgcn_fence(__ATOMIC_RELEASE, "agent");
            asm volatile("s_waitcnt vmcnt(0)" ::: "memory");
            const unsigned og = xb_add(&bar[XB_TOP], 1u);
            const unsigned tg = og / nx;
            if (og + 1u == (tg + 1u) * nx) xb_add(&bar[XB_TOPGEN], 1u);
            else XB_SPIN(xb_ld(&bar[XB_TOPGEN]) == tg, bar);
            __builtin_amdgcn_fence(__ATOMIC_ACQUIRE, "agent");
            xb_add(&bar[XB_XGEN(b.x)], 1u);
            asm volatile("s_waitcnt vmcnt(0)" ::: "memory");
        } else {
            XB_SPIN(xb_ld(&bar[XB_XGEN(b.x)]) == gen, bar);
            __builtin_amdgcn_fence(__ATOMIC_ACQUIRE, "agent");
            asm volatile("s_waitcnt vmcnt(0)" ::: "memory");
        }
    }
    __syncthreads();
}

#define XB_LOC(j) (3456 + 64 * (j))
__device__ __forceinline__ void xcd_local_barrier(unsigned* bar, unsigned x, unsigned nloc, unsigned epoch) {
    asm volatile("s_waitcnt vmcnt(0)" ::: "memory");
    __syncthreads();
    if (threadIdx.x == 0) {
        __builtin_amdgcn_s_waitcnt(0);
        (void)xb_add(&bar[XB_LOC(x)], 1u);
        const unsigned target = epoch * nloc;
        XB_SPIN(xb_ld(&bar[XB_LOC(x)]) < target, bar);
        __builtin_amdgcn_fence(__ATOMIC_ACQUIRE, "agent");
        asm volatile("s_waitcnt vmcnt(0)" ::: "memory");
    }
    __syncthreads();
}

struct Args {
    const float* x; const float* a_w_in; const float* a_sink; const float* a_w_out; const float* b_w_in; const float* b_w_out;
    const float* norm_mix; const float* norm_ffn; const float* w_gate; const float* w_up; const float* w_down; const float* final_norm;
    float* out; unsigned char* ws; int ph_lo, ph_hi;
};
constexpr int N_PHASES = 13;

__global__ void __launch_bounds__(NTHREADS, 2) mega_fwd(Args a) {
    extern __shared__ __attribute__((aligned(16))) unsigned char lds_raw[];
    LAS unsigned char* lds = (LAS unsigned char*)lds_raw;
    const int tid = threadIdx.x, lane = tid & 63, wave = __builtin_amdgcn_readfirstlane(tid >> 6);
    const int G = gridDim.x, bid = blockIdx.x;
    unsigned char* ws = a.ws;
    bf16* Win0 = (bf16*)(ws + WS_WIN0); bf16* Wout0 = (bf16*)(ws + WS_WOUT0); bf16* Win1 = (bf16*)(ws + WS_WIN1); bf16* Wout1 = (bf16*)(ws + WS_WOUT1);
    bf16* Wgu0 = (bf16*)(ws + WS_WGU0); bf16* Wgu1 = (bf16*)(ws + WS_WGU1); bf16* Wd0 = (bf16*)(ws + WS_WD0); bf16* Wd1 = (bf16*)(ws + WS_WD1);
    float* cosT = (float*)(ws + WS_COS); float* sinT = (float*)(ws + WS_SIN); float* rotT = (float*)(ws + WS_ROT); unsigned* ssq = (unsigned*)(ws + WS_SSQ); float* lse = (float*)(ws + WS_LSE);
    bf16* XB = (bf16*)(ws + WS_XB); bf16* OB = (bf16*)(ws + WS_O); bf16* BIG = (bf16*)(ws + WS_BIG);
    float* X = a.out;
    const int lo = a.ph_lo, hi_ph = a.ph_hi;
    unsigned* ctl = (unsigned*)(ws + WS_CTL);
    LAS unsigned* ldsctl = (LAS unsigned*)(lds + 133120);
    if (tid < 8) ldsctl[tid] = 0u;
    __syncthreads();
    XcdBarrier xbar; xbar.bar = ctl; xbar.x = 0; xbar.st = nullptr;
    if (MK_N_LAUNCHES == 1) { xbar.bar = ctl; xbar.x = xb_xcc_id(); xbar.st = (volatile LAS unsigned*)(ldsctl + 2);
        if (tid == 0) ldsctl[4] = xb_add(&ctl[XB_XCNT(xbar.x)], 1u); }
    int vid = bid, bidA = bid; bool local_mode = false; unsigned lepoch = 0u;
    if (a.ph_lo < 0) cg::this_grid().sync();
#define IN(k) (lo <= (k) && (k) < hi_ph)
#define GSYNC() do { asm volatile("s_waitcnt vmcnt(0) lgkmcnt(0)" ::: "memory"); cg::this_grid().sync(); } while (0)
#define SEAM(k) do { if (IN(k) && IN((k) + 1)) { if (local_mode) { ++lepoch; xcd_local_barrier(ctl, xbar.x, (unsigned)(G / 8), lepoch); } else { xcd_barrier(xbar); } } } while (0)
#define STAGGER() do { if (STAGGER_US > 0) { const unsigned long long t0_ = __builtin_amdgcn_s_memrealtime(); const unsigned long long d_ = (unsigned long long)((bid >> 3) & 7) * (unsigned long long)(STAGGER_US * 100 / 8); \
        while (__builtin_amdgcn_s_memrealtime() - t0_ < d_) __builtin_amdgcn_s_sleep(8); } } while (0)

    if (IN(0)) {
        LAS float* scr = (LAS float*)(lds + wave * 16384);
        const int gw = bid * NWAVES + wave, NGW = G * NWAVES;
        constexpr int I_IN0 = 16 * 48, I_OUT = 16 * 32, I_IN1 = 16 * 144, I_GU = 16 * 176, I_D = 44 * 32;
        constexpr int NITEMS = I_IN0 + 2 * I_OUT + I_IN1 + 2 * I_GU + 2 * I_D;
        for (int it = gw; it < NITEMS; it += NGW) {
            int r = it;
            if (r < I_IN0) { transpose_item(a.a_w_in, nullptr, 1, a.norm_mix, 1024, 1536, Win0, 48, scr, r, lane); continue; } r -= I_IN0;
            if (r < I_OUT) { transpose_item(a.a_w_out, nullptr, 0, nullptr, 1024, 1024, Wout0, 32, scr, r, lane); continue; } r -= I_OUT;
            if (r < I_IN1) { transpose_item(a.b_w_in, nullptr, 1, a.norm_mix + 1024, 1024, 4608, Win1, 144, scr, r, lane); continue; } r -= I_IN1;
            if (r < I_OUT) { transpose_item(a.b_w_out, nullptr, 0, nullptr, 1024, 1024, Wout1, 32, scr, r, lane); continue; } r -= I_OUT;
            if (r < I_GU) { transpose_item(a.w_gate, a.w_up, 2, a.norm_ffn, 1024, 2816, Wgu0, 176, scr, r, lane); continue; } r -= I_GU;
            if (r < I_GU) { transpose_item(a.w_gate + (size_t)1024 * 2816, a.w_up + (size_t)1024 * 2816, 2, a.norm_ffn + 1024, 1024, 2816, Wgu1, 176, scr, r, lane); continue; } r -= I_GU;
            if (r < I_D) { transpose_item(a.w_down, nullptr, 0, nullptr, 2816, 1024, Wd0, 32, scr, r, lane); continue; } r -= I_D;
            transpose_item(a.w_down + (size_t)2816 * 1024, nullptr, 0, nullptr, 2816, 1024, Wd1, 32, scr, r, lane);
        }
        const int gt = bid * NTHREADS + tid, NGT = G * NTHREADS;
        for (int i = gt; i < 2048 * 32; i += NGT) {
            const int t = i >> 5, f = i & 31; double inv = 1.0; for (int k = 0; k < f; ++k) inv *= 0.74989420933245583;
            double rev = (double)t * inv * 0.15915494309189535; rev = rev - __builtin_floor(rev); const float fr = (float)rev;
            cosT[i] = __builtin_amdgcn_cosf(fr); sinT[i] = __builtin_amdgcn_sinf(fr);
        }
        if (gt < 32) { double inv = 1.0; for (int k = 0; k < gt; ++k) inv *= 0.74989420933245583;
            double r16 = 16.0 * inv * 0.15915494309189535; r16 -= __builtin_floor(r16); double r128 = 128.0 * inv * 0.15915494309189535; r128 -= __builtin_floor(r128);
            rotT[gt] = __builtin_amdgcn_cosf((float)r16); rotT[32 + gt] = __builtin_amdgcn_sinf((float)r16); rotT[64 + gt] = __builtin_amdgcn_cosf((float)r128); rotT[96 + gt] = __builtin_amdgcn_sinf((float)r128); }
        for (int i = gt; i < 4 * T; i += NGT) ssq[T + i] = 0u;
        for (int row = gw; row < T; row += 4 * NGW) {
            f32x4 v[4][4];
#pragma unroll
            for (int q = 0; q < 4; ++q) { const int rq = min(row + q * NGW, T - 1); const f32x4* xr = (const f32x4*)(a.x + (size_t)rq * DM) + lane;
#pragma unroll
                for (int j = 0; j < 4; ++j) v[q][j] = xr[64 * j]; }
#pragma unroll
            for (int q = 0; q < 4; ++q) { const int rq = row + q * NGW; if (rq < T) { float s = 0.f;
#pragma unroll
                for (int j = 0; j < 4; ++j) s += (v[q][j].x * v[q][j].x + v[q][j].y * v[q][j].y) + (v[q][j].z * v[q][j].z + v[q][j].w * v[q][j].w);
                s = wave_sum(s); if (lane == 0) ssq[rq] = (unsigned)(s * pg8::SSQ_SCALE + 0.5f);
                unsigned long long* o8 = (unsigned long long*)(XB + (size_t)rq * DM) + lane;
#pragma unroll
                for (int j = 0; j < 4; ++j) o8[64 * j] = (unsigned long long)pk2(v[q][j].x, v[q][j].y) | ((unsigned long long)pk2(v[q][j].z, v[q][j].w) << 32); } }
        }
        __syncthreads();
    }
    SEAM(0);
    if (MK_N_LAUNCHES == 1 && XCD_LOCAL && IN(0) && IN(1)) {
        bool okc = (G % 8) == 0 && (G / 8) == 32;
        for (int j = 0; j < 16; ++j) { const unsigned c = xb_ld(&ctl[XB_XCNT(j)]); okc = okc && (j < 8 ? c == (unsigned)(G / 8) : c == 0u); }
        okc = okc && xbar.x < 8u;
        if (okc) { const int xl = (int)ldsctl[4]; local_mode = true; vid = xl * 8 + (int)xbar.x; bidA = (int)xbar.x * 32 + xl; }
    }
    const size_t SLICE = (size_t)8192 * 4608;
    const size_t xsel = local_mode ? (size_t)xbar.x : 0;
    bf16* BIGQ = BIG + xsel * (SLICE - (size_t)8192 * QKVW);
    bf16* BIGH = BIG + xsel * (SLICE - (size_t)8192 * DFF);
    bf16* BIGP = BIG;
    if (IN(1)) _Pragma("unroll") for (int rep = 0; rep < (PROBE_DUP == 1 ? 2 : 1); ++rep) {
        if (rep) GSYNC();
        pg8::Gemm g{XB, Win0, T, QKVW, DM}; pg8::StaticOrder S; S.init(T, QKVW, G, vid);
        pg8::EpiQKV E{BIGQ, QKVW, ssq, cosT, sinT, rotT};
        STAGGER();
        pg8::gemm_phase<pg8::EpiQKV, pg8::StaticOrder, true, true>(lds, g, S, E);
    }
    SEAM(1);
    if (IN(2)) _Pragma("unroll") for (int rep = 0; rep < (PROBE_DUP == 2 ? 2 : 1); ++rep) {
        if (rep) GSYNC();
        constexpr int NU = BATCH * 4 * 32; const int per = (NU + G - 1) / G;
        const bf16* BIGc = BIGQ; bf16* OBc = OB; const float* sinkp = a.a_sink;
        auto dec = [=](int u) { const int qb = u & 31, kvh = (u >> 5) & 3, b = u >> 7; const bf16* base = BIGc + (size_t)b * SEQ * QKVW;
            return att::AU{base + kvh * 256, base + 1024 + kvh * 64, base + 1280 + kvh * 64, OBc + (size_t)b * SEQ * DM + kvh * 256, (size_t)QKVW, (size_t)DM, SEQ, qb * 64, sinkp + kvh * 4, nullptr, 0}; };
        att::phase<128, true, false>(lds, min(NU, bidA * per), min(NU, (bidA + 1) * per), dec);
    }
    SEAM(2);
    if (IN(3)) {
        pg8::Gemm g{OB, Wout0, T, DM, DM}; pg8::StaticOrder S; S.init(T, DM, G, vid);
        pg8::EpiRes E{XB, ssq + T};
        STAGGER();
        pg8::gemm_phase<pg8::EpiRes, pg8::StaticOrder, true, true>(lds, g, S, E);
    }
    SEAM(3);
    if (IN(4)) _Pragma("unroll") for (int rep = 0; rep < (PROBE_DUP == 4 ? 2 : 1); ++rep) {
        if (rep) GSYNC();
        pg8::Gemm g{XB, Wgu0, T, 2 * DFF, DM}; pg8::StaticOrder S; S.init(T, 2 * DFF, G, vid);
        pg8::EpiSwiGLU E{BIGH, DFF, ssq + T};
        STAGGER();
        pg8::gemm_phase<pg8::EpiSwiGLU, pg8::StaticOrder, true, true>(lds, g, S, E);
    }
    SEAM(4);
    if (IN(5)) {
        pg8::Gemm g{BIGH, Wd0, T, DM, DFF}; pg8::StaticOrder S; S.init(T, DM, G, vid);
        pg8::EpiRes E{XB, ssq + 2 * T};
        STAGGER();
        pg8::gemm_phase<pg8::EpiRes, pg8::StaticOrder, true, true>(lds, g, S, E);
    }
    SEAM(5);
    if (IN(6)) _Pragma("unroll") for (int rep = 0; rep < (PROBE_DUP == 6 ? 2 : 1); ++rep) {
        if (rep) GSYNC();
        pg8::Gemm g{XB, Win1, T, 3 * QKVW, DM}; pg8::StaticOrder S; S.init(T, 3 * QKVW, G, vid);
        pg8::EpiQKV E{BIGP, 3 * QKVW, ssq + 2 * T, cosT, sinT, rotT};
        STAGGER();
        pg8::gemm_phase<pg8::EpiQKV, pg8::StaticOrder, true, true>(lds, g, S, E);
    }
    SEAM(6);
    if (IN(7)) {
        constexpr int NU = 3 * BATCH * 4 * 32; const int per = (NU + G - 1) / G;
        bf16* BIGc = BIGP; float* lsep = lse;
        auto dec = [=](int u) { const int xblk = u / 1536, rem = u % 1536, gidx = rem >> 9, v = rem & 511, b = 4 * xblk + (v >> 7), kvh = (v >> 5) & 3, qa = v & 31;
            const int dsh = 2 * gidx, dil = 1 << dsh, nbk = 32 >> dsh, r = qa / nbk, qb = qa % nbk;
            bf16* base = BIGc + ((size_t)b * SEQ + r) * (3 * QKVW) + gidx * QKVW;
            return att::AU{base + kvh * 256, base + 1024 + kvh * 64, base + 1280 + kvh * 64, base + kvh * 256, (size_t)dil * 3 * QKVW, (size_t)dil * 3 * QKVW, SEQ >> dsh, qb * 64, nullptr,
                           lsep + ((size_t)gidx * T + (size_t)b * SEQ + r) * NH + kvh * 4, (size_t)dil * NH}; };
        att::phase<64, false, true>(lds, min(NU, bidA * per), min(NU, (bidA + 1) * per), dec);
    }
    SEAM(7);
    if (IN(8)) {
        const int gt = bid * NTHREADS + tid, NGT = G * NTHREADS;
        const int tpw = T / G;
#pragma unroll 4
        for (int il = tid; il < tpw * 128; il += NTHREADS) {
            const int i = bidA * tpw * 128 + il;
            const int tok = i >> 7, ch = i & 127, head = ch >> 3;
            const float l0 = lse[(size_t)tok * NH + head], l1 = lse[((size_t)T + tok) * NH + head], l2 = lse[((size_t)2 * T + tok) * NH + head];
            const float mx = fmaxf(l0, fmaxf(l1, l2)); float w0 = __builtin_amdgcn_exp2f(l0 - mx), w1 = __builtin_amdgcn_exp2f(l1 - mx), w2 = __builtin_amdgcn_exp2f(l2 - mx);
            const float inv = 1.0f / (w0 + w1 + w2); w0 *= inv; w1 *= inv; w2 *= inv;
            const bf16* src = BIGP + (size_t)tok * (3 * QKVW) + ch * 8;
            const v4u a0 = *(const v4u*)src, a1 = *(const v4u*)(src + QKVW), a2 = *(const v4u*)(src + 2 * QKVW);
            v4u o;
#pragma unroll
            for (int e = 0; e < 4; ++e) {
                const float x0 = __uint_as_float(a0[e] << 16), y0 = __uint_as_float(a0[e] & 0xffff0000u);
                const float x1 = __uint_as_float(a1[e] << 16), y1 = __uint_as_float(a1[e] & 0xffff0000u);
                const float x2 = __uint_as_float(a2[e] << 16), y2 = __uint_as_float(a2[e] & 0xffff0000u);
                o[e] = pk2(w0 * x0 + w1 * x1 + w2 * x2, w0 * y0 + w1 * y1 + w2 * y2);
            }
            *(v4u*)(OB + (size_t)tok * DM + ch * 8) = o;
        }
    }
    SEAM(8);
    if (IN(9)) {
        pg8::Gemm g{OB, Wout1, T, DM, DM}; pg8::StaticOrder S; S.init(T, DM, G, vid);
        pg8::EpiRes E{XB, ssq + 3 * T};
        STAGGER();
        pg8::gemm_phase<pg8::EpiRes, pg8::StaticOrder, true, true>(lds, g, S, E);
    }
    SEAM(9);
    if (IN(10)) _Pragma("unroll") for (int rep = 0; rep < (PROBE_DUP == 10 ? 2 : 1); ++rep) {
        if (rep) GSYNC();
        pg8::Gemm g{XB, Wgu1, T, 2 * DFF, DM}; pg8::StaticOrder S; S.init(T, 2 * DFF, G, vid);
        pg8::EpiSwiGLU E{BIGH, DFF, ssq + 3 * T};
        STAGGER();
        pg8::gemm_phase<pg8::EpiSwiGLU, pg8::StaticOrder, true, true>(lds, g, S, E);
    }
    SEAM(10);
    if (IN(11)) {
        pg8::Gemm g{BIGH, Wd1, T, DM, DFF}; pg8::StaticOrder S; S.init(T, DM, G, vid);
        pg8::EpiRes E{XB, ssq + 4 * T};
        STAGGER();
        pg8::gemm_phase<pg8::EpiRes, pg8::StaticOrder, true, true>(lds, g, S, E);
    }
    SEAM(11);
    if (IN(12)) {
        const int gt = bid * NTHREADS + tid, NGT = G * NTHREADS;
        const int tpw = T / G;
#pragma unroll 4
        for (int il = tid; il < tpw * 128; il += NTHREADS) {
            const int i = bidA * tpw * 128 + il;
            const int row = i >> 7, ch = i & 127;
            const float rstd = __builtin_amdgcn_rsqf((float)ssq[4 * T + row] * pg8::SSQ_INV + pg8::RMS_EPS);
            const v4u v = *(const v4u*)(XB + (size_t)row * DM + ch * 8);
            const f32x4 g0 = *(const f32x4*)(a.final_norm + ch * 8), g1 = *(const f32x4*)(a.final_norm + ch * 8 + 4);
            const f32x4 o0 = (f32x4){__uint_as_float(v.x << 16), __uint_as_float(v.x & 0xffff0000u), __uint_as_float(v.y << 16), __uint_as_float(v.y & 0xffff0000u)};
            const f32x4 o1 = (f32x4){__uint_as_float(v.z << 16), __uint_as_float(v.z & 0xffff0000u), __uint_as_float(v.w << 16), __uint_as_float(v.w & 0xffff0000u)};
            float* orow = X + (size_t)row * DM + ch * 8;
            *(f32x4*)orow = o0 * rstd * g0; *(f32x4*)(orow + 4) = o1 * rstd * g1;
        }
    }
#undef IN
#undef SEAM
}

extern "C" void kernel_launch(void* const* d_in, const int* in_sizes, int n_in, void* d_out, int out_size, void* d_ws, size_t ws_size, hipStream_t stream) {
    static int grid = 0;
    if (grid == 0) {
        if (n_in != 12 || in_sizes[0] != T * DM || out_size != T * DM || ws_size < WS_END) {
            fprintf(stderr, "kernel_launch: unexpected shapes (n_in %d, in0 %d, out %d, ws %zu, need %zu)\n", n_in, n_in > 0 ? in_sizes[0] : -1, out_size, ws_size, (size_t)WS_END); grid = -1; return; }
        int dev = 0, cus = 0, per_cu = 0;
        hipGetDevice(&dev); hipDeviceGetAttribute(&cus, hipDeviceAttributeMultiprocessorCount, dev);
        if (hipFuncSetAttribute((const void*)mega_fwd, hipFuncAttributeMaxDynamicSharedMemorySize, LDS_BYTES) != hipSuccess) { fprintf(stderr, "kernel_launch: hipFuncSetAttribute failed\n"); grid = -1; return; }
        if (hipOccupancyMaxActiveBlocksPerMultiprocessor(&per_cu, (const void*)mega_fwd, NTHREADS, LDS_BYTES) != hipSuccess || per_cu < 1) { fprintf(stderr, "kernel_launch: occupancy query gave %d\n", per_cu); per_cu = 1; }
        (void)hipGetLastError();
        grid = cus * per_cu;
        if (T % grid != 0) { fprintf(stderr, "kernel_launch: grid %d does not divide the %d tokens\n", grid, T); grid = -1; return; }
    }
    if (grid < 0) return;
    Args a{};
    a.x = (const float*)d_in[0]; a.a_w_in = (const float*)d_in[1]; a.a_sink = (const float*)d_in[2]; a.a_w_out = (const float*)d_in[3];
    a.b_w_in = (const float*)d_in[4]; a.b_w_out = (const float*)d_in[5]; a.norm_mix = (const float*)d_in[6]; a.norm_ffn = (const float*)d_in[7];
    a.w_gate = (const float*)d_in[8]; a.w_up = (const float*)d_in[9]; a.w_down = (const float*)d_in[10]; a.final_norm = (const float*)d_in[11];
    a.out = (float*)d_out; a.ws = (unsigned char*)d_ws;
#if MK_N_LAUNCHES == 1
    (void)hipMemsetAsync((char*)d_ws + WS_CTL, 0, 16384, stream);
    a.ph_lo = 0; a.ph_hi = N_PHASES;
    void* args[] = {&a};
    hipError_t e = hipLaunchCooperativeKernel((const void*)mega_fwd, dim3(grid), dim3(NTHREADS), args, LDS_BYTES, stream);
    if (e != hipSuccess) fprintf(stderr, "cooperative launch failed: %s (grid %d)\n", hipGetErrorString(e), grid);
#else
    for (int p = 0; p < N_PHASES; ++p) { a.ph_lo = p; a.ph_hi = p + 1; hipLaunchKernelGGL(mega_fwd, dim3(grid), dim3(NTHREADS), LDS_BYTES, stream, a); }
#endif
}
```

```cpp
#include <hip/hip_runtime.h>
#include <hip/hip_cooperative_groups.h>
#include <cstdio>
#include <cstdint>
namespace cg = cooperative_groups;

#ifndef PROBE_DUP
#define PROBE_DUP -1
#endif
#ifndef STAGGER_US
#define STAGGER_US 0
#endif
#ifndef XCD_LOCAL
#define XCD_LOCAL 1
#endif
#ifndef FFN_PARTS
#define FFN_PARTS 2
#endif
#ifndef MK_N_LAUNCHES
#define MK_N_LAUNCHES 1
#endif

namespace pg8 {
#define PG8_LAS __attribute__((address_space(3)))
typedef unsigned short bf16_t;
typedef short bf16x8 __attribute__((ext_vector_type(8)));
typedef float f32x4 __attribute__((ext_vector_type(4)));
typedef unsigned u32x4 __attribute__((ext_vector_type(4)));
typedef unsigned u32x2 __attribute__((ext_vector_type(2)));
constexpr int BM = 256, BK = 64, HALF = 128, HTB = HALF * BK * 2, STAGE_BYTES = 8 * HTB, NXCD = 8, WGM = 8;

__host__ __device__ __forceinline__ int lds_byte(int r, int c) { const int st = (r >> 4) * 2 + (c >> 5), rr = r & 15, cc = c & 31, ob = rr * 64 + cc * 2; return st * 1024 + (ob ^ (((ob >> 9) & 1) << 5)); }
__host__ __device__ __forceinline__ void stage_rc(int b, int& R, int& C) { const int st = b / 1024, sb = b % 1024, swz = sb ^ (((sb >> 9) & 1) << 5); R = (st >> 1) * 16 + swz / 64; C = (st & 1) * 32 + (swz % 64) / 2; }
__host__ __device__ __forceinline__ int perm32(int rho) { const int n = rho >> 4, i = rho & 15; return 8 * (i >> 2) + 4 * n + (i & 3); }

struct Unit { int pm, pn; };
struct Gemm { const bf16_t* A; const bf16_t* Bt; int M, N, K; };

struct StaticOrder {
    int nM, nN, nwg, G, c, part, nparts;
    __host__ __device__ void init(int M, int N, int G_, int c_) { nM = M / BM; nN = N / BM; nwg = nM * nN; G = G_; c = c_; part = 0; nparts = 1; }
    __host__ __device__ bool next(int i, Unit& u) const {
        const long L = (long)i * G + c; if (L >= nwg / nparts) return false;
        int wgid = (int)L; { const int q = nwg / NXCD, r = nwg % NXCD, xcd = wgid % NXCD, off = wgid / NXCD + part * (q / nparts); wgid = (xcd < r ? xcd * (q + 1) : r * (q + 1) + (xcd - r) * q) + off; }
        const int nig = WGM * nN, gid = wgid / nig, fm = gid * WGM, gsz = (nM - fm) < WGM ? (nM - fm) : WGM;
        u.pm = fm + ((wgid % nig) % gsz); u.pn = (wgid % nig) / gsz; return true;
    }
    __device__ __forceinline__ void a_ready(const Unit&) const {}
    __device__ __forceinline__ void done(const Unit&) const {}
};

__device__ __forceinline__ unsigned cvt_pk_bf16(float lo, float hi) { unsigned r; asm volatile("v_cvt_pk_bf16_f32 %0, %1, %2" : "=v"(r) : "v"(lo), "v"(hi)); return r; }

constexpr float RMS_EPS = 1e-6f;
constexpr float SSQ_SCALE = 2048.0f, SSQ_INV = 1.0f / (2048.0f * 1024.0f);
constexpr float QSCALE = 0.125f * 1.4426950408889634f;


struct EpiQKV {
    static constexpr bool PERM = true, AFTER_DRAIN = false;
    bf16_t* O; int ldc; const unsigned* ssq; const float* cosT; const float* sinT; const float* rot;
    __device__ __forceinline__ void operator()(const f32x4 (&acc)[2][2][4][2], const Unit& u, int wr, int wc, int fr, int fq) const {
        const int row0 = u.pm * BM + wr * 64 + fr; const int t6 = u.pn % 6;
        const int col0 = u.pn * BM + wc * 32 + 8 * fq; const int fi = 16 * (wc & 1) + 4 * fq;
        const float qs = t6 < 4 ? QSCALE : 1.0f; const bool rope = t6 < 5;
        unsigned sq[8];
#pragma unroll
        for (int i = 0; i < 8; ++i) { const int row = row0 + (i >> 2) * HALF + (i & 3) * 16; sq[i] = ssq[row]; }
        f32x4 c0 = (f32x4){1.f, 1.f, 1.f, 1.f}, s0 = (f32x4){0.f, 0.f, 0.f, 0.f}, c16 = c0, s16 = s0, c128 = c0, s128 = s0;
        if (rope) { const int t0 = row0 & 2047;
            c0 = *(const f32x4*)(cosT + t0 * 32 + fi); s0 = *(const f32x4*)(sinT + t0 * 32 + fi);
            c16 = *(const f32x4*)(rot + fi); s16 = *(const f32x4*)(rot + 32 + fi); c128 = *(const f32x4*)(rot + 64 + fi); s128 = *(const f32x4*)(rot + 96 + fi); }
        asm volatile("" ::: "memory");
#pragma unroll
        for (int ai = 0; ai < 2; ++ai) {
            f32x4 c = c0, sn = s0;
            if (ai == 1) { c = c0 * c128 - s0 * s128; sn = s0 * c128 + c0 * s128; }
#pragma unroll
            for (int m = 0; m < 4; ++m) {
                const int row = row0 + ai * HALF + m * 16;
                const float s1 = __builtin_amdgcn_rsqf((float)sq[ai * 4 + m] * SSQ_INV + RMS_EPS) * qs; const f32x4 c1 = c * s1, n1 = sn * s1;
                bf16_t* rowp = O + (size_t)row * ldc + col0;
#pragma unroll
                for (int bj = 0; bj < 2; ++bj) {
                    const f32x4 v0 = acc[ai][bj][m][0], v1 = acc[ai][bj][m][1];
                    const f32x4 o0 = v0 * c1 - v1 * n1, o1 = v1 * c1 + v0 * n1;
                    u32x4 w; w.x = cvt_pk_bf16(o0[0], o0[1]); w.y = cvt_pk_bf16(o0[2], o0[3]); w.z = cvt_pk_bf16(o1[0], o1[1]); w.w = cvt_pk_bf16(o1[2], o1[3]);
                    *(u32x4*)(rowp + bj * HALF) = w; }
                if (m < 3) { const f32x4 cn = c * c16 - sn * s16; sn = sn * c16 + c * s16; c = cn; }
            }
        }
    }
};

struct EpiSwiGLU {
    static constexpr bool PERM = true, AFTER_DRAIN = false;
    bf16_t* O; int ldc; const unsigned* ssq;
    __device__ __forceinline__ void operator()(const f32x4 (&acc)[2][2][4][2], const Unit& u, int wr, int wc, int fr, int fq) const {
        const int row0 = u.pm * BM + wr * 64 + fr; const int col0 = u.pn * HALF + wc * 32 + 8 * fq;
        unsigned sq[8];
#pragma unroll
        for (int i = 0; i < 8; ++i) sq[i] = ssq[row0 + (i >> 2) * HALF + (i & 3) * 16];
        asm volatile("" ::: "memory");
#pragma unroll
        for (int i = 0; i < 8; ++i) {
            const int ai = i >> 2, m = i & 3; const int row = row0 + ai * HALF + m * 16;
            const float rstd = __builtin_amdgcn_rsqf((float)sq[i] * SSQ_INV + RMS_EPS), nr = -1.4426950408889634f * rstd, r2 = rstd * rstd;
            float h[8];
            typedef float f32x2 __attribute__((ext_vector_type(2)));
#pragma unroll
            for (int n = 0; n < 2; ++n)
#pragma unroll
                for (int e = 0; e < 4; e += 2) { const f32x2 ag = {acc[ai][0][m][n][e], acc[ai][0][m][n][e + 1]}, au = {acc[ai][1][m][n][e], acc[ai][1][m][n][e + 1]};
                    const f32x2 t = ag * nr; f32x2 ex; ex.x = __builtin_amdgcn_exp2f(t.x); ex.y = __builtin_amdgcn_exp2f(t.y);
                    const f32x2 d = ex + 1.0f; f32x2 rc; rc.x = __builtin_amdgcn_rcpf(d.x); rc.y = __builtin_amdgcn_rcpf(d.y);
                    const f32x2 hv = (ag * au) * (rc * r2); h[n * 4 + e] = hv.x; h[n * 4 + e + 1] = hv.y; }
            u32x4 w; w.x = cvt_pk_bf16(h[0], h[1]); w.y = cvt_pk_bf16(h[2], h[3]); w.z = cvt_pk_bf16(h[4], h[5]); w.w = cvt_pk_bf16(h[6], h[7]);
            *(u32x4*)(O + (size_t)row * ldc + col0) = w;
        }
    }
};

struct EpiRes {
    static constexpr bool PERM = true, AFTER_DRAIN = false;
    bf16_t* xb; unsigned* ssq;
    __device__ __forceinline__ void operator()(const f32x4 (&acc)[2][2][4][2], const Unit& u, int wr, int wc, int fr, int fq) const {
        const int row0 = u.pm * BM + wr * 64 + fr; const int col0 = u.pn * BM + wc * 32 + 8 * fq;
#pragma unroll
        for (int i = 0; i < 8; ++i) {
            const int ai = i >> 2, m = i & 3; const int row = row0 + ai * HALF + m * 16; bf16_t* rowp = xb + (size_t)row * 1024 + col0; float s = 0.f;
            u32x4 xv[2];
#pragma unroll
            for (int bj = 0; bj < 2; ++bj) xv[bj] = *(const u32x4*)(rowp + bj * HALF);
#pragma unroll
            for (int bj = 0; bj < 2; ++bj) {
                float o[8];
#pragma unroll
                for (int e = 0; e < 4; ++e) { o[2 * e] = __uint_as_float(xv[bj][e] << 16) + acc[ai][bj][m][e >> 1][(2 * e) & 3]; o[2 * e + 1] = __uint_as_float(xv[bj][e] & 0xffff0000u) + acc[ai][bj][m][e >> 1][(2 * e + 1) & 3]; }
#pragma unroll
                for (int e = 0; e < 8; ++e) s += o[e] * o[e];
                u32x4 w; w.x = cvt_pk_bf16(o[0], o[1]); w.y = cvt_pk_bf16(o[2], o[3]); w.z = cvt_pk_bf16(o[4], o[5]); w.w = cvt_pk_bf16(o[6], o[7]);
                *(u32x4*)(rowp + bj * HALF) = w;
            }
            s += __shfl_xor(s, 16); s += __shfl_xor(s, 32);
            if (fq == 0) atomicAdd(ssq + row, (unsigned)(s * SSQ_SCALE + 0.5f));
        }
    }
};

template <class Epi, class Sched, bool ALIGN_EPI = false, bool SP2 = false>
__device__ __forceinline__ void gemm_phase(PG8_LAS unsigned char* lds, const Gemm g, const Sched& S, const Epi& E) {
    const int tid = threadIdx.x, wid = __builtin_amdgcn_readfirstlane(tid >> 6), lane = tid & 63, wr = wid >> 2, wc = wid & 3, fr = lane & 15, fq = lane >> 4;
    const int K = g.K, nt = K / BK;
    unsigned voffA[2], voffB[2];
#pragma unroll
    for (int i = 0; i < 2; ++i) { int R, C; stage_rc(tid * 16 + i * 8192, R, C); const int Rb = Epi::PERM ? ((R & ~31) + perm32(R & 31)) : R;
        voffA[i] = (unsigned)(R * K + C) * 2u; voffB[i] = (unsigned)(Rb * K + C) * 2u; }
    const size_t kstep = (size_t)(BK * 2);
    const size_t hstep = (size_t)HALF * K * 2;
    const size_t tstep = 2 * hstep;
    const unsigned ldsw = (unsigned)wid * 1024u;
    const int aoff = lds_byte(wr * 64 + fr, fq * 8), boff = lds_byte(wc * 32 + fr, fq * 8);
#define PG8_SA(b, h) (((b) * 2 + (h)) * HTB)
#define PG8_SB(b, h) ((4 + (b) * 2 + (h)) * HTB)
#define PG8_STAGE(bufoff, gbase, voff) do { _Pragma("unroll") for (int _i = 0; _i < 2; ++_i) \
        __builtin_amdgcn_global_load_lds((const unsigned*)((const char*)(gbase) + (voff)[_i]), (PG8_LAS unsigned*)(lds + (bufoff) + ldsw + _i * 8192), 16, 0, 0); } while (0)
#define PG8_LDA(dst, b, h) do { _Pragma("unroll") for (int m = 0; m < 4; ++m) _Pragma("unroll") for (int k = 0; k < 2; ++k) dst[m][k] = *(const PG8_LAS bf16x8*)(lds + PG8_SA(b, h) + aoff + m * 2048 + k * 1024); } while (0)
#define PG8_LDB(dst, b, h) do { _Pragma("unroll") for (int n = 0; n < 2; ++n) _Pragma("unroll") for (int k = 0; k < 2; ++k) dst[n][k] = *(const PG8_LAS bf16x8*)(lds + PG8_SB(b, h) + boff + n * 2048 + k * 1024); } while (0)
#define PG8_MMA(ai, bj, At, Bt) do { __builtin_amdgcn_s_setprio(1); _Pragma("unroll") for (int m = 0; m < 4; ++m) _Pragma("unroll") for (int n = 0; n < 2; ++n) _Pragma("unroll") for (int k = 0; k < 2; ++k) \
        acc[ai][bj][m][n] = __builtin_amdgcn_mfma_f32_16x16x32_bf16(Bt[n][k], At[m][k], acc[ai][bj][m][n], 0, 0, 0); __builtin_amdgcn_s_setprio(0); } while (0)
#define PG8_WAIT_V(n) asm volatile("s_waitcnt vmcnt(" #n ")" ::: "memory")
#define PG8_WAIT_L(n) asm volatile("s_waitcnt lgkmcnt(" #n ")" ::: "memory")
#define PG8_BAR __builtin_amdgcn_s_barrier()
#define PG8_SCHED __builtin_amdgcn_sched_barrier(0)
    Unit cur, nxt; int ui = 0;
    if (!S.next(0, cur)) return;
    f32x4 acc[2][2][4][2];
#pragma unroll
    for (int a = 0; a < 2; ++a)
#pragma unroll
        for (int b = 0; b < 2; ++b)
#pragma unroll
            for (int m = 0; m < 4; ++m)
#pragma unroll
                for (int n = 0; n < 2; ++n) acc[a][b][m][n] = (f32x4){0.f, 0.f, 0.f, 0.f};
    bf16x8 At[4][2], B0[2][2], B1[2][2];
    const char* cA = (const char*)g.A + (size_t)cur.pm * tstep; const char* cB = (const char*)g.Bt + (size_t)cur.pn * tstep;
    S.a_ready(cur);
    if constexpr (SP2) {
        PG8_STAGE(PG8_SB(0, 0), cB, voffB); PG8_STAGE(PG8_SB(0, 1), cB + hstep, voffB); PG8_STAGE(PG8_SA(0, 0), cA, voffA); PG8_STAGE(PG8_SA(0, 1), cA + hstep, voffA);
        if (wr == 1) PG8_BAR;
        PG8_WAIT_V(2); PG8_BAR;
        PG8_STAGE(PG8_SB(1, 0), cB + kstep, voffB); PG8_STAGE(PG8_SA(1, 0), cA + kstep, voffA); PG8_STAGE(PG8_SB(1, 1), cB + hstep + kstep, voffB);
        PG8_WAIT_V(6); PG8_BAR;
    } else {
        PG8_STAGE(PG8_SB(0, 0), cB, voffB); PG8_STAGE(PG8_SA(0, 0), cA, voffA); PG8_STAGE(PG8_SB(0, 1), cB + hstep, voffB); PG8_STAGE(PG8_SA(0, 1), cA + hstep, voffA);
        if (wr == 1) PG8_BAR;
        PG8_WAIT_V(4); PG8_BAR;
        PG8_STAGE(PG8_SB(1, 0), cB + kstep, voffB); PG8_STAGE(PG8_SA(1, 0), cA + kstep, voffA); PG8_STAGE(PG8_SB(1, 1), cB + hstep + kstep, voffB);
        PG8_WAIT_V(6); PG8_BAR;
    }
    for (;;) {
        const bool has_next = S.next(ui + 1, nxt);
        const char* nA = has_next ? (const char*)g.A + (size_t)nxt.pm * tstep : cA; const char* nB = has_next ? (const char*)g.Bt + (size_t)nxt.pn * tstep : cB;
        for (int t = 0; t < nt; t += 2) {
            const bool last = (t == nt - 2);
            const char* a1 = cA + (size_t)(t + 1) * kstep;
            const char* a2 = last ? nA : cA + (size_t)(t + 2) * kstep; const char* b2 = last ? nB : cB + (size_t)(t + 2) * kstep;
            const char* a3 = a2 + kstep; const char* b3 = b2 + kstep;
            if (last && has_next) S.a_ready(nxt);
            if constexpr (SP2) {
            PG8_LDB(B0, 0, 0); PG8_LDB(B1, 0, 1); PG8_SCHED; PG8_LDA(At, 0, 0); PG8_STAGE(PG8_SA(1, 1), a1 + hstep, voffA);
            PG8_WAIT_V(8); PG8_WAIT_L(0); PG8_BAR; PG8_MMA(0, 0, At, B0); PG8_MMA(0, 1, At, B1); PG8_BAR; PG8_SCHED;
            PG8_LDA(At, 0, 1); PG8_STAGE(PG8_SB(0, 0), b2, voffB); PG8_STAGE(PG8_SB(0, 1), b2 + hstep, voffB); PG8_STAGE(PG8_SA(0, 0), a2, voffA);
            PG8_WAIT_V(8); PG8_WAIT_L(0); PG8_BAR; PG8_MMA(1, 0, At, B0); PG8_MMA(1, 1, At, B1); PG8_BAR; PG8_SCHED;
            PG8_LDB(B0, 1, 0); PG8_LDB(B1, 1, 1); PG8_SCHED; PG8_LDA(At, 1, 0); PG8_STAGE(PG8_SA(0, 1), a2 + hstep, voffA);
            PG8_WAIT_V(8); PG8_WAIT_L(0); PG8_BAR; PG8_MMA(0, 0, At, B0); PG8_MMA(0, 1, At, B1); PG8_BAR; PG8_SCHED;
            PG8_LDA(At, 1, 1); PG8_STAGE(PG8_SB(1, 0), b3, voffB); PG8_STAGE(PG8_SB(1, 1), b3 + hstep, voffB); PG8_STAGE(PG8_SA(1, 0), a3, voffA);
            PG8_WAIT_V(8); PG8_WAIT_L(0); PG8_BAR; PG8_MMA(1, 0, At, B0); PG8_MMA(1, 1, At, B1); PG8_BAR; PG8_SCHED;
            } else {
            PG8_LDB(B0, 0, 0); PG8_SCHED; PG8_LDA(At, 0, 0); PG8_STAGE(PG8_SA(1, 1), a1 + hstep, voffA);
            PG8_WAIT_L(8); PG8_BAR; PG8_WAIT_L(0); PG8_MMA(0, 0, At, B0); PG8_BAR; PG8_SCHED;
            PG8_LDB(B1, 0, 1); PG8_STAGE(PG8_SB(0, 0), b2, voffB);
            PG8_BAR; PG8_WAIT_L(0); PG8_MMA(0, 1, At, B1); PG8_BAR;
            PG8_LDA(At, 0, 1); PG8_STAGE(PG8_SA(0, 0), a2, voffA);
            PG8_BAR; PG8_WAIT_L(0); PG8_MMA(1, 0, At, B0); PG8_BAR; PG8_SCHED;
            PG8_STAGE(PG8_SB(0, 1), b2 + hstep, voffB);
            PG8_WAIT_V(6); PG8_BAR; PG8_MMA(1, 1, At, B1); PG8_BAR;
            PG8_LDB(B0, 1, 0); PG8_SCHED; PG8_LDA(At, 1, 0); PG8_STAGE(PG8_SA(0, 1), a2 + hstep, voffA);
            PG8_WAIT_L(8); PG8_BAR; PG8_WAIT_L(0); PG8_MMA(0, 0, At, B0); PG8_BAR; PG8_SCHED;
            PG8_LDB(B1, 1, 1); PG8_STAGE(PG8_SB(1, 0), b3, voffB);
            PG8_BAR; PG8_WAIT_L(0); PG8_MMA(0, 1, At, B1); PG8_BAR;
            PG8_LDA(At, 1, 1); PG8_STAGE(PG8_SA(1, 0), a3, voffA);
            PG8_BAR; PG8_WAIT_L(0); PG8_MMA(1, 0, At, B0); PG8_BAR; PG8_SCHED;
            PG8_STAGE(PG8_SB(1, 1), b3 + hstep, voffB);
            PG8_WAIT_V(6); PG8_BAR; PG8_MMA(1, 1, At, B1); PG8_BAR;
            }
        }
        if constexpr (ALIGN_EPI) { if (wr == 0) PG8_BAR; }
        if constexpr (!Epi::AFTER_DRAIN) { E(acc, cur, wr, wc, fr, fq); S.done(cur); }
        if (!has_next) break;
#pragma unroll
        for (int a = 0; a < 2; ++a)
#pragma unroll
            for (int b = 0; b < 2; ++b)
#pragma unroll
                for (int m = 0; m < 4; ++m)
#pragma unroll
                    for (int n = 0; n < 2; ++n) acc[a][b][m][n] = (f32x4){0.f, 0.f, 0.f, 0.f};
        cur = nxt; cA = nA; cB = nB; ++ui;
        if constexpr (ALIGN_EPI) { if (wr == 1) PG8_BAR; }
    }
    PG8_WAIT_V(0);
    if constexpr (!ALIGN_EPI) { if (wr == 0) PG8_BAR; }
    PG8_BAR;
#undef PG8_SA
#undef PG8_SB
#undef PG8_STAGE
#undef PG8_LDA
#undef PG8_LDB
#undef PG8_MMA
#undef PG8_WAIT_V
#undef PG8_WAIT_L
#undef PG8_BAR
#undef PG8_SCHED
}
}

namespace att {
#define ATT_LAS __attribute__((address_space(3)))
typedef unsigned short bf16_t;
typedef short bf16x8 __attribute__((ext_vector_type(8)));
typedef short s16x4 __attribute__((ext_vector_type(4)));
typedef float f32x16 __attribute__((ext_vector_type(16)));
typedef unsigned u32x4 __attribute__((ext_vector_type(4)));
typedef unsigned u32x2 __attribute__((ext_vector_type(2)));
__device__ __forceinline__ int crow(int r, int hi) { return (r & 3) + 8 * (r >> 2) + 4 * hi; }
__device__ __forceinline__ unsigned swz(int row, int ch) { return (unsigned)(row * 128 + ((ch ^ ((((row >> 1) & 1) << 2) | ((row >> 2) & 3))) << 4)); }
__device__ __forceinline__ float swap32f(float v) { auto rr = __builtin_amdgcn_permlane32_swap(__float_as_uint(v), __float_as_uint(v), false, false); return (threadIdx.x & 32) ? __uint_as_float(rr[0]) : __uint_as_float(rr[1]); }
__device__ __forceinline__ unsigned pk(float lo, float hi) { unsigned r; asm volatile("v_cvt_pk_bf16_f32 %0, %1, %2" : "=v"(r) : "v"(lo), "v"(hi)); return r; }

struct AU { const bf16_t* Q; const bf16_t* K; const bf16_t* V; bf16_t* O; size_t rstride, ostride; int L, q0; const float* sink; float* lse; size_t lstride; };

template <int W, bool SINK, bool LSEOUT, class Dec, bool SKIPT = false>
__device__ __forceinline__ void phase(ATT_LAS unsigned char* lds, int ub, int ue, const Dec& dec) {
    constexpr int NK = 64 + 2 * W, NCH = NK * 8, PER = NCH / 512, NT = 2 * W / 32 + 1, VOFF = NK * 128;
    static_assert(NCH % 512 == 0, "staging split");
    if (ub >= ue) return;
    const int tid = threadIdx.x, lane = tid & 63, r32 = lane & 31, hi = lane >> 5, wid = __builtin_amdgcn_readfirstlane(tid >> 6), h = wid & 3, sb = wid >> 2;
    const int qq = (lane & 15) >> 2, p = lane & 3, blk = (lane >> 4) & 1;
    const int fk = (((r32 >> 1) & 1) << 2) | ((r32 >> 2) & 3);
    unsigned kaddr[4];
#pragma unroll
    for (int d0 = 0; d0 < 4; ++d0) kaddr[d0] = (unsigned)(r32 * 128 + (((2 * d0 + hi) ^ fk) << 4));
    unsigned vaddr[2][2];
#pragma unroll
    for (int c = 0; c < 2; ++c)
#pragma unroll
        for (int hf = 0; hf < 2; ++hf) { const int fv = ((qq >> 1) << 2) | ((2 * hf + hi) & 3);
            vaddr[c][hf] = (unsigned)(VOFF + (8 * hf + 4 * hi + qq) * 128 + (((4 * c + 2 * blk + (p >> 1)) ^ fv) << 4) + 8 * (p & 1)); }
    u32x4 kreg[PER], vreg[PER]; unsigned kmask[PER]; bf16x8 qn[4]; float sinkn = 0.f;
#define ATT_LOAD(U) do { \
        _Pragma("unroll") for (int i_ = 0; i_ < PER; ++i_) { const int cid_ = tid + 512 * i_, row_ = cid_ >> 3, ch_ = cid_ & 7, kp_ = (U).q0 - W + row_; \
            const int kc_ = min(max(kp_, 0), (U).L - 1); const unsigned ok_ = (kp_ == kc_) ? 0xffffffffu : 0u;     \
            kreg[i_] = *(const u32x4*)((U).K + (size_t)kc_ * (U).rstride + ch_ * 8); vreg[i_] = *(const u32x4*)((U).V + (size_t)kc_ * (U).rstride + ch_ * 8); kmask[i_] = ok_; } \
        { const bf16_t* qp_ = (U).Q + (size_t)((U).q0 + 32 * sb + r32) * (U).rstride + h * 64 + 8 * hi; \
          if (SINK) sinkn = (U).sink[h]; \
          _Pragma("unroll") for (int d0_ = 0; d0_ < 4; ++d0_) qn[d0_] = *(const bf16x8*)(qp_ + 16 * d0_); } } while (0)
#define ATT_PIN() asm volatile("" : "+v"(qn[3]))
    if (wid >= 4) __builtin_amdgcn_s_setprio(1);
    AU cur = dec(ub);
    ATT_LOAD(cur); ATT_PIN();
    for (int u = ub; u < ue; ++u) {
        const float sink2 = sinkn * 1.4426950408889634f;
#pragma unroll
        for (int i = 0; i < PER; ++i) { const int cid = tid + 512 * i, row = cid >> 3, ch = cid & 7; const unsigned o = swz(row, ch);
            *(ATT_LAS u32x4*)(lds + o) = kreg[i] & kmask[i]; *(ATT_LAS u32x4*)(lds + VOFF + o) = vreg[i] & kmask[i]; }
        bf16x8 qf[4];
#pragma unroll
        for (int d0 = 0; d0 < 4; ++d0) qf[d0] = qn[d0];
        asm volatile("s_waitcnt lgkmcnt(0)" ::: "memory"); __builtin_amdgcn_s_barrier(); asm volatile("" ::: "memory");
        const AU nxt = dec(min(u + 1, ue - 1));
        ATT_LOAD(nxt);
        const int q0 = cur.q0, L = cur.L; const int qrow = q0 + 32 * sb + r32;
        float m = 0.f, l = 0.f; f32x16 o0 = {}, o1 = {}, negm = {};
        const float NEG = -INFINITY;
        const int tb = q0 - W + 32 * sb;
        const int j0 = tb < 0 ? (-tb) >> 5 : 0; const int j1 = SKIPT ? j0 - 1 : min(NT - 1, (L - 32 - tb) >> 5);
        bf16x8 kf[4];
        { const unsigned rb0 = (unsigned)((32 * sb + 32 * j0) * 128);
#pragma unroll
          for (int d0 = 0; d0 < 4; ++d0) kf[d0] = *(const ATT_LAS bf16x8*)(lds + rb0 + kaddr[d0]); }
        for (int j = j0; j <= j1; ++j) {
            const unsigned rb = (unsigned)((32 * sb + 32 * j) * 128);
            f32x16 S = negm;
#pragma unroll
            for (int d0 = 0; d0 < 4; ++d0) S = __builtin_amdgcn_mfma_f32_32x32x16_bf16(kf[d0], qf[d0], S, 0, 0, 0);
            s16x4 vv[2][2][2];
#pragma unroll
            for (int s2 = 0; s2 < 2; ++s2)
#pragma unroll
                for (int c = 0; c < 2; ++c)
#pragma unroll
                    for (int hf = 0; hf < 2; ++hf) vv[s2][c][hf] = __builtin_bit_cast(s16x4, __builtin_amdgcn_ds_read_tr16_b64_v4i16((ATT_LAS s16x4*)(lds + rb + s2 * 2048 + vaddr[c][hf])));
            { const unsigned rbn = j < j1 ? rb + 4096u : rb;
#pragma unroll
              for (int d0 = 0; d0 < 4; ++d0) kf[d0] = *(const ATT_LAS bf16x8*)(lds + rbn + kaddr[d0]); }
            __builtin_amdgcn_sched_barrier(0);
            if (j == 0) {
#pragma unroll
                for (int r = 0; r < 16; ++r) if (crow(r, hi) < r32) S[r] = NEG; }
            if (j == NT - 1) {
#pragma unroll
                for (int r = 0; r < 16; ++r) if (crow(r, hi) > r32) S[r] = NEG; }
            float mx = fmaxf(fmaxf(S[0], S[1]), S[2]);
#pragma unroll
            for (int r = 3; r < 15; r += 2) mx = fmaxf(fmaxf(mx, S[r]), S[r + 1]);
            mx = fmaxf(mx, S[15]);
            { auto rr = __builtin_amdgcn_permlane32_swap(__float_as_uint(mx), __float_as_uint(mx), false, false); mx = fmaxf(__uint_as_float(rr[0]), __uint_as_float(rr[1])); }
            if (j == j0) {
                float mr = mx; if (SINK) mr = fmaxf(mr, sink2);
                m = mr; l = 0.f; if (SINK) l = hi == 0 ? __builtin_amdgcn_exp2f(sink2 - mr) : 0.f;
#pragma unroll
                for (int r = 0; r < 16; ++r) { S[r] -= mr; negm[r] = -mr; }
            } else if (__builtin_amdgcn_ballot_w64(mx > 8.0f) != 0ull) {
                const float d = fmaxf(mx, 0.f), alpha = __builtin_amdgcn_exp2f(-d); m += d; l *= alpha;
#pragma unroll
                for (int r = 0; r < 16; ++r) { S[r] -= d; negm[r] = -m; o0[r] *= alpha; o1[r] *= alpha; }
            }
            float ls0 = 0.f, ls1 = 0.f;
#pragma unroll
            for (int r = 0; r < 16; r += 2) { S[r] = __builtin_amdgcn_exp2f(S[r]); S[r + 1] = __builtin_amdgcn_exp2f(S[r + 1]); ls0 += S[r]; ls1 += S[r + 1]; }
            l += ls0 + ls1;
            u32x4 pw0, pw1;
            pw0.x = pk(S[0], S[1]); pw0.y = pk(S[2], S[3]); pw0.z = pk(S[4], S[5]); pw0.w = pk(S[6], S[7]);
            pw1.x = pk(S[8], S[9]); pw1.y = pk(S[10], S[11]); pw1.z = pk(S[12], S[13]); pw1.w = pk(S[14], S[15]);
            const bf16x8 pa0 = __builtin_bit_cast(bf16x8, pw0), pa1 = __builtin_bit_cast(bf16x8, pw1);
#pragma unroll
            for (int s2 = 0; s2 < 2; ++s2) {
                const bf16x8 pa = s2 ? pa1 : pa0;
#pragma unroll
                for (int c = 0; c < 2; ++c) {
                    const s16x4 v0 = vv[s2][c][0], v1 = vv[s2][c][1];
                    const bf16x8 vf = (bf16x8){v0[0], v0[1], v0[2], v0[3], v1[0], v1[1], v1[2], v1[3]};
                    if (c == 0) o0 = __builtin_amdgcn_mfma_f32_32x32x16_bf16(vf, pa, o0, 0, 0, 0); else o1 = __builtin_amdgcn_mfma_f32_32x32x16_bf16(vf, pa, o1, 0, 0, 0);
                }
            }
        }
        float lt; { auto rr = __builtin_amdgcn_permlane32_swap(__float_as_uint(l), __float_as_uint(l), false, false); lt = __uint_as_float(rr[0]) + __uint_as_float(rr[1]); }
        const float inv = 1.0f / lt;
        unsigned char* rbp = (unsigned char*)(cur.O + (size_t)qrow * cur.ostride + h * 64) + (hi ? 16 : 0);
#pragma unroll
        for (int kp = 0; kp < 4; ++kp) {
            const int c = kp >> 1, g0 = 2 * (kp & 1);
            unsigned ax, ay, bx, by;
            if (c == 0) { ax = pk(o0[4 * g0] * inv, o0[4 * g0 + 1] * inv); ay = pk(o0[4 * g0 + 2] * inv, o0[4 * g0 + 3] * inv); bx = pk(o0[4 * g0 + 4] * inv, o0[4 * g0 + 5] * inv); by = pk(o0[4 * g0 + 6] * inv, o0[4 * g0 + 7] * inv); }
            else        { ax = pk(o1[4 * g0] * inv, o1[4 * g0 + 1] * inv); ay = pk(o1[4 * g0 + 2] * inv, o1[4 * g0 + 3] * inv); bx = pk(o1[4 * g0 + 4] * inv, o1[4 * g0 + 5] * inv); by = pk(o1[4 * g0 + 6] * inv, o1[4 * g0 + 7] * inv); }
            { auto r = __builtin_amdgcn_permlane32_swap(ax, bx, false, false); ax = r[0]; bx = r[1]; }
            { auto r = __builtin_amdgcn_permlane32_swap(ay, by, false, false); ay = r[0]; by = r[1]; }
            *(u32x4*)(rbp + 32 * kp) = (u32x4){ax, ay, bx, by};
        }
        if (LSEOUT) { if (hi == 0) cur.lse[(size_t)qrow * cur.lstride + h] = m + __builtin_amdgcn_logf(lt); }
        asm volatile("s_waitcnt lgkmcnt(0)" ::: "memory"); __builtin_amdgcn_s_barrier(); asm volatile("" ::: "memory");
        ATT_PIN();
        cur = nxt;
    }
    __builtin_amdgcn_s_setprio(0);
#undef ATT_LOAD
#undef ATT_PIN
}
}

#define LAS __attribute__((address_space(3)))
typedef unsigned short bf16;
typedef unsigned v4u __attribute__((ext_vector_type(4)));
typedef float f32x4 __attribute__((ext_vector_type(4)));
constexpr int NWAVES = 8, NTHREADS = 512;
constexpr int BATCH = 32, SEQ = 2048, DM = 1024, T = BATCH * SEQ, DFF = 2816, QKVW = 1536, NH = 16;
constexpr int LDS_BYTES = 135168;
constexpr size_t MiB = 1u << 20;
constexpr size_t WS_WIN0 = 0;
constexpr size_t WS_WOUT0 = WS_WIN0 + (size_t)1536 * 1024 * 2;
constexpr size_t WS_WIN1 = WS_WOUT0 + (size_t)1024 * 1024 * 2;
constexpr size_t WS_WOUT1 = WS_WIN1 + (size_t)4608 * 1024 * 2;
constexpr size_t WS_WGU0 = WS_WOUT1 + (size_t)1024 * 1024 * 2;
constexpr size_t WS_WGU1 = WS_WGU0 + (size_t)5632 * 1024 * 2;
constexpr size_t WS_WD0 = WS_WGU1 + (size_t)5632 * 1024 * 2;
constexpr size_t WS_WD1 = WS_WD0 + (size_t)1024 * 2816 * 2;
constexpr size_t WS_COS = WS_WD1 + (size_t)1024 * 2816 * 2;
constexpr size_t WS_SIN = WS_COS + (size_t)2048 * 32 * 4;
constexpr size_t WS_SSQ = WS_SIN + (size_t)2048 * 32 * 4;
constexpr size_t WS_LSE = WS_SSQ + (size_t)5 * T * 4;
constexpr size_t WS_CTL = 71 * MiB;
constexpr size_t WS_ROT = 71 * MiB + 65536;
constexpr size_t WS_XB = 72 * MiB;
constexpr size_t WS_O = WS_XB + 128 * MiB;
constexpr size_t WS_BIG = WS_O + 128 * MiB;
constexpr size_t WS_END = WS_BIG + (size_t)T * 4608 * 2;
static_assert(WS_LSE + (size_t)3 * T * 16 * 4 <= WS_XB, "ws map");

__device__ __forceinline__ unsigned f2bf(float f) { unsigned u = __builtin_bit_cast(unsigned, f); return (u + 0x7fffu + ((u >> 16) & 1u)) >> 16; }
__device__ __forceinline__ unsigned pk2(float lo, float hi) { return f2bf(lo) | (f2bf(hi) << 16); }
__device__ __forceinline__ float wave_sum(float v) {
#pragma unroll
    for (int o = 1; o < 64; o <<= 1) v += __shfl_xor(v, o);
    return v;
}
__device__ __forceinline__ void transpose_item(const float* Wa, const float* Wb, int mode, const float* gain, int K, int Nsrc, bf16* WT, int nblk, LAS float* scr, int item, int lane) {
    const int kb = item / nblk, nb = item % nblk, k0 = 64 * kb, n0 = 32 * nb;
    const int np = n0 + (lane & 31); const float* W = Wa; int ncol = np;
    if (mode == 1) { const int grp = np / 1536; int c = np % 1536;
        if (c < 1280) { const int head = c >> 6, pp = c & 63, j = pp >> 3, e = pp & 7; c = head * 64 + (e < 4 ? 4 * j + e : 32 + 4 * j + (e - 4)); }
        ncol = grp * 1536 + c; }
    else if (mode == 2) { const int pn = np >> 8, wi = np & 255; W = (wi >> 7) ? Wb : Wa; ncol = pn * 128 + (wi & 127); }
    float wv[32], gv[32];
#pragma unroll
    for (int i = 0; i < 32; ++i) { const int kk = 2 * i + (lane >> 5); wv[i] = W[(size_t)(k0 + kk) * Nsrc + ncol]; gv[i] = gain ? gain[k0 + kk] : 1.0f; }
#pragma unroll
    for (int i = 0; i < 32; ++i) { const int kk = 2 * i + (lane >> 5); scr[kk * 33 + (lane & 31)] = wv[i] * gv[i]; }
    asm volatile("s_waitcnt lgkmcnt(0)" ::: "memory");
    const int c = lane & 7;
#pragma unroll
    for (int j = 0; j < 4; ++j) { const int n = (lane >> 3) + 8 * j; const LAS float* s = scr + (8 * c) * 33 + n;
        v4u o; o.x = pk2(s[0 * 33], s[1 * 33]); o.y = pk2(s[2 * 33], s[3 * 33]); o.z = pk2(s[4 * 33], s[5 * 33]); o.w = pk2(s[6 * 33], s[7 * 33]);
        *(v4u*)(WT + (size_t)(n0 + n) * K + k0 + 8 * c) = o; }
    asm volatile("s_waitcnt lgkmcnt(0)" ::: "memory");
}

#define XB_TMO      128
#define XB_XCNT(j)  (256  + 64 * (j))
#define XB_XSUB(j)  (1280 + 64 * (j))
#define XB_XGEN(j)  (2304 + 64 * (j))
#define XB_TOP      3328
#define XB_TOPGEN   3392
#define XCD_BAR_WORDS 3456
#define XB_SPIN_CAP (1u << 18)
__device__ __forceinline__ unsigned xb_ld(unsigned* p)              { return __hip_atomic_load(p, __ATOMIC_RELAXED, __HIP_MEMORY_SCOPE_AGENT); }
__device__ __forceinline__ unsigned xb_add(unsigned* p, unsigned v) { return __hip_atomic_fetch_add(p, v, __ATOMIC_RELAXED, __HIP_MEMORY_SCOPE_AGENT); }
__device__ __forceinline__ unsigned xb_xcc_id() { return (unsigned)__builtin_amdgcn_s_getreg((3 << 11) | 20) & 0xFu; }
#define XB_SPIN(cond, bar) do { unsigned _sp = 0; while (cond) { __builtin_amdgcn_s_sleep(1); \
    if ((++_sp & 255u) == 0u) { if (xb_ld(&(bar)[XB_TMO])) break; if (_sp > XB_SPIN_CAP) { atomicAdd(&(bar)[XB_TMO], 1u); break; } } } } while (0)
struct XcdBarrier { unsigned* bar; unsigned x; volatile LAS unsigned* st; };
__device__ __forceinline__ XcdBarrier xcd_barrier_post(unsigned* bar, volatile LAS unsigned* st) {
    XcdBarrier b; b.bar = bar; b.x = xb_xcc_id(); b.st = st;
    if (threadIdx.x == 0) (void)xb_add(&bar[XB_XCNT(b.x)], 1u);
    return b;
}
__device__ __forceinline__ void xcd_barrier_complete(unsigned* bar, unsigned x, unsigned& nloc, unsigned& nx) {
    const unsigned G = gridDim.x * gridDim.y * gridDim.z;
    unsigned sum, cnt, mine, sp = 0u;
    for (;;) {
        sum = 0u; cnt = 0u; mine = 0u;
#pragma unroll
        for (unsigned j = 0; j < 16; ++j) { const unsigned c = xb_ld(&bar[XB_XCNT(j)]); sum += c; cnt += (c > 0u) ? 1u : 0u; mine = (j == x) ? c : mine; }
        if (sum == G) break;
        __builtin_amdgcn_s_sleep(1);
        if ((++sp & 255u) == 0u) { if (xb_ld(&bar[XB_TMO])) break; if (sp > XB_SPIN_CAP) { atomicAdd(&bar[XB_TMO], 1u); break; } }
    }
    nloc = mine > 0u ? mine : 1u; nx = cnt > 0u ? cnt : 1u;
}
__device__ __forceinline__ void xcd_barrier(const XcdBarrier& b) {
    asm volatile("s_waitcnt vmcnt(0)" ::: "memory");
    __syncthreads();
    if (threadIdx.x == 0) {
        unsigned* bar = b.bar;
        __builtin_amdgcn_s_waitcnt(0);
        unsigned nloc = b.st[0], nx = b.st[1];
        if (nloc == 0u) { xcd_barrier_complete(bar, b.x, nloc, nx); b.st[0] = nloc; b.st[1] = nx; }
        const unsigned old = xb_add(&bar[XB_XSUB(b.x)], 1u);
        const unsigned gen = old / nloc;
        if (old + 1u == (gen + 1u) * nloc) {
            __builtin_amdgcn_fence(__ATOMIC_RELEASE, "agent");
            asm volatile("s_waitcnt vmcnt(0)" ::: "memory");
            const unsigned og = xb_add(&bar[XB_TOP], 1u);
            const unsigned tg = og / nx;
            if (og + 1u == (tg + 1u) * nx) xb_add(&bar[XB_TOPGEN], 1u);
            else XB_SPIN(xb_ld(&bar[XB_TOPGEN]) == tg, bar);
            __builtin_amdgcn_fence(__ATOMIC_ACQUIRE, "agent");
            xb_add(&bar[XB_XGEN(b.x)], 1u);
            asm volatile("s_waitcnt vmcnt(0)" ::: "memory");
        } else {
            XB_SPIN(xb_ld(&bar[XB_XGEN(b.x)]) == gen, bar);
            __builtin_amdgcn_fence(__ATOMIC_ACQUIRE, "agent");
            asm volatile("s_waitcnt vmcnt(0)" ::: "memory");
        }
    }
    __syncthreads();
}

#define XB_LOC(j) (3456 + 64 * (j))
__device__ __forceinline__ void xcd_local_barrier(unsigned* bar, unsigned x, unsigned nloc, unsigned epoch) {
    asm volatile("s_waitcnt vmcnt(0)" ::: "memory");
    __syncthreads();
    if (threadIdx.x == 0) {
        __builtin_amdgcn_s_waitcnt(0);
        (void)xb_add(&bar[XB_LOC(x)], 1u);
        const unsigned target = epoch * nloc;
        XB_SPIN(xb_ld(&bar[XB_LOC(x)]) < target, bar);
        __builtin_amdgcn_fence(__ATOMIC_ACQUIRE, "agent");
        asm volatile("s_waitcnt vmcnt(0)" ::: "memory");
    }
    __syncthreads();
}

struct Args {
    const float* x; const float* a_w_in; const float* a_sink; const float* a_w_out; const float* b_w_in; const float* b_w_out;
    const float* norm_mix; const float* norm_ffn; const float* w_gate; const float* w_up; const float* w_down; const float* final_norm;
    float* out; unsigned char* ws; int ph_lo, ph_hi;
};
constexpr int N_PHASES = 13;

__global__ void __launch_bounds__(NTHREADS, 2) mega_fwd(Args a) {
    extern __shared__ __attribute__((aligned(16))) unsigned char lds_raw[];
    LAS unsigned char* lds = (LAS unsigned char*)lds_raw;
    const int tid = threadIdx.x, lane = tid & 63, wave = __builtin_amdgcn_readfirstlane(tid >> 6);
    const int G = gridDim.x, bid = blockIdx.x;
    unsigned char* ws = a.ws;
    bf16* Win0 = (bf16*)(ws + WS_WIN0); bf16* Wout0 = (bf16*)(ws + WS_WOUT0); bf16* Win1 = (bf16*)(ws + WS_WIN1); bf16* Wout1 = (bf16*)(ws + WS_WOUT1);
    bf16* Wgu0 = (bf16*)(ws + WS_WGU0); bf16* Wgu1 = (bf16*)(ws + WS_WGU1); bf16* Wd0 = (bf16*)(ws + WS_WD0); bf16* Wd1 = (bf16*)(ws + WS_WD1);
    float* cosT = (float*)(ws + WS_COS); float* sinT = (float*)(ws + WS_SIN); float* rotT = (float*)(ws + WS_ROT); unsigned* ssq = (unsigned*)(ws + WS_SSQ); float* lse = (float*)(ws + WS_LSE);
    bf16* XB = (bf16*)(ws + WS_XB); bf16* OB = (bf16*)(ws + WS_O); bf16* BIG = (bf16*)(ws + WS_BIG);
    float* X = a.out;
    const int lo = a.ph_lo, hi_ph = a.ph_hi;
    unsigned* ctl = (unsigned*)(ws + WS_CTL);
    LAS unsigned* ldsctl = (LAS unsigned*)(lds + 133120);
    if (tid < 8) ldsctl[tid] = 0u;
    __syncthreads();
    XcdBarrier xbar; xbar.bar = ctl; xbar.x = 0; xbar.st = nullptr;
    if (MK_N_LAUNCHES == 1) { xbar.bar = ctl; xbar.x = xb_xcc_id(); xbar.st = (volatile LAS unsigned*)(ldsctl + 2);
        if (tid == 0) ldsctl[4] = xb_add(&ctl[XB_XCNT(xbar.x)], 1u); }
    int vid = bid, bidA = bid; bool local_mode = false; unsigned lepoch = 0u;
    if (a.ph_lo < 0) cg::this_grid().sync();
#define IN(k) (lo <= (k) && (k) < hi_ph)
#define GSYNC() do { asm volatile("s_waitcnt vmcnt(0) lgkmcnt(0)" ::: "memory"); cg::this_grid().sync(); } while (0)
#define SEAM(k) do { if (IN(k) && IN((k) + 1)) { if (local_mode) { ++lepoch; xcd_local_barrier(ctl, xbar.x, (unsigned)(G / 8), lepoch); } else { xcd_barrier(xbar); } } } while (0)
#define STAGGER() do { if (STAGGER_US > 0) { const unsigned long long t0_ = __builtin_amdgcn_s_memrealtime(); const unsigned long long d_ = (unsigned long long)((bid >> 3) & 7) * (unsigned long long)(STAGGER_US * 100 / 8); \
        while (__builtin_amdgcn_s_memrealtime() - t0_ < d_) __builtin_amdgcn_s_sleep(8); } } while (0)

    if (IN(0)) {
        LAS float* scr = (LAS float*)(lds + wave * 16384);
        const int gw = bid * NWAVES + wave, NGW = G * NWAVES;
        constexpr int I_IN0 = 16 * 48, I_OUT = 16 * 32, I_IN1 = 16 * 144, I_GU = 16 * 176, I_D = 44 * 32;
        constexpr int NITEMS = I_IN0 + 2 * I_OUT + I_IN1 + 2 * I_GU + 2 * I_D;
        for (int it = gw; it < NITEMS; it += NGW) {
            int r = it;
            if (r < I_IN0) { transpose_item(a.a_w_in, nullptr, 1, a.norm_mix, 1024, 1536, Win0, 48, scr, r, lane); continue; } r -= I_IN0;
            if (r < I_OUT) { transpose_item(a.a_w_out, nullptr, 0, nullptr, 1024, 1024, Wout0, 32, scr, r, lane); continue; } r -= I_OUT;
            if (r < I_IN1) { transpose_item(a.b_w_in, nullptr, 1, a.norm_mix + 1024, 1024, 4608, Win1, 144, scr, r, lane); continue; } r -= I_IN1;
            if (r < I_OUT) { transpose_item(a.b_w_out, nullptr, 0, nullptr, 1024, 1024, Wout1, 32, scr, r, lane); continue; } r -= I_OUT;
            if (r < I_GU) { transpose_item(a.w_gate, a.w_up, 2, a.norm_ffn, 1024, 2816, Wgu0, 176, scr, r, lane); continue; } r -= I_GU;
            if (r < I_GU) { transpose_item(a.w_gate + (size_t)1024 * 2816, a.w_up + (size_t)1024 * 2816, 2, a.norm_ffn + 1024, 1024, 2816, Wgu1, 176, scr, r, lane); continue; } r -= I_GU;
            if (r < I_D) { transpose_item(a.w_down, nullptr, 0, nullptr, 2816, 1024, Wd0, 32, scr, r, lane); continue; } r -= I_D;
            transpose_item(a.w_down + (size_t)2816 * 1024, nullptr, 0, nullptr, 2816, 1024, Wd1, 32, scr, r, lane);
        }
        const int gt = bid * NTHREADS + tid, NGT = G * NTHREADS;
        for (int i = gt; i < 2048 * 32; i += NGT) {
            const int t = i >> 5, f = i & 31; double inv = 1.0; for (int k = 0; k < f; ++k) inv *= 0.74989420933245583;
            double rev = (double)t * inv * 0.15915494309189535; rev = rev - __builtin_floor(rev); const float fr = (float)rev;
            cosT[i] = __builtin_amdgcn_cosf(fr); sinT[i] = __builtin_amdgcn_sinf(fr);
        }
        if (gt < 32) { double inv = 1.0; for (int k = 0; k < gt; ++k) inv *= 0.74989420933245583;
            double r16 = 16.0 * inv * 0.15915494309189535; r16 -= __builtin_floor(r16); double r128 = 128.0 * inv * 0.15915494309189535; r128 -= __builtin_floor(r128);
            rotT[gt] = __builtin_amdgcn_cosf((float)r16); rotT[32 + gt] = __builtin_amdgcn_sinf((float)r16); rotT[64 + gt] = __builtin_amdgcn_cosf((float)r128); rotT[96 + gt] = __builtin_amdgcn_sinf((float)r128); }
        for (int i = gt; i < 4 * T; i += NGT) ssq[T + i] = 0u;
        for (int row = gw; row < T; row += 4 * NGW) {
            f32x4 v[4][4];
#pragma unroll
            for (int q = 0; q < 4; ++q) { const int rq = min(row + q * NGW, T - 1); const f32x4* xr = (const f32x4*)(a.x + (size_t)rq * DM) + lane;
#pragma unroll
                for (int j = 0; j < 4; ++j) v[q][j] = xr[64 * j]; }
#pragma unroll
            for (int q = 0; q < 4; ++q) { const int rq = row + q * NGW; if (rq < T) { float s = 0.f;
#pragma unroll
                for (int j = 0; j < 4; ++j) s += (v[q][j].x * v[q][j].x + v[q][j].y * v[q][j].y) + (v[q][j].z * v[q][j].z + v[q][j].w * v[q][j].w);
                s = wave_sum(s); if (lane == 0) ssq[rq] = (unsigned)(s * pg8::SSQ_SCALE + 0.5f);
                unsigned long long* o8 = (unsigned long long*)(XB + (size_t)rq * DM) + lane;
#pragma unroll
                for (int j = 0; j < 4; ++j) o8[64 * j] = (unsigned long long)pk2(v[q][j].x, v[q][j].y) | ((unsigned long long)pk2(v[q][j].z, v[q][j].w) << 32); } }
        }
        __syncthreads();
    }
    SEAM(0);
    if (MK_N_LAUNCHES == 1 && XCD_LOCAL && IN(0) && IN(1)) {
        bool okc = (G % 8) == 0 && (G / 8) == 32;
        for (int j = 0; j < 16; ++j) { const unsigned c = xb_ld(&ctl[XB_XCNT(j)]); okc = okc && (j < 8 ? c == (unsigned)(G / 8) : c == 0u); }
        okc = okc && xbar.x < 8u;
        if (okc) { const int xl = (int)ldsctl[4]; local_mode = true; vid = xl * 8 + (int)xbar.x; bidA = (int)xbar.x * 32 + xl; }
    }
    const size_t SLICE = (size_t)8192 * 4608;
    const size_t xsel = local_mode ? (size_t)xbar.x : 0;
    bf16* BIGQ = BIG + xsel * (SLICE - (size_t)8192 * QKVW);
    bf16* BIGH = BIG + xsel * (SLICE - (size_t)8192 * DFF);
    bf16* BIGP = BIG;
    if (IN(1)) _Pragma("unroll") for (int rep = 0; rep < (PROBE_DUP == 1 ? 2 : 1); ++rep) {
        if (rep) GSYNC();
        pg8::Gemm g{XB, Win0, T, QKVW, DM}; pg8::StaticOrder S; S.init(T, QKVW, G, vid);
        pg8::EpiQKV E{BIGQ, QKVW, ssq, cosT, sinT, rotT};
        STAGGER();
        pg8::gemm_phase<pg8::EpiQKV, pg8::StaticOrder, true, true>(lds, g, S, E);
    }
    SEAM(1);
    if (IN(2)) _Pragma("unroll") for (int rep = 0; rep < (PROBE_DUP == 2 ? 2 : 1); ++rep) {
        if (rep) GSYNC();
        constexpr int NU = BATCH * 4 * 32; const int per = (NU + G - 1) / G;
        const bf16* BIGc = BIGQ; bf16* OBc = OB; const float* sinkp = a.a_sink;
        auto dec = [=](int u) { const int qb = u & 31, kvh = (u >> 5) & 3, b = u >> 7; const bf16* base = BIGc + (size_t)b * SEQ * QKVW;
            return att::AU{base + kvh * 256, base + 1024 + kvh * 64, base + 1280 + kvh * 64, OBc + (size_t)b * SEQ * DM + kvh * 256, (size_t)QKVW, (size_t)DM, SEQ, qb * 64, sinkp + kvh * 4, nullptr, 0}; };
        att::phase<128, true, false>(lds, min(NU, bidA * per), min(NU, (bidA + 1) * per), dec);
    }
    SEAM(2);
    if (IN(3)) {
        pg8::Gemm g{OB, Wout0, T, DM, DM}; pg8::StaticOrder S; S.init(T, DM, G, vid);
        pg8::EpiRes E{XB, ssq + T};
        STAGGER();
        pg8::gemm_phase<pg8::EpiRes, pg8::StaticOrder, true, true>(lds, g, S, E);
    }
    SEAM(3);
    if (IN(4)) for (int part = 0; part < FFN_PARTS; ++part) {
        { pg8::Gemm g{XB, Wgu0, T, 2 * DFF, DM}; pg8::StaticOrder S; S.init(T, 2 * DFF, G, vid); S.part = part; S.nparts = FFN_PARTS;
          pg8::EpiSwiGLU E{BIGH, DFF, ssq + T};
          pg8::gemm_phase<pg8::EpiSwiGLU, pg8::StaticOrder, true, true>(lds, g, S, E); }
        SEAM(4);
        { pg8::Gemm g{BIGH, Wd0, T, DM, DFF}; pg8::StaticOrder S; S.init(T, DM, G, vid); S.part = part; S.nparts = FFN_PARTS;
          pg8::EpiRes E{XB, ssq + 2 * T};
          pg8::gemm_phase<pg8::EpiRes, pg8::StaticOrder, true, true>(lds, g, S, E); }
        SEAM(5);
    }
    if (IN(6)) _Pragma("unroll") for (int rep = 0; rep < (PROBE_DUP == 6 ? 2 : 1); ++rep) {
        if (rep) GSYNC();
        pg8::Gemm g{XB, Win1, T, 3 * QKVW, DM}; pg8::StaticOrder S; S.init(T, 3 * QKVW, G, vid);
        pg8::EpiQKV E{BIGP, 3 * QKVW, ssq + 2 * T, cosT, sinT, rotT};
        STAGGER();
        pg8::gemm_phase<pg8::EpiQKV, pg8::StaticOrder, true, true>(lds, g, S, E);
    }
    SEAM(6);
    if (IN(7)) {
        constexpr int NU = 3 * BATCH * 4 * 32; const int per = (NU + G - 1) / G;
        bf16* BIGc = BIGP; float* lsep = lse;
        auto dec = [=](int u) { const int xblk = u / 1536, rem = u % 1536, gidx = rem >> 9, v = rem & 511, b = 4 * xblk + (v >> 7), kvh = (v >> 5) & 3, qa = v & 31;
            const int dsh = 2 * gidx, dil = 1 << dsh, nbk = 32 >> dsh, r = qa / nbk, qb = qa % nbk;
            bf16* base = BIGc + ((size_t)b * SEQ + r) * (3 * QKVW) + gidx * QKVW;
            return att::AU{base + kvh * 256, base + 1024 + kvh * 64, base + 1280 + kvh * 64, base + kvh * 256, (size_t)dil * 3 * QKVW, (size_t)dil * 3 * QKVW, SEQ >> dsh, qb * 64, nullptr,
                           lsep + ((size_t)gidx * T + (size_t)b * SEQ + r) * NH + kvh * 4, (size_t)dil * NH}; };
        att::phase<64, false, true>(lds, min(NU, bidA * per), min(NU, (bidA + 1) * per), dec);
    }
    SEAM(7);
    if (IN(8)) {
        const int gt = bid * NTHREADS + tid, NGT = G * NTHREADS;
        const int tpw = T / G;
#pragma unroll 4
        for (int il = tid; il < tpw * 128; il += NTHREADS) {
            const int i = bidA * tpw * 128 + il;
            const int tok = i >> 7, ch = i & 127, head = ch >> 3;
            const float l0 = lse[(size_t)tok * NH + head], l1 = lse[((size_t)T + tok) * NH + head], l2 = lse[((size_t)2 * T + tok) * NH + head];
            const float mx = fmaxf(l0, fmaxf(l1, l2)); float w0 = __builtin_amdgcn_exp2f(l0 - mx), w1 = __builtin_amdgcn_exp2f(l1 - mx), w2 = __builtin_amdgcn_exp2f(l2 - mx);
            const float inv = 1.0f / (w0 + w1 + w2); w0 *= inv; w1 *= inv; w2 *= inv;
            const bf16* src = BIGP + (size_t)tok * (3 * QKVW) + ch * 8;
            const v4u a0 = *(const v4u*)src, a1 = *(const v4u*)(src + QKVW), a2 = *(const v4u*)(src + 2 * QKVW);
            v4u o;
#pragma unroll
            for (int e = 0; e < 4; ++e) {
                const float x0 = __uint_as_float(a0[e] << 16), y0 = __uint_as_float(a0[e] & 0xffff0000u);
                const float x1 = __uint_as_float(a1[e] << 16), y1 = __uint_as_float(a1[e] & 0xffff0000u);
                const float x2 = __uint_as_float(a2[e] << 16), y2 = __uint_as_float(a2[e] & 0xffff0000u);
                o[e] = pk2(w0 * x0 + w1 * x1 + w2 * x2, w0 * y0 + w1 * y1 + w2 * y2);
            }
            *(v4u*)(OB + (size_t)tok * DM + ch * 8) = o;
        }
    }
    SEAM(8);
    if (IN(9)) {
        pg8::Gemm g{OB, Wout1, T, DM, DM}; pg8::StaticOrder S; S.init(T, DM, G, vid);
        pg8::EpiRes E{XB, ssq + 3 * T};
        STAGGER();
        pg8::gemm_phase<pg8::EpiRes, pg8::StaticOrder, true, true>(lds, g, S, E);
    }
    SEAM(9);
    if (IN(10)) for (int part = 0; part < FFN_PARTS; ++part) {
        { pg8::Gemm g{XB, Wgu1, T, 2 * DFF, DM}; pg8::StaticOrder S; S.init(T, 2 * DFF, G, vid); S.part = part; S.nparts = FFN_PARTS;
          pg8::EpiSwiGLU E{BIGH, DFF, ssq + 3 * T};
          pg8::gemm_phase<pg8::EpiSwiGLU, pg8::StaticOrder, true, true>(lds, g, S, E); }
        SEAM(10);
        { pg8::Gemm g{BIGH, Wd1, T, DM, DFF}; pg8::StaticOrder S; S.init(T, DM, G, vid); S.part = part; S.nparts = FFN_PARTS;
          pg8::EpiRes E{XB, ssq + 4 * T};
          pg8::gemm_phase<pg8::EpiRes, pg8::StaticOrder, true, true>(lds, g, S, E); }
        SEAM(11);
    }
    if (IN(12)) {
        const int gt = bid * NTHREADS + tid, NGT = G * NTHREADS;
        const int tpw = T / G;
#pragma unroll 4
        for (int il = tid; il < tpw * 128; il += NTHREADS) {
            const int i = bidA * tpw * 128 + il;
            const int row = i >> 7, ch = i & 127;
            const float rstd = __builtin_amdgcn_rsqf((float)ssq[4 * T + row] * pg8::SSQ_INV + pg8::RMS_EPS);
            const v4u v = *(const v4u*)(XB + (size_t)row * DM + ch * 8);
            const f32x4 g0 = *(const f32x4*)(a.final_norm + ch * 8), g1 = *(const f32x4*)(a.final_norm + ch * 8 + 4);
            const f32x4 o0 = (f32x4){__uint_as_float(v.x << 16), __uint_as_float(v.x & 0xffff0000u), __uint_as_float(v.y << 16), __uint_as_float(v.y & 0xffff0000u)};
            const f32x4 o1 = (f32x4){__uint_as_float(v.z << 16), __uint_as_float(v.z & 0xffff0000u), __uint_as_float(v.w << 16), __uint_as_float(v.w & 0xffff0000u)};
            float* orow = X + (size_t)row * DM + ch * 8;
            *(f32x4*)orow = o0 * rstd * g0; *(f32x4*)(orow + 4) = o1 * rstd * g1;
        }
    }
#undef IN
#undef SEAM
}

extern "C" void kernel_launch(void* const* d_in, const int* in_sizes, int n_in, void* d_out, int out_size, void* d_ws, size_t ws_size, hipStream_t stream) {
    static int grid = 0;
    if (grid == 0) {
        if (n_in != 12 || in_sizes[0] != T * DM || out_size != T * DM || ws_size < WS_END) {
            fprintf(stderr, "kernel_launch: unexpected shapes (n_in %d, in0 %d, out %d, ws %zu, need %zu)\n", n_in, n_in > 0 ? in_sizes[0] : -1, out_size, ws_size, (size_t)WS_END); grid = -1; return; }
        int dev = 0, cus = 0, per_cu = 0;
        hipGetDevice(&dev); hipDeviceGetAttribute(&cus, hipDeviceAttributeMultiprocessorCount, dev);
        if (hipFuncSetAttribute((const void*)mega_fwd, hipFuncAttributeMaxDynamicSharedMemorySize, LDS_BYTES) != hipSuccess) { fprintf(stderr, "kernel_launch: hipFuncSetAttribute failed\n"); grid = -1; return; }
        if (hipOccupancyMaxActiveBlocksPerMultiprocessor(&per_cu, (const void*)mega_fwd, NTHREADS, LDS_BYTES) != hipSuccess || per_cu < 1) { fprintf(stderr, "kernel_launch: occupancy query gave %d\n", per_cu); per_cu = 1; }
        (void)hipGetLastError();
        grid = cus * per_cu;
        if (T % grid != 0) { fprintf(stderr, "kernel_launch: grid %d does not divide the %d tokens\n", grid, T); grid = -1; return; }
    }
    if (grid < 0) return;
    Args a{};
    a.x = (const float*)d_in[0]; a.a_w_in = (const float*)d_in[1]; a.a_sink = (const float*)d_in[2]; a.a_w_out = (const float*)d_in[3];
    a.b_w_in = (const float*)d_in[4]; a.b_w_out = (const float*)d_in[5]; a.norm_mix = (const float*)d_in[6]; a.norm_ffn = (const float*)d_in[7];
    a.w_gate = (const float*)d_in[8]; a.w_up = (const float*)d_in[9]; a.w_down = (const float*)d_in[10]; a.final_norm = (const float*)d_in[11];
    a.out = (float*)d_out; a.ws = (unsigned char*)d_ws;
#if MK_N_LAUNCHES == 1
    (void)hipMemsetAsync((char*)d_ws + WS_CTL, 0, 16384, stream);
    a.ph_lo = 0; a.ph_hi = N_PHASES;
    void* args[] = {&a};
    hipError_t e = hipLaunchCooperativeKernel((const void*)mega_fwd, dim3(grid), dim3(NTHREADS), args, LDS_BYTES, stream);
    if (e != hipSuccess) fprintf(stderr, "cooperative launch failed: %s (grid %d)\n", hipGetErrorString(e), grid);
#else
    for (int p = 0; p < N_PHASES; ++p) { a.ph_lo = p; a.ph_hi = p + 1; hipLaunchKernelGGL(mega_fwd, dim3(grid), dim3(NTHREADS), LDS_BYTES, stream, a); }
#endif
}
```
